# Optimizing an MI355X kernel written in HIP

```python
import math
import jax, jax.numpy as jnp
from jax import lax
import numpy as np


D_MODEL = 1024
BATCH = 8
SEQ = 4096
DEPTH = 2

RMS_EPS = 1e-6
ROPE_THETA = 10000.0
QUERY_BLOCK = 128
MLA_HEADS = 8
MLA_Q_LORA = 256
MLA_KV_LORA = 128
MLA_NOPE_DIM = 64
MLA_ROPE_DIM = 32
MLA_V_DIM = 64
FOX_HEADS = 8
FOX_HEAD_DIM = 64
FOX_FORGET_BIAS_INIT = 2.0
MOBA_HEADS = 8
MOBA_HEAD_DIM = 64
MOBA_BLOCK = 256
MOBA_TOPK = 3
MOBA_QUERY_CHUNK = 32
N_BRANCH = 3
BRANCH_WIDTH = FOX_HEADS * FOX_HEAD_DIM
DENSE_FF = 2816
N_EXPERTS = 8
TOP_K = 2
EXPERT_FF = 3584
MOE_ROW_BLOCK = 256
N_DENSE = (DEPTH + 1) // 2
N_MOE = DEPTH // 2

FOX_W = FOX_HEADS * FOX_HEAD_DIM
MOBA_W = MOBA_HEADS * MOBA_HEAD_DIM
GATE_COLS = N_BRANCH * D_MODEL
IN_SPLIT_SIZES = [MLA_Q_LORA, MLA_KV_LORA, MLA_ROPE_DIM,
                  FOX_W, FOX_W, FOX_W, FOX_HEADS,
                  MOBA_W, MOBA_W, MOBA_W, GATE_COLS]
IN_COLS = sum(IN_SPLIT_SIZES)
IN_SPLIT_POINTS = [int(v) for v in np.cumsum(IN_SPLIT_SIZES)[:-1]]

kernel_name = "hybrid_mla_fox_moba_moe_block"


def rms_norm(x, g):
    xf = x.astype(jnp.float32)
    y = xf * lax.rsqrt(jnp.mean(xf * xf, axis=-1, keepdims=True) + RMS_EPS)
    return (y * g.astype(jnp.float32)).astype(x.dtype)


def rope(x, positions):
    d = x.shape[-1]
    half = d // 2
    inv_freq = jnp.exp(-math.log(ROPE_THETA) * jnp.arange(half, dtype=jnp.float32) * 2.0 / d)
    ang = positions.astype(jnp.float32)[..., None] * inv_freq
    cos = jnp.cos(ang)[:, :, None, :]
    sin = jnp.sin(ang)[:, :, None, :]
    xf = x.astype(jnp.float32)
    x1, x2 = xf[..., :half], xf[..., half:]
    return jnp.concatenate([x1 * cos - x2 * sin, x2 * cos + x1 * sin], axis=-1).astype(x.dtype)


def causal_attention(q, k, v, scale, cum_log_f=None):
    B, S, H, dk = q.shape
    dv = v.shape[-1]
    nb = S // QUERY_BLOCK
    q_blocks = q.reshape(B, nb, QUERY_BLOCK, H, dk).swapaxes(0, 1)
    kpos = jnp.arange(S)
    idx = jnp.arange(nb)
    if cum_log_f is None:
        xs = (idx, q_blocks)
        ck = None
    else:
        xs = (idx, q_blocks, cum_log_f.reshape(B, nb, QUERY_BLOCK, H).swapaxes(0, 1))
        ck = cum_log_f.transpose(0, 2, 1)

    def block(args):
        i, qi = args[0], args[1]
        s = jnp.einsum('bqhd,bkhd->bhqk', qi, k).astype(jnp.float32) * scale
        if ck is not None:
            cq = args[2].transpose(0, 2, 1)
            s = s + (cq[..., :, None] - ck[..., None, :])
        qpos = i * QUERY_BLOCK + jnp.arange(QUERY_BLOCK)
        s = jnp.where(kpos[None, :] <= qpos[:, None], s, -jnp.inf)
        p = jax.nn.softmax(s, axis=-1).astype(v.dtype)
        return jnp.einsum('bhqk,bkhd->bqhd', p, v)

    out = lax.map(block, xs)
    return out.swapaxes(0, 1).reshape(B, S, H * dv)


def moba_attention(q, k, v):
    B, S, H, d = q.shape
    nblk = -(-S // MOBA_BLOCK)
    s_pad = nblk * MOBA_BLOCK
    pad = ((0, 0), (0, s_pad - S), (0, 0), (0, 0))
    kb = jnp.pad(k, pad).transpose(0, 2, 1, 3).reshape(B, H, nblk, MOBA_BLOCK, d)
    vb = jnp.pad(v, pad).transpose(0, 2, 1, 3).reshape(B, H, nblk, MOBA_BLOCK, d)
    k_mean = jnp.mean(kb.astype(jnp.float32), axis=3)
    n_sel = min(MOBA_TOPK, nblk)
    nq = S // MOBA_QUERY_CHUNK
    q_chunks = q.reshape(B, nq, MOBA_QUERY_CHUNK, H, d).transpose(1, 0, 3, 2, 4)
    b_idx = jnp.arange(B)[:, None, None, None]
    h_idx = jnp.arange(H)[None, :, None, None]
    scale = d ** -0.5
    blk_ids = jnp.arange(nblk)

    def chunk(args):
        i, qi = args
        qpos = i * MOBA_QUERY_CHUNK + jnp.arange(MOBA_QUERY_CHUNK)
        own = (i * MOBA_QUERY_CHUNK) // MOBA_BLOCK
        gate = jnp.einsum('bhqd,bhnd->bhqn', qi.astype(jnp.float32), k_mean)
        gate = jnp.where(blk_ids < own, gate, -jnp.inf)
        top_val, top_idx = lax.top_k(gate, n_sel)
        sel_ok = jnp.isfinite(top_val)
        k_sel = kb[b_idx, h_idx, top_idx]
        v_sel = vb[b_idx, h_idx, top_idx]
        s_sel = jnp.einsum('bhqd,bhqnkd->bhqnk', qi, k_sel).astype(jnp.float32) * scale
        s_sel = jnp.where(sel_ok[..., None], s_sel, -jnp.inf)
        s_sel = s_sel.reshape(B, H, MOBA_QUERY_CHUNK, n_sel * MOBA_BLOCK)
        k_own = lax.dynamic_index_in_dim(kb, own, axis=2, keepdims=False)
        v_own = lax.dynamic_index_in_dim(vb, own, axis=2, keepdims=False)
        s_own = jnp.einsum('bhqd,bhkd->bhqk', qi, k_own).astype(jnp.float32) * scale
        kpos = own * MOBA_BLOCK + jnp.arange(MOBA_BLOCK)
        s_own = jnp.where(kpos[None, :] <= qpos[:, None], s_own, -jnp.inf)
        p = jax.nn.softmax(jnp.concatenate([s_sel, s_own], axis=-1), axis=-1).astype(v.dtype)
        p_sel = p[..., :n_sel * MOBA_BLOCK].reshape(B, H, MOBA_QUERY_CHUNK, n_sel, MOBA_BLOCK)
        p_own = p[..., n_sel * MOBA_BLOCK:]
        return (jnp.einsum('bhqnk,bhqnkd->bhqd', p_sel, v_sel)
                + jnp.einsum('bhqk,bhkd->bhqd', p_own, v_own))

    out = lax.map(chunk, (jnp.arange(nq), q_chunks))
    return out.transpose(1, 0, 3, 2, 4).reshape(B, S, H * d)


def token_mixers(h, positions, w_in, g_q_lat, g_kv_lat, w_uq, w_ukv, b_forget, w_branch, w_out):
    B, S, _ = h.shape
    proj = h @ w_in
    (c_q, c_kv, k_pe, fq, fk, fv, f_logit, mq, mk, mv, gate_logits) = jnp.split(
        proj, IN_SPLIT_POINTS, axis=-1)

    q = (rms_norm(c_q, g_q_lat) @ w_uq).reshape(B, S, MLA_HEADS, MLA_NOPE_DIM + MLA_ROPE_DIM)
    q = jnp.concatenate([q[..., :MLA_NOPE_DIM], rope(q[..., MLA_NOPE_DIM:], positions)], axis=-1)
    kv = (rms_norm(c_kv, g_kv_lat) @ w_ukv).reshape(B, S, MLA_HEADS, MLA_NOPE_DIM + MLA_V_DIM)
    k_rot = rope(k_pe[:, :, None, :], positions)
    k = jnp.concatenate([kv[..., :MLA_NOPE_DIM],
                         jnp.broadcast_to(k_rot, (B, S, MLA_HEADS, MLA_ROPE_DIM))], axis=-1)
    y_mla = causal_attention(q, k, kv[..., MLA_NOPE_DIM:], (MLA_NOPE_DIM + MLA_ROPE_DIM) ** -0.5)

    log_f = jax.nn.log_sigmoid(f_logit.astype(jnp.float32) + b_forget.astype(jnp.float32))
    cum_log_f = jnp.cumsum(log_f, axis=1)
    heads = lambda t: t.reshape(B, S, FOX_HEADS, FOX_HEAD_DIM)
    y_fox = causal_attention(heads(fq), heads(fk), heads(fv), FOX_HEAD_DIM ** -0.5, cum_log_f)

    mheads = lambda t: t.reshape(B, S, MOBA_HEADS, MOBA_HEAD_DIM)
    y_moba = moba_attention(rope(mheads(mq), positions), rope(mheads(mk), positions), mheads(mv))

    branches = jnp.stack([y_mla, y_fox, y_moba], axis=2)
    gates = jax.nn.sigmoid(gate_logits.reshape(B, S, N_BRANCH, D_MODEL))
    merged = jnp.sum(gates * jnp.einsum('bsnc,ncd->bsnd', branches, w_branch), axis=2)
    return merged @ w_out


def dense_swiglu(h, w_gu, w_down):
    g, u = jnp.split(h @ w_gu, 2, axis=-1)
    return (jax.nn.silu(g) * u) @ w_down


def moe_swiglu(h, w_router, w_gu, w_down):
    B, S, D = h.shape
    T = B * S
    x = h.reshape(T, D)
    logits = (x @ w_router).astype(jnp.float32)
    top_logit, top_e = lax.top_k(logits, TOP_K)
    gate_w = jax.nn.softmax(top_logit, axis=-1)
    A = T * TOP_K
    flat_e = top_e.reshape(A)
    order = jnp.argsort(flat_e, stable=True)
    sorted_e = flat_e[order]
    sorted_tok = order // TOP_K
    sorted_w = gate_w.reshape(A)[order]
    counts = jnp.bincount(flat_e, length=N_EXPERTS)
    padded = (counts + MOE_ROW_BLOCK - 1) // MOE_ROW_BLOCK * MOE_ROW_BLOCK
    pad_end = jnp.cumsum(padded)
    pad_start = pad_end - padded
    start = jnp.cumsum(counts) - counts
    dest = pad_start[sorted_e] + jnp.arange(A) - start[sorted_e]
    n_rows = (-(-A // MOE_ROW_BLOCK) + N_EXPERTS) * MOE_ROW_BLOCK
    n_blocks = n_rows // MOE_ROW_BLOCK
    row_tok = jnp.zeros((n_rows,), jnp.int32).at[dest].set(sorted_tok.astype(jnp.int32))
    row_w = jnp.zeros((n_rows,), jnp.float32).at[dest].set(sorted_w)
    block_e = jnp.minimum(
        jnp.searchsorted(pad_end, jnp.arange(n_blocks) * MOE_ROW_BLOCK, side='right'),
        N_EXPERTS - 1)
    x_rows = x[row_tok].reshape(n_blocks, MOE_ROW_BLOCK, D)

    def expert_block(args):
        xb, e = args
        g, u = jnp.split(xb @ w_gu[e], 2, axis=-1)
        return (jax.nn.silu(g) * u) @ w_down[e]

    y_rows = lax.map(expert_block, (x_rows, block_e)).reshape(n_rows, D)
    y = jnp.zeros((T, D), y_rows.dtype).at[row_tok].add(
        y_rows * row_w[:, None].astype(y_rows.dtype))
    return y.reshape(B, S, D)


def setup_inputs(seed: int = 0) -> dict:
    key = jax.random.key(seed)
    ks = jax.random.split(key, 17)
    f32 = jnp.float32

    def dense(k, shape, fan_in):
        return jax.random.normal(k, shape, f32) * fan_in ** -0.5

    def gain(k, shape):
        return 1.0 + 0.02 * jax.random.normal(k, shape, f32)

    return {
        "x": jax.random.normal(ks[0], (BATCH, SEQ, D_MODEL), f32),
        "positions": jnp.broadcast_to(jnp.arange(SEQ, dtype=jnp.int32)[None, :], (BATCH, SEQ)),
        "g_mix": gain(ks[1], (DEPTH, D_MODEL)),
        "w_in": dense(ks[2], (DEPTH, D_MODEL, IN_COLS), D_MODEL),
        "g_q_lat": gain(ks[3], (DEPTH, MLA_Q_LORA)),
        "g_kv_lat": gain(ks[4], (DEPTH, MLA_KV_LORA)),
        "w_uq": dense(ks[5], (DEPTH, MLA_Q_LORA, MLA_HEADS * (MLA_NOPE_DIM + MLA_ROPE_DIM)), MLA_Q_LORA),
        "w_ukv": dense(ks[6], (DEPTH, MLA_KV_LORA, MLA_HEADS * (MLA_NOPE_DIM + MLA_V_DIM)), MLA_KV_LORA),
        "b_forget": FOX_FORGET_BIAS_INIT + 0.1 * jax.random.normal(ks[7], (DEPTH, FOX_HEADS), f32),
        "w_branch": dense(ks[8], (DEPTH, N_BRANCH, BRANCH_WIDTH, D_MODEL), BRANCH_WIDTH),
        "w_out": dense(ks[9], (DEPTH, D_MODEL, D_MODEL), D_MODEL),
        "g_ffn": gain(ks[10], (DEPTH, D_MODEL)),
        "w_dense_gu": dense(ks[11], (N_DENSE, D_MODEL, 2 * DENSE_FF), D_MODEL),
        "w_dense_down": dense(ks[12], (N_DENSE, DENSE_FF, D_MODEL), DENSE_FF),
        "w_router": dense(ks[13], (N_MOE, D_MODEL, N_EXPERTS), D_MODEL),
        "w_exp_gu": dense(ks[14], (N_MOE, N_EXPERTS, D_MODEL, 2 * EXPERT_FF), D_MODEL),
        "w_exp_down": dense(ks[15], (N_MOE, N_EXPERTS, EXPERT_FF, D_MODEL), EXPERT_FF),
        "g_final": gain(ks[16], (D_MODEL,)),
    }


def reference(x, positions, g_mix, w_in, g_q_lat, g_kv_lat, w_uq, w_ukv, b_forget, w_branch,
              w_out, g_ffn, w_dense_gu, w_dense_down, w_router, w_exp_gu, w_exp_down, g_final):
    for l in range(DEPTH):
        x = x + token_mixers(rms_norm(x, g_mix[l]), positions, w_in[l], g_q_lat[l], g_kv_lat[l],
                             w_uq[l], w_ukv[l], b_forget[l], w_branch[l], w_out[l])
        h = rms_norm(x, g_ffn[l])
        if l % 2 == 0:
            x = x + dense_swiglu(h, w_dense_gu[l // 2], w_dense_down[l // 2])
        else:
            x = x + moe_swiglu(h, w_router[l // 2], w_exp_gu[l // 2], w_exp_down[l // 2])
    return rms_norm(x, g_final)
```

```cpp
#include <hip/hip_runtime.h>
#include <hip/hip_bf16.h>
#include <cstdio>
#include <cstdint>
#include <cstring>

#define LAS __attribute__((address_space(3)))
#define GAS __attribute__((address_space(1)))

namespace pg8 {
typedef unsigned short bf16_t;
typedef short bf16x8 __attribute__((ext_vector_type(8)));
typedef float f32x4 __attribute__((ext_vector_type(4)));
typedef float f32x2 __attribute__((ext_vector_type(2)));
typedef unsigned u32x4 __attribute__((ext_vector_type(4)));
typedef unsigned u32x2 __attribute__((ext_vector_type(2)));
typedef int i32x4 __attribute__((ext_vector_type(4)));
typedef int i32x8 __attribute__((ext_vector_type(8)));
constexpr int BM = 256, BK = 64, HALF = 128, HTB = HALF * BK * 2  , STAGE_BYTES = 8 * HTB, NXCD = 8, WGM = 8;

__host__ __device__ __forceinline__ int lds_byte(int r, int c) { const int st = (r >> 4) * 2 + (c >> 5), rr = r & 15, cc = c & 31, ob = rr * 64 + cc * 2; return st * 1024 + (ob ^ (((ob >> 9) & 1) << 5)); }
__host__ __device__ __forceinline__ void stage_rc(int b, int& R, int& C) { const int st = b / 1024, sb = b % 1024, swz = sb ^ (((sb >> 9) & 1) << 5); R = (st >> 1) * 16 + swz / 64; C = (st & 1) * 32 + (swz % 64) / 2; }
__host__ __device__ __forceinline__ int perm32(int rho) { const int n = rho >> 4, i = rho & 15; return 8 * (i >> 2) + 4 * n + (i & 3); }

struct Unit { int pm, pn, bt; unsigned aoff; int nt; unsigned boff; int ks; };
struct Gemm { const bf16_t* A; const bf16_t* Bt; int lda, K; };

struct GridOrder {
    int nM, nN, nwg, G, c;
    __device__ void init(int nM_, int nN_, int G_, int c_) { nM = nM_; nN = nN_; nwg = nM * nN; G = G_; c = c_; }
    __device__ __forceinline__ bool next_mn(int i, int& pm, int& pn) const {
        const int L = i * G + c; if (L >= nwg) return false;
        int wgid = L; { const int q = nwg / NXCD, r = nwg % NXCD, xcd = wgid % NXCD, off = wgid / NXCD; wgid = (xcd < r ? xcd * (q + 1) : r * (q + 1) + (xcd - r) * q) + off; }
        const int nig = WGM * nN, gid = wgid / nig, fm = gid * WGM, gsz = (nM - fm) < WGM ? (nM - fm) : WGM;
        pm = fm + ((wgid % nig) % gsz); pn = (wgid % nig) / gsz; return true;
    }
    __device__ __forceinline__ bool next(int i, Unit& u) const { if (!next_mn(i, u.pm, u.pn)) return false; u.bt = u.pn; u.aoff = 0u; return true; }
};
struct MidOrder : GridOrder {
    __device__ __forceinline__ bool next(int i, Unit& u) const { if (!next_mn(i, u.pm, u.pn)) return false; u.bt = u.pn; u.aoff = (u.pn >= 3) ? 512u : 0u; return true; }
};
struct MoeOrder : GridOrder {
    const __attribute__((address_space(4))) int* tab;
    __device__ __forceinline__ bool next(int i, Unit& u) const { if (!next_mn(i, u.pm, u.pn)) return false;
        const int e = tab[u.pm]; u.bt = e * nN + u.pn; u.aoff = 0u; return true; }
};

struct MoeDownOrder {
    GridOrder main; int nblk, G, c; const __attribute__((address_space(4))) int* tab;
    __device__ void init(int nblk_, int G_, int c_) { nblk = nblk_; G = G_; c = c_; main.init(256, 4, G_, c_); }
    __device__ __forceinline__ bool next(int i, Unit& u) const {
        const int L = i * G + c; const int j = L - 1024;
        if (j >= (nblk - 256) * 28) return false;
        int pm, pn; main.next_mn(L < 1024 ? i : 0, pm, pn);
        const int q = j / 28, r = j - q * 28, pn2 = r / 7, ks2 = r - pn2 * 7; const bool tail = j >= 0;
        pm = tail ? 256 + q : pm; pn = tail ? pn2 : pn;
        const unsigned off = tail ? (unsigned)ks2 * 512u : 0u;
        u.pm = pm; u.pn = pn; u.bt = tab[pm] * 4 + pn; u.aoff = off; u.boff = off; u.nt = tail ? 4 : 28; u.ks = tail ? ks2 : -1; return true; }
};

__device__ __forceinline__ unsigned cvt_pk_bf16(float lo, float hi) { unsigned r; asm volatile("v_cvt_pk_bf16_f32 %0, %1, %2" : "=v"(r) : "v"(lo), "v"(hi)); return r; }
__device__ __forceinline__ u32x4 pack8(const f32x4 v0, const f32x4 v1) { u32x4 w; w.x = cvt_pk_bf16(v0[0], v0[1]); w.y = cvt_pk_bf16(v0[2], v0[3]); w.z = cvt_pk_bf16(v1[0], v1[1]); w.w = cvt_pk_bf16(v1[2], v1[3]); return w; }
__device__ __forceinline__ u32x2 pack4(const f32x4 v0) { u32x2 w; w.x = cvt_pk_bf16(v0[0], v0[1]); w.y = cvt_pk_bf16(v0[2], v0[3]); return w; }
__device__ __forceinline__ float clamp8(float v) { return fminf(fmaxf(v, -448.0f), 448.0f); }
__device__ __forceinline__ unsigned pk4_f8(float a, float b, float c, float d) { int v = 0; v = __builtin_amdgcn_cvt_pk_fp8_f32(clamp8(a), clamp8(b), v, false); v = __builtin_amdgcn_cvt_pk_fp8_f32(clamp8(c), clamp8(d), v, true); return (unsigned)v; }
__device__ __forceinline__ float bf_lo(unsigned w) { return __uint_as_float(w << 16); }
__device__ __forceinline__ float bf_hi(unsigned w) { return __uint_as_float(w & 0xffff0000u); }
__device__ __forceinline__ float fast_sigmoid(float x) { return __builtin_amdgcn_rcpf(1.0f + __builtin_amdgcn_exp2f(-1.4426950408889634f * x)); }

typedef f32x4 Acc[2][2][4][2];
__device__ __forceinline__ int lane_id_opaque() { int l; asm volatile("v_mbcnt_lo_u32_b32 %0, -1, 0\n\tv_mbcnt_hi_u32_b32 %0, -1, %0" : "=v"(l)); return l; }

template <class Epi, class Sched, bool F8 = false, bool ALIGN_EPI = true, bool SP2 = true, bool I8 = false, bool VARK = false, bool PEEL = true>
__device__ __forceinline__ void gemm_phase(LAS unsigned char* lds, const Gemm g, const Sched& S, const Epi& E, int wid) {
    const int lane = lane_id_opaque();
    const int tid = wid * 64 + lane, wr = wid >> 2, wc = wid & 3, fr = lane & 15, fq = lane >> 4;
    const int K = g.K, nt = K / BK, lda = g.lda;
    unsigned voffA, voffB;
    { int R, C; stage_rc(tid * 16, R, C); voffA = (unsigned)(R * lda + C) * 2u; voffB = (unsigned)(R * K + C) * 2u; }
    const size_t rstepA = (size_t)64 * lda * 2, rstepB = (size_t)64 * K * 2;
    const size_t kstep = (size_t)(BK * 2);
    const size_t hstepA = (size_t)HALF * lda * 2, hstepB = (size_t)HALF * K * 2;
    const size_t tstepA = 2 * hstepA, tstepB = 2 * hstepB;
    const unsigned ldsw = (unsigned)wid * 1024u;
    const int aoff = lds_byte(wr * 64 + fr, fq * 8), boff = lds_byte(wc * 32 + fr, fq * 8);
#define PG8_SA(b, h) (((b) * 2 + (h)) * HTB)
#define PG8_SB(b, h) ((4 + (b) * 2 + (h)) * HTB)
#define PG8_STAGE(bufoff, gbase, X) do { _Pragma("unroll") for (int _i = 0; _i < 2; ++_i) \
        __builtin_amdgcn_global_load_lds((const unsigned*)((const char*)(gbase) + _i * rstep##X + voff##X), (LAS unsigned*)(lds + (bufoff) + ldsw + _i * 8192), 16, 0, 0); } while (0)
#define PG8_LDA(dst, b, h) do { _Pragma("unroll") for (int m = 0; m < 4; ++m) _Pragma("unroll") for (int k = 0; k < 2; ++k) dst[m][k] = *(const LAS bf16x8*)(lds + PG8_SA(b, h) + aoff + m * 2048 + k * 1024); } while (0)
#define PG8_LDB(dst, b, h) do { _Pragma("unroll") for (int n = 0; n < 2; ++n) _Pragma("unroll") for (int k = 0; k < 2; ++k) dst[n][k] = *(const LAS bf16x8*)(lds + PG8_SB(b, h) + boff + n * 2048 + k * 1024); } while (0)
#define PG8_CAT8(x) __builtin_shufflevector(__builtin_bit_cast(i32x4, x[0]), __builtin_bit_cast(i32x4, x[1]), 0, 1, 2, 3, 4, 5, 6, 7)
#define PG8_MMA(ai, bj, At, Bt) do { __builtin_amdgcn_s_setprio(1); _Pragma("unroll") for (int m = 0; m < 4; ++m) _Pragma("unroll") for (int n = 0; n < 2; ++n) { \
        if constexpr (F8) acc[ai][bj][m][n] = __builtin_amdgcn_mfma_scale_f32_16x16x128_f8f6f4(PG8_CAT8(Bt[n]), PG8_CAT8(At[m]), acc[ai][bj][m][n], 0, 0, 0, 0x7F7F7F7F, 0, 0x7F7F7F7F); \
        else if constexpr (I8) { _Pragma("unroll") for (int k = 0; k < 2; ++k) acc[ai][bj][m][n] = __builtin_bit_cast(f32x4, __builtin_amdgcn_mfma_i32_16x16x64_i8(__builtin_bit_cast(i32x4, Bt[n][k]), __builtin_bit_cast(i32x4, At[m][k]), __builtin_bit_cast(i32x4, acc[ai][bj][m][n]), 0, 0, 0)); } \
        else { _Pragma("unroll") for (int k = 0; k < 2; ++k) acc[ai][bj][m][n] = __builtin_amdgcn_mfma_f32_16x16x32_bf16(Bt[n][k], At[m][k], acc[ai][bj][m][n], 0, 0, 0); } } __builtin_amdgcn_s_setprio(0); } while (0)
#define PG8_WAIT_V(n) asm volatile("s_waitcnt vmcnt(" #n ")" ::: "memory")
#define PG8_WAIT_VE asm volatile("s_waitcnt vmcnt(%0)" :: "n"(8 + Epi::NVM) : "memory")
#define PG8_WAIT_L(n) asm volatile("s_waitcnt lgkmcnt(" #n ")" ::: "memory")
#define PG8_BAR __builtin_amdgcn_s_barrier()
#define PG8_SCHED __builtin_amdgcn_sched_barrier(0)
    Unit cur, nxt; int ui = 0;
    if (!S.next(0, cur)) return;
    Acc acc;
#pragma unroll
    for (int a = 0; a < 2; ++a)
#pragma unroll
        for (int b = 0; b < 2; ++b)
#pragma unroll
            for (int m = 0; m < 4; ++m)
#pragma unroll
                for (int n = 0; n < 2; ++n) acc[a][b][m][n] = (f32x4){0.f, 0.f, 0.f, 0.f};
    bf16x8 At[4][2], B0[2][2], B1[2][2];
    const char* cA = (const char*)g.A + (size_t)cur.pm * tstepA + cur.aoff; const char* cB = (const char*)g.Bt + (size_t)cur.bt * tstepB + (VARK ? cur.boff : 0u);
    {
        PG8_STAGE(PG8_SB(0, 0), cB, B); PG8_STAGE(PG8_SB(0, 1), cB + hstepB, B); PG8_STAGE(PG8_SA(0, 0), cA, A); PG8_STAGE(PG8_SA(0, 1), cA + hstepA, A);
        if (wr == 1) PG8_BAR;
        PG8_WAIT_V(2); PG8_BAR;
        PG8_STAGE(PG8_SB(1, 0), cB + kstep, B); PG8_STAGE(PG8_SA(1, 0), cA + kstep, A); PG8_STAGE(PG8_SB(1, 1), cB + hstepB + kstep, B);
        PG8_WAIT_V(6); PG8_BAR;
    }
    for (;;) {
        const bool has_next = S.next(ui + 1, nxt);
        const char* nA = has_next ? (const char*)g.A + (size_t)nxt.pm * tstepA + nxt.aoff : cA; const char* nB = has_next ? (const char*)g.Bt + (size_t)nxt.bt * tstepB + (VARK ? nxt.boff : 0u) : cB;
        const int ntc = VARK ? cur.nt : nt;
        if constexpr (Epi::LDSSCALE) { const int l_ = lane_id_opaque(); const float* src = (wid < 4 ? E.cs_src(cur) : E.rs_src(cur) - 256) + wid * 64 + l_;
            __builtin_amdgcn_global_load_lds((const unsigned*)src, (LAS unsigned*)(lds + 8 * HTB + 4096 + (ui & 1) * 2048 + wid * 256), 4, 0, 0); }
#define PG8_TRIP(WF) do { \
            const bool last = (t == ntc - 2); \
            const char* a1 = cA + (size_t)(t + 1) * kstep; \
            const char* a2 = last ? nA : cA + (size_t)(t + 2) * kstep; const char* b2 = last ? nB : cB + (size_t)(t + 2) * kstep; \
            const char* a3 = a2 + kstep; const char* b3 = b2 + kstep; \
            if constexpr (Epi::MIDK) { if (t == Epi::MID0 || t == Epi::MID1) { const int l_ = lane_id_opaque(); E.mid(acc, cur, t, wr, wc, l_ & 15, l_ >> 4); } } \
            PG8_LDB(B0, 0, 0); PG8_LDB(B1, 0, 1); PG8_SCHED; PG8_LDA(At, 0, 0); PG8_STAGE(PG8_SA(1, 1), a1 + hstepA, A); \
            WF; PG8_WAIT_L(0); PG8_BAR; PG8_MMA(0, 0, At, B0); PG8_MMA(0, 1, At, B1); PG8_BAR; PG8_SCHED; \
            PG8_LDA(At, 0, 1); PG8_STAGE(PG8_SB(0, 0), b2, B); PG8_STAGE(PG8_SB(0, 1), b2 + hstepB, B); PG8_STAGE(PG8_SA(0, 0), a2, A); \
            WF; PG8_WAIT_L(0); PG8_BAR; PG8_MMA(1, 0, At, B0); PG8_MMA(1, 1, At, B1); PG8_BAR; PG8_SCHED; \
            PG8_LDB(B0, 1, 0); PG8_LDB(B1, 1, 1); PG8_SCHED; PG8_LDA(At, 1, 0); PG8_STAGE(PG8_SA(0, 1), a2 + hstepA, A); \
            WF; PG8_WAIT_L(0); PG8_BAR; PG8_MMA(0, 0, At, B0); PG8_MMA(0, 1, At, B1); PG8_BAR; PG8_SCHED; \
            PG8_LDA(At, 1, 1); PG8_STAGE(PG8_SB(1, 0), b3, B); PG8_STAGE(PG8_SB(1, 1), b3 + hstepB, B); PG8_STAGE(PG8_SA(1, 0), a3, A); \
            PG8_WAIT_V(8); PG8_WAIT_L(0); PG8_BAR; PG8_MMA(1, 0, At, B0); PG8_MMA(1, 1, At, B1); PG8_BAR; PG8_SCHED; } while (0)
        int t = 0;
        if constexpr (PEEL) { if (ui > 0) { PG8_TRIP(PG8_WAIT_VE); t = 2; } }
#pragma unroll 1
        for (; t < ntc; t += 2) PG8_TRIP(PG8_WAIT_V(8));
#undef PG8_TRIP
        if constexpr (ALIGN_EPI) { if (wr == 0) PG8_BAR; }
        { const int l_ = lane_id_opaque();
          if constexpr (Epi::LDSSCALE) E.run(acc, cur, wr, wc, l_ & 15, l_ >> 4, (const LAS float*)(lds + 8 * HTB + 4096 + (ui & 1) * 2048));
          else E(acc, cur, wr, wc, l_ & 15, l_ >> 4); }
        if (!has_next) break;
#pragma unroll
        for (int a = 0; a < 2; ++a)
#pragma unroll
            for (int b = 0; b < 2; ++b)
#pragma unroll
                for (int m = 0; m < 4; ++m)
#pragma unroll
                    for (int n = 0; n < 2; ++n) acc[a][b][m][n] = (f32x4){0.f, 0.f, 0.f, 0.f};
        cur = nxt; cA = nA; cB = nB; ++ui;
        if constexpr (ALIGN_EPI) { if (wr == 1) PG8_BAR; }
    }
    PG8_WAIT_V(0);
    if constexpr (!ALIGN_EPI) { if (wr == 0) PG8_BAR; }
    PG8_BAR;
#undef PG8_SA
#undef PG8_SB
#undef PG8_STAGE
#undef PG8_LDA
#undef PG8_LDB
#undef PG8_MMA
#undef PG8_CAT8
#undef PG8_WAIT_V
#undef PG8_WAIT_VE
#undef PG8_WAIT_L
#undef PG8_BAR
#undef PG8_SCHED
}
}
constexpr int BATCH = 8, SEQ = 4096, DM = 1024, MTOK = BATCH * SEQ;
constexpr int IN_COLS = 6568, IN_N = 6656;
constexpr int LAT_W = 512;
constexpr int QM_W = 768, KVM_W = 1024, UP_N = QM_W + KVM_W;
constexpr int BR_W = 512, Y3_W = 1536, GT_W = 3072;
constexpr int DFF = 2816, EFF = 3584, NEXP = 8;
constexpr int MOE_ROWS = (MTOK * 2 / 256 + NEXP) * 256;
constexpr int MOE_BLKS = MOE_ROWS / 256;
constexpr float RMS_EPS = 1e-6f;
constexpr float LOG2E = 1.4426950408889634f;
constexpr float C2_64 = 0.125f * LOG2E;
constexpr float C2_96 = 0.10206207261596577f * LOG2E;

typedef unsigned short bf16;
constexpr size_t MiB = 1u << 20;
constexpr size_t WS_CTL = 0, CTL_ZERO_BYTES = 1 * MiB;
#ifndef DENSE_DOWN_F8
#define DENSE_DOWN_F8 0
#endif
constexpr size_t WS_SMALL = 1 * MiB;
constexpr size_t OFF_SSQ = WS_SMALL;
constexpr size_t OFF_LOGF = OFF_SSQ + (size_t)MTOK * 8 * 4;
constexpr size_t OFF_CUM = OFF_LOGF + (size_t)MTOK * 8 * 4;
constexpr size_t OFF_KMEAN = OFF_CUM + (size_t)MTOK * 8 * 4;
constexpr size_t OFF_R64C = OFF_KMEAN + (size_t)BATCH * 16 * 512 * 4;
constexpr size_t OFF_R64S = OFF_R64C + (size_t)MTOK * 32 * 4;
constexpr size_t OFF_R32C = OFF_R64S + (size_t)MTOK * 32 * 4;
constexpr size_t OFF_R32S = OFF_R32C + (size_t)MTOK * 16 * 4;
constexpr size_t OFF_TOKI = OFF_R32S + (size_t)MTOK * 16 * 4;
constexpr size_t OFF_TOKW = OFF_TOKI + (size_t)MTOK * 16;
constexpr size_t OFF_TOKR = OFF_TOKW + (size_t)MTOK * 8;
constexpr size_t OFF_CNT = OFF_TOKR + (size_t)MTOK * 8;
constexpr size_t OFF_MTAB = OFF_CNT + 256 * 8 * 4;
constexpr size_t OFF_KNM = OFF_MTAB + 512 * 4;
constexpr size_t OFF_RSX = OFF_KNM + 256;
constexpr size_t OFF_RSG = OFF_RSX + (size_t)MTOK * 4;
constexpr size_t OFF_CSC = OFF_RSG + (size_t)MOE_ROWS * 4;
constexpr size_t OFF_CSIN = OFF_CSC + (size_t)2 * DFF * 4;
constexpr size_t OFF_RSIN = OFF_CSIN + (size_t)2 * IN_N * 4;
constexpr size_t OFF_CSE = OFF_RSIN + (size_t)MTOK * 4;
constexpr size_t OFF_WPRE = OFF_CSE + (size_t)8 * 2 * EFF * 4;
constexpr size_t OFF_SMALL_END = OFF_WPRE + (size_t)256 * 8 * 8 * 4;
constexpr size_t WS_W = 20 * MiB;
constexpr size_t W_IN_E = (size_t)IN_N * DM, W_UP_E = (size_t)UP_N * 256, W_BR_E = (size_t)DM * Y3_W, W_OUT_E = (size_t)DM * DM;
constexpr size_t W_LAYER_E = W_IN_E + W_UP_E + W_BR_E + W_OUT_E;
constexpr size_t OFF_WL = WS_W;
constexpr size_t OFF_WDGU = OFF_WL + 2 * W_LAYER_E * 2;
constexpr size_t OFF_WDDN = OFF_WDGU + (size_t)2 * DFF * DM * 2;
constexpr size_t OFF_WEGU = OFF_WDDN + (size_t)DM * DFF * 2;
constexpr size_t OFF_WEDN = OFF_WEGU + (size_t)NEXP * 2 * EFF * DM;
constexpr size_t OFF_W_END = OFF_WEDN + (size_t)NEXP * DM * EFF;
constexpr float W8S_GU = 1024.0f, W8S_DN = 2048.0f, A8S_ACT = 8.0f, A8_ROWMAX = 384.0f;
constexpr size_t WS_ACT = ((OFF_W_END + MiB - 1) / MiB) * MiB;
constexpr size_t OFF_XN = WS_ACT;
constexpr size_t OFF_QM = OFF_XN;
constexpr size_t OFF_LAT = OFF_XN + (size_t)MTOK * DM * 2;
constexpr size_t OFF_KR = OFF_LAT + (size_t)MTOK * LAT_W * 2;
constexpr size_t OFF_FQ = OFF_KR + (size_t)MTOK * 32 * 2;
constexpr size_t OFF_FK = OFF_FQ + (size_t)MTOK * BR_W * 2, OFF_FV = OFF_FK + (size_t)MTOK * BR_W * 2;
constexpr size_t OFF_MQ = OFF_FV + (size_t)MTOK * BR_W * 2, OFF_MK = OFF_MQ + (size_t)MTOK * BR_W * 2, OFF_MV = OFF_MK + (size_t)MTOK * BR_W * 2;
constexpr size_t OFF_GT = OFF_MV + (size_t)MTOK * BR_W * 2;
constexpr size_t OFF_KVM = OFF_GT + (size_t)MTOK * GT_W * 2;
constexpr size_t OFF_MERGED = OFF_KVM;
constexpr size_t OFF_Y3 = OFF_KVM + (size_t)MTOK * KVM_W * 2;
constexpr size_t OFF_XN8 = OFF_Y3;
constexpr size_t OFF_XS = OFF_Y3 + (size_t)MTOK * Y3_W * 2;
constexpr size_t OFF_ACT_END = OFF_XS + (size_t)MTOK * DM * 2;
constexpr size_t OFF_ACTD = OFF_LAT;
constexpr size_t OFF_XG = OFF_LAT;
constexpr size_t OFF_ACTM = OFF_XG + (size_t)MOE_ROWS * DM;
constexpr size_t OFF_YE = OFF_ACTM + (size_t)MOE_ROWS * EFF;
constexpr size_t OFF_MOE_END = OFF_YE + (size_t)MOE_ROWS * DM * 2;
constexpr size_t WS_NEED = OFF_ACT_END;
static_assert(OFF_SMALL_END <= WS_W, "small tables");
static_assert(OFF_ACTD + (size_t)MTOK * DFF * 2 <= OFF_KVM, "dense hidden overlay must not reach MERGED");
static_assert(OFF_MOE_END <= OFF_XN8, "MoE buffers must not reach XN8 (the gather reads it)");
constexpr int CW_BAR = 4096;

namespace pg8 {
struct EpiIn {
    static constexpr bool LDSSCALE = true; static constexpr bool MIDK = false; static constexpr int MID0 = -1, MID1 = -1; static constexpr int NVM = 16;
    unsigned char* ws; const float* bfg; const float* CS;
    __device__ __forceinline__ const float* cs_src(const Unit& u) const { return CS + u.pn * BM; }
    __device__ __forceinline__ const float* rs_src(const Unit& u) const { return (const float*)(ws + OFF_RSIN) + u.pm * BM; }
    __device__ __forceinline__ void run(Acc& acc, const Unit& u, int wr, int wc, int fr, int fq, const LAS float* sl) const {
        unsigned char* w = ws; asm volatile("" : "+s"(w));
        { f32x4 cs[2][2];
#pragma unroll
            for (int bj = 0; bj < 2; ++bj)
#pragma unroll
                for (int n = 0; n < 2; ++n) cs[bj][n] = *(const LAS f32x4*)(sl + bj * HALF + wc * 32 + 16 * n + 4 * fq);
#pragma unroll
            for (int ai = 0; ai < 2; ++ai)
#pragma unroll
                for (int m = 0; m < 4; ++m) { const float rs = sl[256 + wr * 64 + fr + ai * HALF + m * 16];
#pragma unroll
                    for (int bj = 0; bj < 2; ++bj)
#pragma unroll
                        for (int n = 0; n < 2; ++n) { const i32x4 iv = __builtin_bit_cast(i32x4, acc[ai][bj][m][n]);
                            acc[ai][bj][m][n] = (f32x4){(float)iv[0], (float)iv[1], (float)iv[2], (float)iv[3]} * (cs[bj][n] * rs); } } }
        bf16_t* LAT = (bf16_t*)(w + OFF_LAT); bf16_t* KR = (bf16_t*)(w + OFF_KR); bf16_t* FQ = (bf16_t*)(w + OFF_FQ); bf16_t* GT = (bf16_t*)(w + OFF_GT);
        float* LOGF = (float*)(w + OFF_LOGF); float* SSQ = (float*)(w + OFF_SSQ);
        const float* R64C = (const float*)(w + OFF_R64C); const float* R64S = (const float*)(w + OFF_R64S); const float* R32C = (const float*)(w + OFF_R32C); const float* R32S = (const float*)(w + OFF_R32S);
        const int pn = u.pn; const int row0 = u.pm * BM + wr * 64 + fr;
        if (pn == 0) {
#pragma unroll
            for (int ai = 0; ai < 2; ++ai)
#pragma unroll
                for (int m = 0; m < 4; ++m) { const int row = row0 + ai * HALF + m * 16; float s = 0.f;
#pragma unroll
                    for (int bj = 0; bj < 2; ++bj) { const f32x4 v0 = acc[ai][bj][m][0], v1 = acc[ai][bj][m][1];
                        s += (v0[0] * v0[0] + v0[1] * v0[1]) + (v0[2] * v0[2] + v0[3] * v0[3]) + (v1[0] * v1[0] + v1[1] * v1[1]) + (v1[2] * v1[2] + v1[3] * v1[3]);
                        *(u32x4*)(LAT + (size_t)row * LAT_W + bj * HALF + wc * 32 + 8 * fq) = pack8(v0, v1); }
                    s += __shfl_xor(s, 16); s += __shfl_xor(s, 32);
                    if (fq == 0) SSQ[(size_t)row * 8 + wc] = s; asm volatile("" ::: "memory"); }
        } else if (pn == 1) {
#pragma unroll
            for (int ai = 0; ai < 2; ++ai)
#pragma unroll
                for (int m = 0; m < 4; ++m) { const int row = row0 + ai * HALF + m * 16;
                    { const f32x4 v0 = acc[ai][0][m][0], v1 = acc[ai][0][m][1];
                      float s = (v0[0] * v0[0] + v0[1] * v0[1]) + (v0[2] * v0[2] + v0[3] * v0[3]) + (v1[0] * v1[0] + v1[1] * v1[1]) + (v1[2] * v1[2] + v1[3] * v1[3]);
                      *(u32x4*)(LAT + (size_t)row * LAT_W + 256 + wc * 32 + 8 * fq) = pack8(v0, v1);
                      s += __shfl_xor(s, 16); s += __shfl_xor(s, 32);
                      if (fq == 0) SSQ[(size_t)row * 8 + 4 + wc] = s; }
                    *(u32x4*)(LAT + (size_t)row * LAT_W + 384 + wc * 32 + 8 * fq) = (u32x4){0u, 0u, 0u, 0u};
                    if (wc == 0) {
                        const f32x4 x1 = acc[ai][1][m][0], x2 = acc[ai][1][m][1];
                        const f32x4 c = *(const f32x4*)(R32C + (size_t)row * 16 + 4 * fq), s = *(const f32x4*)(R32S + (size_t)row * 16 + 4 * fq);
                        *(u32x2*)(KR + (size_t)row * 32 + 4 * fq) = pack4(x1 * c - x2 * s);
                        *(u32x2*)(KR + (size_t)row * 32 + 16 + 4 * fq) = pack4(x2 * c + x1 * s);
                    } else if (wc == 1 && fq < 2) {
                        const f32x4 z = acc[ai][1][m][0] + *(const f32x4*)(bfg + 4 * fq); f32x4 o;
#pragma unroll
                        for (int j = 0; j < 4; ++j) o[j] = fminf(z[j], 0.f) - log1pf(__expf(-fabsf(z[j])));
                        *(f32x4*)(LOGF + (size_t)row * 8 + 4 * fq) = o; }
                    asm volatile("" ::: "memory"); }
        } else if (pn >= 8 && pn < 12) {
            bf16_t* dst = FQ + (size_t)(3 + ((pn - 8) >> 1)) * ((size_t)MTOK * BR_W); const float sc = (pn < 10) ? C2_64 : 1.0f; const int colt = ((pn - 8) & 1) * 256;
            const int i0 = 16 * (wc & 1) + 4 * fq;
#pragma unroll
            for (int ai = 0; ai < 2; ++ai)
#pragma unroll
                for (int m = 0; m < 4; ++m) { const int row = row0 + ai * HALF + m * 16;
                    const f32x4 c = *(const f32x4*)(R64C + (size_t)row * 32 + i0) * sc, s = *(const f32x4*)(R64S + (size_t)row * 32 + i0) * sc;
#pragma unroll
                    for (int bj = 0; bj < 2; ++bj) { const f32x4 x1 = acc[ai][bj][m][0], x2 = acc[ai][bj][m][1];
                        bf16_t* p = dst + (size_t)row * BR_W + colt + (2 * bj + (wc >> 1)) * 64 + i0;
                        *(u32x2*)p = pack4(x1 * c - x2 * s); *(u32x2*)(p + 32) = pack4(x2 * c + x1 * s); } asm volatile("" ::: "memory"); }
        } else {
            bf16_t* dst; int pitch, colt; float sc = 1.0f; const bool sig = pn >= 14;
            if (!sig) { const int bi = (pn - 2) >> 1; dst = FQ + (size_t)bi * ((size_t)MTOK * BR_W); pitch = BR_W; colt = (pn & 1) * 256; if (pn < 4) sc = C2_64; }
            else { dst = GT; pitch = GT_W; colt = (pn - 14) * 256; }
#pragma unroll
            for (int ai = 0; ai < 2; ++ai)
#pragma unroll
                for (int m = 0; m < 4; ++m) { const int row = row0 + ai * HALF + m * 16;
#pragma unroll
                    for (int bj = 0; bj < 2; ++bj) { f32x4 v0 = acc[ai][bj][m][0], v1 = acc[ai][bj][m][1];
                        if (sig) {
#pragma unroll
                            for (int j = 0; j < 4; ++j) { v0[j] = fmaxf(fast_sigmoid(v0[j]), 1e-7f); v1[j] = fmaxf(fast_sigmoid(v1[j]), 1e-7f); }
                        } else { v0 = v0 * sc; v1 = v1 * sc; }
                        __builtin_nontemporal_store(pack8(v0, v1), (u32x4*)(dst + (size_t)row * pitch + colt + bj * HALF + wc * 32 + 8 * fq)); } }
        }
    }
};

struct EpiUp {
    static constexpr bool LDSSCALE = false; static constexpr bool MIDK = false; static constexpr int MID0 = -1, MID1 = -1; static constexpr int NVM = 16;
    unsigned char* ws;
    __device__ __forceinline__ void operator()(const Acc& acc, const Unit& u, int wr, int wc, int fr, int fq) const {
        unsigned char* w = ws; asm volatile("" : "+s"(w));
        bf16_t* QM = (bf16_t*)(w + OFF_QM); bf16_t* KVM = (bf16_t*)(w + OFF_KVM); const float* SSQ = (const float*)(w + OFF_SSQ); const float* R32C = (const float*)(w + OFF_R32C); const float* R32S = (const float*)(w + OFF_R32S);
        const int pn = u.pn; const int row0 = u.pm * BM + wr * 64 + fr; const bool isq = pn < 3;
#pragma unroll
        for (int ai = 0; ai < 2; ++ai)
#pragma unroll
            for (int m = 0; m < 4; ++m) { const int row = row0 + ai * HALF + m * 16;
                const f32x4 ss = *(const f32x4*)(SSQ + (size_t)row * 8 + (isq ? 0 : 4));
                const float tot = (ss[0] + ss[1]) + (ss[2] + ss[3]);
                const float r = isq ? rsqrtf(tot * (1.0f / 256.0f) + RMS_EPS) * C2_96 : rsqrtf(tot * (1.0f / 128.0f) + RMS_EPS);
#pragma unroll
                for (int bj = 0; bj < 2; ++bj) { const f32x4 v0 = acc[ai][bj][m][0] * r, v1 = acc[ai][bj][m][1] * r;
                    if (isq) { const int g = 8 * pn + 4 * bj + wc;
                        if (g % 3 == 2) { const f32x4 c = *(const f32x4*)(R32C + (size_t)row * 16 + 4 * fq), s = *(const f32x4*)(R32S + (size_t)row * 16 + 4 * fq);
                            bf16_t* p = QM + (size_t)row * QM_W + g * 32 + 4 * fq;
                            *(u32x2*)p = pack4(v0 * c - v1 * s); *(u32x2*)(p + 16) = pack4(v1 * c + v0 * s);
                        } else __builtin_nontemporal_store(pack8(v0, v1), (u32x4*)(QM + (size_t)row * QM_W + g * 32 + 8 * fq));
                    } else __builtin_nontemporal_store(pack8(v0, v1), (u32x4*)(KVM + (size_t)row * KVM_W + (pn - 3) * 256 + bj * HALF + wc * 32 + 8 * fq)); } asm volatile("" ::: "memory"); }
    }
};

struct EpiMerge {
    static constexpr bool LDSSCALE = false; static constexpr bool MIDK = true; static constexpr int MID0 = 8, MID1 = 16; static constexpr int NVM = 16;
    const bf16_t* GT; bf16_t* OUT;
    __device__ __forceinline__ void mid(Acc& acc, const Unit& u, int t, int wr, int wc, int fr, int fq) const {
        const int nb = (t == MID0) ? 0 : 1; const bf16_t* gbase = GT + (size_t)(u.pm * BM + wr * 64 + fr) * GT_W + nb * DM + u.pn * BM + wc * 32 + 8 * fq;
#pragma unroll
        for (int ai = 0; ai < 2; ++ai) { u32x4 ga[4][2], gb[4][2];
#pragma unroll
            for (int m = 0; m < 4; ++m)
#pragma unroll
                for (int bj = 0; bj < 2; ++bj) { const bf16_t* gp = gbase + (size_t)(ai * HALF + m * 16) * GT_W + bj * HALF; ga[m][bj] = *(const u32x4*)gp; gb[m][bj] = *(const u32x4*)(gp + DM); }
#pragma unroll
            for (int m = 0; m < 4; ++m) {
#pragma unroll
                for (int bj = 0; bj < 2; ++bj)
#pragma unroll
                    for (int j = 0; j < 4; ++j) { const unsigned wa = ga[m][bj][j], wb = gb[m][bj][j]; const int n = j >> 1, e = (j & 1) * 2;
                        acc[ai][bj][m][n][e] *= bf_lo(wa) * __builtin_amdgcn_rcpf(bf_lo(wb)); acc[ai][bj][m][n][e + 1] *= bf_hi(wa) * __builtin_amdgcn_rcpf(bf_hi(wb)); }
                asm volatile("" : "+v"(acc[ai][0][m][0]), "+v"(acc[ai][0][m][1]), "+v"(acc[ai][1][m][0]), "+v"(acc[ai][1][m][1])); }
            asm volatile("" ::: "memory"); }
    }
    __device__ __forceinline__ void operator()(const Acc& acc, const Unit& u, int wr, int wc, int fr, int fq) const {
        const int row0 = u.pm * BM + wr * 64 + fr; const int col0 = u.pn * BM + wc * 32 + 8 * fq;
#pragma unroll
        for (int ai = 0; ai < 2; ++ai) { u32x4 g[4][2];
#pragma unroll
            for (int m = 0; m < 4; ++m)
#pragma unroll
                for (int bj = 0; bj < 2; ++bj) g[m][bj] = *(const u32x4*)(GT + (size_t)(row0 + ai * HALF + m * 16) * GT_W + 2 * DM + col0 + bj * HALF);
#pragma unroll
            for (int m = 0; m < 4; ++m) { const int row = row0 + ai * HALF + m * 16;
#pragma unroll
                for (int bj = 0; bj < 2; ++bj) { const u32x4 gg = g[m][bj]; f32x4 v0 = acc[ai][bj][m][0], v1 = acc[ai][bj][m][1];
                    v0[0] *= bf_lo(gg[0]); v0[1] *= bf_hi(gg[0]); v0[2] *= bf_lo(gg[1]); v0[3] *= bf_hi(gg[1]); v1[0] *= bf_lo(gg[2]); v1[1] *= bf_hi(gg[2]); v1[2] *= bf_lo(gg[3]); v1[3] *= bf_hi(gg[3]);
                    *(u32x4*)(OUT + (size_t)row * DM + col0 + bj * HALF) = pack8(v0, v1); } }
            asm volatile("" ::: "memory"); }
    }
};

struct EpiResid {
    static constexpr bool LDSSCALE = false; static constexpr bool MIDK = false; static constexpr int MID0 = -1, MID1 = -1; static constexpr int NVM = 0;
    const float* base; float* out;
    __device__ __forceinline__ void operator()(const Acc& acc, const Unit& u, int wr, int wc, int fr, int fq) const {
        const int row0 = u.pm * BM + wr * 64 + fr; const int col0 = u.pn * BM + wc * 32 + 4 * fq;
#pragma unroll
        for (int ai = 0; ai < 2; ++ai)
#pragma unroll
            for (int m = 0; m < 4; ++m) { const size_t off = (size_t)(row0 + ai * HALF + m * 16) * DM + col0;
#pragma unroll
                for (int bj = 0; bj < 2; ++bj)
#pragma unroll
                    for (int n = 0; n < 2; ++n) { const f32x4 b = *(const f32x4*)(base + off + bj * HALF + n * 16); *(f32x4*)(out + off + bj * HALF + n * 16) = b + acc[ai][bj][m][n]; } asm volatile("" ::: "memory"); }
    }
};

template <bool BASE32> struct EpiResidB {
    static constexpr bool LDSSCALE = false; static constexpr bool MIDK = false; static constexpr int MID0 = -1, MID1 = -1; static constexpr int NVM = 16;
    const void* base; bf16_t* out; float sc;
    __device__ __forceinline__ void operator()(const Acc& acc, const Unit& u, int wr, int wc, int fr, int fq) const {
        const size_t off0 = (size_t)(u.pm * BM + wr * 64 + fr) * DM + u.pn * BM + wc * 32 + 8 * fq;
        if constexpr (BASE32) {
#pragma unroll
            for (int ai = 0; ai < 2; ++ai) { f32x4 b[4][2][2];
#pragma unroll
                for (int m = 0; m < 4; ++m)
#pragma unroll
                    for (int bj = 0; bj < 2; ++bj) { const float* bp = (const float*)base + off0 + (size_t)(ai * HALF + m * 16) * DM + bj * HALF; b[m][bj][0] = *(const f32x4*)bp; b[m][bj][1] = *(const f32x4*)(bp + 4); }
#pragma unroll
                for (int m = 0; m < 4; ++m)
#pragma unroll
                    for (int bj = 0; bj < 2; ++bj) *(u32x4*)(out + off0 + (size_t)(ai * HALF + m * 16) * DM + bj * HALF) = pack8(b[m][bj][0] + acc[ai][bj][m][0] * sc, b[m][bj][1] + acc[ai][bj][m][1] * sc);
                asm volatile("" ::: "memory"); }
        } else {
            u32x4 w[2][4][2];
#pragma unroll
            for (int ai = 0; ai < 2; ++ai)
#pragma unroll
                for (int m = 0; m < 4; ++m)
#pragma unroll
                    for (int bj = 0; bj < 2; ++bj) w[ai][m][bj] = *(const u32x4*)((const bf16_t*)base + off0 + (size_t)(ai * HALF + m * 16) * DM + bj * HALF);
            asm volatile("" ::: "memory");
#pragma unroll
            for (int ai = 0; ai < 2; ++ai)
#pragma unroll
                for (int m = 0; m < 4; ++m) {
#pragma unroll
                    for (int bj = 0; bj < 2; ++bj) { const u32x4 ww = w[ai][m][bj]; const f32x4 b0 = {bf_lo(ww.x), bf_hi(ww.x), bf_lo(ww.y), bf_hi(ww.y)}, b1 = {bf_lo(ww.z), bf_hi(ww.z), bf_lo(ww.w), bf_hi(ww.w)};
                        *(u32x4*)(out + off0 + (size_t)(ai * HALF + m * 16) * DM + bj * HALF) = pack8(b0 + acc[ai][bj][m][0] * sc, b1 + acc[ai][bj][m][1] * sc); }
                    asm volatile("" ::: "memory"); }
        }
    }
};
struct EpiSwiglu {
    static constexpr bool LDSSCALE = false; static constexpr bool MIDK = false; static constexpr int MID0 = -1, MID1 = -1; static constexpr int NVM = 0;
    bf16_t* ACT; int pitch;
    __device__ __forceinline__ void operator()(const Acc& acc, const Unit& u, int wr, int wc, int fr, int fq) const {
        const int row0 = u.pm * BM + wr * 64 + fr; const int col = u.pn * HALF + wc * 32 + 8 * fq;
#pragma unroll
        for (int ai = 0; ai < 2; ++ai)
#pragma unroll
            for (int m = 0; m < 4; ++m) { f32x4 o[2];
#pragma unroll
                for (int n = 0; n < 2; ++n)
#pragma unroll
                    for (int j = 0; j < 4; ++j) { const float gv = acc[ai][0][m][n][j], uv = acc[ai][1][m][n][j]; o[n][j] = gv * fast_sigmoid(gv) * uv; }
                *(u32x4*)(ACT + (size_t)(row0 + ai * HALF + m * 16) * pitch + col) = pack8(o[0], o[1]); }
    }
};

struct EpiSwigluB8 {
    static constexpr bool LDSSCALE = false; static constexpr bool MIDK = false; static constexpr int MID0 = -1, MID1 = -1; static constexpr int NVM = 0;
    unsigned char* ACT; int pitch;
    __device__ __forceinline__ void operator()(const Acc& acc, const Unit& u, int wr, int wc, int fr, int fq) const {
        const int row0 = u.pm * BM + wr * 64 + fr; const int col = u.pn * HALF + wc * 32 + 8 * fq;
#pragma unroll
        for (int ai = 0; ai < 2; ++ai)
#pragma unroll
            for (int m = 0; m < 4; ++m) { float o[8];
#pragma unroll
                for (int n = 0; n < 2; ++n)
#pragma unroll
                    for (int j = 0; j < 4; ++j) { const float gv = acc[ai][0][m][n][j], uv = acc[ai][1][m][n][j]; o[4 * n + j] = gv * fast_sigmoid(gv) * uv * A8S_ACT; }
                u32x2 w; w.x = pk4_f8(o[0], o[1], o[2], o[3]); w.y = pk4_f8(o[4], o[5], o[6], o[7]);
                *(u32x2*)(ACT + (size_t)(row0 + ai * HALF + m * 16) * pitch + col) = w; }
    }
};
struct SwigluI8Core {
    __device__ static __forceinline__ f32x2 pair(int g0, int g1, int u0, int u1, f32x2 cg, f32x2 cu, float a, float irs2) {
        const f32x2 t = (f32x2){(float)g0, (float)g1} * cg, w = (f32x2){(float)u0, (float)u1} * cu, ar = t * (f32x2){a, a};
        const f32x2 e = {__builtin_amdgcn_exp2f(ar.x), __builtin_amdgcn_exp2f(ar.y)};
        const f32x2 d = e * (f32x2){irs2, irs2} + (f32x2){irs2, irs2};
        const f32x2 r = {__builtin_amdgcn_rcpf(d.x), __builtin_amdgcn_rcpf(d.y)};
        return (t * w) * r; }
};
struct EpiSwigluI8 {
    static constexpr bool LDSSCALE = true; static constexpr bool MIDK = false; static constexpr int MID0 = -1, MID1 = -1; static constexpr int NVM = 8;
    unsigned char* ACT; int pitch; const float* RS; const float* CS;
    __device__ __forceinline__ const float* cs_src(const Unit& u) const { return CS + u.bt * BM; }
    __device__ __forceinline__ const float* rs_src(const Unit& u) const { return RS + u.pm * BM; }
    __device__ __forceinline__ void run(const Acc& acc, const Unit& u, int wr, int wc, int fr, int fq, const LAS float* sl) const {
        const int row0 = u.pm * BM + wr * 64 + fr; const int col = u.pn * HALF + wc * 32 + 8 * fq;
        f32x4 cg[2], cu[2]; float rsv[8];
#pragma unroll
        for (int n = 0; n < 2; ++n) { cg[n] = *(const LAS f32x4*)(sl + wc * 32 + 16 * n + 4 * fq); cu[n] = *(const LAS f32x4*)(sl + HALF + wc * 32 + 16 * n + 4 * fq) * A8S_ACT; }
#pragma unroll
        for (int i = 0; i < 8; ++i) rsv[i] = sl[256 + wr * 64 + fr + (i >> 2) * HALF + (i & 3) * 16];
#pragma unroll
        for (int ai = 0; ai < 2; ++ai)
#pragma unroll
            for (int m = 0; m < 4; ++m) { const int row = row0 + ai * HALF + m * 16; const float rs = rsv[ai * 4 + m]; const float a = rs * -1.4426950408889634f, irs2 = __builtin_amdgcn_rcpf(rs * rs); u32x2 w;
#pragma unroll
                for (int n = 0; n < 2; ++n) { const i32x4 ig = __builtin_bit_cast(i32x4, acc[ai][0][m][n]), iu = __builtin_bit_cast(i32x4, acc[ai][1][m][n]);
                    const f32x2 o0 = SwigluI8Core::pair(ig[0], ig[1], iu[0], iu[1], (f32x2){cg[n][0], cg[n][1]}, (f32x2){cu[n][0], cu[n][1]}, a, irs2);
                    const f32x2 o1 = SwigluI8Core::pair(ig[2], ig[3], iu[2], iu[3], (f32x2){cg[n][2], cg[n][3]}, (f32x2){cu[n][2], cu[n][3]}, a, irs2);
                    w[n] = pk4_f8(o0.x, o0.y, o1.x, o1.y); }
                *(u32x2*)(ACT + (size_t)row * pitch + col) = w; asm volatile("" ::: "memory"); }
    }
};
struct EpiSwigluI8B {
    static constexpr bool LDSSCALE = true; static constexpr bool MIDK = false; static constexpr int MID0 = -1, MID1 = -1; static constexpr int NVM = 8;
    bf16_t* ACT; int pitch; const float* RS; const float* CS;
    __device__ __forceinline__ const float* cs_src(const Unit& u) const { return CS + u.bt * BM; }
    __device__ __forceinline__ const float* rs_src(const Unit& u) const { return RS + u.pm * BM; }
    __device__ __forceinline__ void run(const Acc& acc, const Unit& u, int wr, int wc, int fr, int fq, const LAS float* sl) const {
        const int row0 = u.pm * BM + wr * 64 + fr; const int col = u.pn * HALF + wc * 32 + 8 * fq;
        f32x4 cg[2], cu[2]; float rsv[8];
#pragma unroll
        for (int n = 0; n < 2; ++n) { cg[n] = *(const LAS f32x4*)(sl + wc * 32 + 16 * n + 4 * fq); cu[n] = *(const LAS f32x4*)(sl + HALF + wc * 32 + 16 * n + 4 * fq); }
#pragma unroll
        for (int i = 0; i < 8; ++i) rsv[i] = sl[256 + wr * 64 + fr + (i >> 2) * HALF + (i & 3) * 16];
#pragma unroll
        for (int ai = 0; ai < 2; ++ai)
#pragma unroll
            for (int m = 0; m < 4; ++m) { const int row = row0 + ai * HALF + m * 16; const float rs = rsv[ai * 4 + m]; const float a = rs * -1.4426950408889634f, irs2 = __builtin_amdgcn_rcpf(rs * rs); f32x4 o[2];
#pragma unroll
                for (int n = 0; n < 2; ++n) { const i32x4 ig = __builtin_bit_cast(i32x4, acc[ai][0][m][n]), iu = __builtin_bit_cast(i32x4, acc[ai][1][m][n]);
                    const f32x2 o0 = SwigluI8Core::pair(ig[0], ig[1], iu[0], iu[1], (f32x2){cg[n][0], cg[n][1]}, (f32x2){cu[n][0], cu[n][1]}, a, irs2);
                    const f32x2 o1 = SwigluI8Core::pair(ig[2], ig[3], iu[2], iu[3], (f32x2){cg[n][2], cg[n][3]}, (f32x2){cu[n][2], cu[n][3]}, a, irs2);
                    o[n] = (f32x4){o0.x, o0.y, o1.x, o1.y}; }
                *(u32x4*)(ACT + (size_t)row * pitch + col) = pack8(o[0], o[1]); asm volatile("" ::: "memory"); }
    }
};
struct EpiSwiglu8 {
    static constexpr bool LDSSCALE = false; static constexpr bool MIDK = false; static constexpr int MID0 = -1, MID1 = -1; static constexpr int NVM = 0;
    unsigned char* ACT; int pitch; const float* RS;
    __device__ __forceinline__ void operator()(const Acc& acc, const Unit& u, int wr, int wc, int fr, int fq) const {
        const int row0 = u.pm * BM + wr * 64 + fr; const int col = u.pn * HALF + wc * 32 + 8 * fq;
        float rsv[8];
#pragma unroll
        for (int i = 0; i < 8; ++i) rsv[i] = RS[row0 + (i >> 2) * HALF + (i & 3) * 16];
#pragma unroll
        for (int ai = 0; ai < 2; ++ai)
#pragma unroll
            for (int m = 0; m < 4; ++m) { const int row = row0 + ai * HALF + m * 16; const float rs = rsv[ai * 4 + m] * (1.0f / W8S_GU); float o[8];
#pragma unroll
                for (int n = 0; n < 2; ++n)
#pragma unroll
                    for (int j = 0; j < 4; ++j) { const float gv = acc[ai][0][m][n][j] * rs, uv = acc[ai][1][m][n][j] * rs; o[4 * n + j] = gv * fast_sigmoid(gv) * uv * A8S_ACT; }
                u32x2 w; w.x = pk4_f8(o[0], o[1], o[2], o[3]); w.y = pk4_f8(o[4], o[5], o[6], o[7]);
                *(u32x2*)(ACT + (size_t)row * pitch + col) = w; asm volatile("" ::: "memory"); }
    }
};
struct EpiNull {
    static constexpr bool LDSSCALE = false; static constexpr bool MIDK = false; static constexpr int MID0 = -1, MID1 = -1; static constexpr int NVM = 0;
    __device__ __forceinline__ void operator()(const Acc& acc, const Unit& u, int wr, int wc, int fr, int fq) const {
#pragma unroll
        for (int a = 0; a < 2; ++a)
#pragma unroll
            for (int b = 0; b < 2; ++b)
#pragma unroll
                for (int m = 0; m < 4; ++m)
#pragma unroll
                    for (int n = 0; n < 2; ++n) asm volatile("" :: "v"(acc[a][b][m][n]));
    }
};
struct EpiResid8 {
    static constexpr bool LDSSCALE = false; static constexpr bool MIDK = false; static constexpr int MID0 = -1, MID1 = -1; static constexpr int NVM = 0;
    const float* base; float* out; float sc;
    __device__ __forceinline__ void operator()(const Acc& acc, const Unit& u, int wr, int wc, int fr, int fq) const {
        const int row0 = u.pm * BM + wr * 64 + fr; const int col0 = u.pn * BM + wc * 32 + 4 * fq;
#pragma unroll
        for (int ai = 0; ai < 2; ++ai)
#pragma unroll
            for (int m = 0; m < 4; ++m) { const size_t off = (size_t)(row0 + ai * HALF + m * 16) * DM + col0;
#pragma unroll
                for (int bj = 0; bj < 2; ++bj)
#pragma unroll
                    for (int n = 0; n < 2; ++n) { const f32x4 b = *(const f32x4*)(base + off + bj * HALF + n * 16); *(f32x4*)(out + off + bj * HALF + n * 16) = b + acc[ai][bj][m][n] * sc; } asm volatile("" ::: "memory"); }
    }
};
struct EpiBf8 {
    static constexpr bool LDSSCALE = false; static constexpr bool MIDK = false; static constexpr int MID0 = -1, MID1 = -1; static constexpr int NVM = 16;
    bf16_t* OUT; int pitch; float sc;
    __device__ __forceinline__ void operator()(const Acc& acc, const Unit& u, int wr, int wc, int fr, int fq) const {
        const int row0 = u.pm * BM + wr * 64 + fr;
#pragma unroll
        for (int ai = 0; ai < 2; ++ai)
#pragma unroll
            for (int m = 0; m < 4; ++m)
#pragma unroll
                for (int bj = 0; bj < 2; ++bj) *(u32x4*)(OUT + (size_t)(row0 + ai * HALF + m * 16) * pitch + u.pn * BM + bj * HALF + wc * 32 + 8 * fq) = pack8(acc[ai][bj][m][0] * sc, acc[ai][bj][m][1] * sc);
    }
};
struct EpiBf8K {
    static constexpr bool LDSSCALE = false; static constexpr bool MIDK = false; static constexpr int MID0 = -1, MID1 = -1; static constexpr int NVM = 16;
    bf16_t* OUT; float* PART; float sc;
    __device__ __forceinline__ void operator()(const Acc& acc, const Unit& u, int wr, int wc, int fr, int fq) const {
        const int r0 = wr * 64 + fr; const int col = u.pn * BM + wc * 32 + 8 * fq;
        if (u.ks < 0) {
#pragma unroll
            for (int ai = 0; ai < 2; ++ai)
#pragma unroll
                for (int m = 0; m < 4; ++m)
#pragma unroll
                    for (int bj = 0; bj < 2; ++bj) *(u32x4*)(OUT + (size_t)(u.pm * BM + r0 + ai * HALF + m * 16) * DM + col + bj * HALF) = pack8(acc[ai][bj][m][0] * sc, acc[ai][bj][m][1] * sc);
        } else { float* pb = PART + (size_t)(((u.pm - 256) * 7 + u.ks) * 256 + r0) * DM + col;
#pragma unroll
            for (int ai = 0; ai < 2; ++ai)
#pragma unroll
                for (int m = 0; m < 4; ++m)
#pragma unroll
                    for (int bj = 0; bj < 2; ++bj) { float* q = pb + (size_t)(ai * HALF + m * 16) * DM + bj * HALF; *(f32x4*)q = acc[ai][bj][m][0] * sc; *(f32x4*)(q + 4) = acc[ai][bj][m][1] * sc; } }
    }
};
}
namespace att {
using bf16 = __hip_bfloat16;
using bf16x8 = __attribute__((ext_vector_type(8))) short;
using s16x4 = __attribute__((ext_vector_type(4))) short;
using f32x16 = __attribute__((ext_vector_type(16))) float;
using f32x4 = __attribute__((ext_vector_type(4))) float;
using f32x2 = __attribute__((ext_vector_type(2))) float;
using u32x4 = __attribute__((ext_vector_type(4))) unsigned;
typedef LAS const char* lds_cptr;
typedef LAS char* lds_ptr;
constexpr int NW = 8, QBLK = 32, QB = QBLK * NW, KVBLK = 64, NQB = SEQ / QB, NSLOT = 3;
constexpr int KSLOT = 12288, VSLOT = 8192;
constexpr int LDS_K = 0, LDS_V = NSLOT * KSLOT, LDS_CB = LDS_V + NSLOT * VSLOT, LDS_KM = LDS_CB + SEQ * 4, LDS_WS = LDS_KM + 8192, LDS_OST = LDS_WS + NW * 64 * 4, LDS_BYTES = LDS_OST + NW * 4096;
static_assert(LDS_BYTES <= 131072, "attention LDS");
constexpr float NEGBIG = -1.0e30f;
constexpr float THR = 8.0f;
#define SBAR() __builtin_amdgcn_sched_barrier(0)
__device__ __forceinline__ int crow(int r, int hi) { return (r & 3) + 8 * (r >> 2) + 4 * hi; }
__device__ __forceinline__ void glds16(const void* gsrc, unsigned lds_dst) { unsigned keep;
    asm volatile("s_mov_b32 %0, m0\n\ts_mov_b32 m0, %2\n\ts_nop 0\n\tglobal_load_lds_dwordx4 %1, off\n\ts_mov_b32 m0, %0" : "=&s"(keep) : "v"(gsrc), "s"(lds_dst) : "memory"); }
typedef float f32x2_t __attribute__((ext_vector_type(2))); typedef __bf16 bf16x2_t __attribute__((ext_vector_type(2)));
__device__ __forceinline__ unsigned cvtpk_s(float lo, float hi) { f32x2_t v = {lo, hi}; bf16x2_t b = __builtin_convertvector(v, bf16x2_t); return __builtin_bit_cast(unsigned, b); }
#define WAIT_BAR(N) asm volatile("s_waitcnt vmcnt(" #N ") lgkmcnt(0)\n\ts_barrier" ::: "memory")

struct Args { const bf16* Q; const bf16* K; const bf16* KR; const bf16* V; bf16* O; const float* CUM; const float* KMEAN; int qpitch, kpitch, vpitch, opitch, qhs, khs; };

template <int ND> __device__ __forceinline__ void qkt(f32x16& p0, f32x16& p1, lds_cptr kb, const bf16x8* qr, const f32x16& cin) {
#pragma unroll
    for (int d0 = 0; d0 < ND; ++d0) {
        const bf16x8 b0 = *(const LAS bf16x8*)(kb + d0 * 2048); const bf16x8 b1 = *(const LAS bf16x8*)(kb + d0 * 2048 + 512);
        if (d0 == 0) { p0 = __builtin_amdgcn_mfma_f32_32x32x16_bf16(b0, qr[0], cin, 0, 0, 0); p1 = __builtin_amdgcn_mfma_f32_32x32x16_bf16(b1, qr[0], cin, 0, 0, 0); }
        else { p0 = __builtin_amdgcn_mfma_f32_32x32x16_bf16(b0, qr[d0], p0, 0, 0, 0); p1 = __builtin_amdgcn_mfma_f32_32x32x16_bf16(b1, qr[d0], p1, 0, 0, 0); } }
}
__device__ __forceinline__ float rowmax(const f32x16& p0, const f32x16& p1) {
    float a = fmaxf(fmaxf(p0[0], p0[1]), p1[0]), b = fmaxf(fmaxf(p0[2], p0[3]), p1[1]); a = fmaxf(fmaxf(a, p1[2]), p1[3]);
#pragma unroll
    for (int r = 4; r < 16; r += 4) { a = fmaxf(fmaxf(a, p0[r]), p0[r + 1]); b = fmaxf(fmaxf(b, p0[r + 2]), p0[r + 3]); a = fmaxf(fmaxf(a, p1[r]), p1[r + 1]); b = fmaxf(fmaxf(b, p1[r + 2]), p1[r + 3]); }
    const float m = fmaxf(a, b);
    auto rr = __builtin_amdgcn_permlane32_swap(__float_as_uint(m), __float_as_uint(m), false, false);
    return fmaxf(__uint_as_float(rr[0]), __uint_as_float(rr[1]));
}
struct VFrag { s16x4 lo[2][4], hi[2][4]; };
__device__ __forceinline__ void pv_issue(VFrag& f, int vb) {
#pragma unroll
    for (int d0 = 0; d0 < 2; ++d0)
#pragma unroll
        for (int ks = 0; ks < 4; ++ks) {
            asm volatile("ds_read_b64_tr_b16 %0,%1 offset:%c2" : "=&v"(f.lo[d0][ks]) : "v"(vb), "i"(d0 * 4096 + ks * 1024) : "memory");
            asm volatile("ds_read_b64_tr_b16 %0,%1 offset:%c2" : "=&v"(f.hi[d0][ks]) : "v"(vb), "i"(d0 * 4096 + ks * 1024 + 512) : "memory"); }
}
__device__ __forceinline__ void pv_mma(f32x16& o0, f32x16& o1, f32x16& o2, VFrag& f, bf16x8 pa0, bf16x8 pa1, bf16x8 pa2, bf16x8 pa3) {
    asm volatile("s_waitcnt lgkmcnt(0)" : "+v"(f.lo[0][0]), "+v"(f.lo[0][1]), "+v"(f.lo[0][2]), "+v"(f.lo[0][3]), "+v"(f.hi[0][0]), "+v"(f.hi[0][1]), "+v"(f.hi[0][2]), "+v"(f.hi[0][3]),
                 "+v"(f.lo[1][0]), "+v"(f.lo[1][1]), "+v"(f.lo[1][2]), "+v"(f.lo[1][3]), "+v"(f.hi[1][0]), "+v"(f.hi[1][1]), "+v"(f.hi[1][2]), "+v"(f.hi[1][3]) :: "memory");
#define PK(d, k) (bf16x8){f.lo[d][k][0], f.lo[d][k][1], f.lo[d][k][2], f.lo[d][k][3], f.hi[d][k][0], f.hi[d][k][1], f.hi[d][k][2], f.hi[d][k][3]}
    o0 = __builtin_amdgcn_mfma_f32_32x32x16_bf16(pa0, PK(0, 0), o0, 0, 0, 0); o1 = __builtin_amdgcn_mfma_f32_32x32x16_bf16(pa0, PK(1, 0), o1, 0, 0, 0);
    o0 = __builtin_amdgcn_mfma_f32_32x32x16_bf16(pa1, PK(0, 1), o0, 0, 0, 0); o1 = __builtin_amdgcn_mfma_f32_32x32x16_bf16(pa1, PK(1, 1), o1, 0, 0, 0);
    o0 = __builtin_amdgcn_mfma_f32_32x32x16_bf16(pa2, PK(0, 2), o0, 0, 0, 0); o1 = __builtin_amdgcn_mfma_f32_32x32x16_bf16(pa2, PK(1, 2), o1, 0, 0, 0);
    o0 = __builtin_amdgcn_mfma_f32_32x32x16_bf16(pa3, PK(0, 3), o0, 0, 0, 0); o1 = __builtin_amdgcn_mfma_f32_32x32x16_bf16(pa3, PK(1, 3), o1, 0, 0, 0);
#undef PK
    const bf16x8 ones = {0x3F80, 0x3F80, 0x3F80, 0x3F80, 0x3F80, 0x3F80, 0x3F80, 0x3F80};
    o2 = __builtin_amdgcn_mfma_f32_32x32x16_bf16(pa0, ones, o2, 0, 0, 0);
    o2 = __builtin_amdgcn_mfma_f32_32x32x16_bf16(pa1, ones, o2, 0, 0, 0);
    o2 = __builtin_amdgcn_mfma_f32_32x32x16_bf16(pa2, ones, o2, 0, 0, 0);
    o2 = __builtin_amdgcn_mfma_f32_32x32x16_bf16(pa3, ones, o2, 0, 0, 0);
}

template <int VAR, bool FIRST, bool BAND>
__device__ __forceinline__ void tile_step(f32x16& o0, f32x16& o1, f32x16& o2, float& mhat, const bf16x8* qr, lds_cptr kb, int vb, LAS float* wsf, lds_cptr cbp, bool take, int jb, int qrel, int hi, int r32) {
    constexpr int ND = (VAR == 0) ? 6 : 4;
    f32x16 cin; { const float c0 = (VAR == 2 && !BAND && !take) ? NEGBIG : -mhat;
#pragma unroll
        for (int r = 0; r < 16; ++r) cin[r] = c0; }
    f32x16 p0, p1; qkt<ND>(p0, p1, kb, qr, cin);
    if (VAR == 1) {
#pragma unroll
        for (int j = 0; j < 4; ++j) { const f32x4 b0 = *(const LAS f32x4*)(cbp + j * 32), b1 = *(const LAS f32x4*)(cbp + 128 + j * 32);
#pragma unroll
            for (int e = 0; e < 4; ++e) { p0[4 * j + e] += b0[e]; p1[4 * j + e] += b1[e]; } } }
    VFrag vf; pv_issue(vf, vb);
    if (BAND) { const int kb0 = 64 * jb + 4 * hi;
#pragma unroll
        for (int r = 0; r < 16; ++r) { const int kv = kb0 + (r & 3) + 8 * (r >> 2); if (kv > qrel) p0[r] = NEGBIG; if (kv + 32 > qrel) p1[r] = NEGBIG; } }
    const float rm = rowmax(p0, p1);
    if (FIRST) { mhat = rm;
#pragma unroll
        for (int r = 0; r < 16; ++r) { p0[r] -= rm; p1[r] -= rm; }
    } else if (__builtin_amdgcn_ballot_w64(rm > THR) != 0ull) {
        const float dl = fmaxf(rm, 0.f); mhat += dl;
#pragma unroll
        for (int r = 0; r < 16; ++r) { p0[r] -= dl; p1[r] -= dl; }
        const float f = __builtin_amdgcn_exp2f(-dl); if (hi == 0) wsf[r32] = f;
#pragma unroll
        for (int j = 0; j < 4; ++j) { const f32x4 fv = *(const LAS f32x4*)(wsf + 8 * j + 4 * hi);
#pragma unroll
            for (int e = 0; e < 4; ++e) { o0[4 * j + e] *= fv[e]; o1[4 * j + e] *= fv[e]; o2[4 * j + e] *= fv[e]; } }
    }
#pragma unroll
    for (int r = 0; r < 16; ++r) { p0[r] = __builtin_amdgcn_exp2f(p0[r]); p1[r] = __builtin_amdgcn_exp2f(p1[r]); }
    u32x4 pw0, pw1, pw2, pw3;
#define PKW(P, B) cvtpk_s(P[B], P[B + 1])
    pw0 = (u32x4){PKW(p0, 0), PKW(p0, 2), PKW(p0, 4), PKW(p0, 6)}; pw1 = (u32x4){PKW(p0, 8), PKW(p0, 10), PKW(p0, 12), PKW(p0, 14)};
    pw2 = (u32x4){PKW(p1, 0), PKW(p1, 2), PKW(p1, 4), PKW(p1, 6)}; pw3 = (u32x4){PKW(p1, 8), PKW(p1, 10), PKW(p1, 12), PKW(p1, 14)};
#undef PKW
    pv_mma(o0, o1, o2, vf, __builtin_bit_cast(bf16x8, pw0), __builtin_bit_cast(bf16x8, pw1), __builtin_bit_cast(bf16x8, pw2), __builtin_bit_cast(bf16x8, pw3));
}

template <int VAR>
__device__ __forceinline__ void attn_unit(int b, int h, int qb, const Args& A, char* shm, int wid) {
    constexpr int DK = (VAR == 0) ? 96 : 64, ND = DK / 16;
    const int lane = pg8::lane_id_opaque(), tid = wid * 64 + lane, r32 = lane & 31, hi = lane >> 5;
    const long rowbase = (long)b * SEQ; const int q0 = qb * QB;
    const unsigned lds0 = (unsigned)(uintptr_t)shm;
    const lds_cptr shm3 = (lds_cptr)shm;
    LAS float* wsf = (LAS float*)((lds_ptr)shm + LDS_WS) + wid * 64;
    const bf16* Qw = A.Q + (rowbase + q0 + wid * QBLK) * A.qpitch + h * A.qhs;
    const bf16* Kh = A.K + rowbase * A.kpitch + h * A.khs; const bf16* Vh = A.V + rowbase * A.vpitch + h * A.khs;
    const int NT = (q0 + QB) / KVBLK;
    bf16x8 qr[ND];
#pragma unroll
    for (int d0 = 0; d0 < ND; ++d0) qr[d0] = *reinterpret_cast<const bf16x8*>(&Qw[(long)r32 * A.qpitch + d0 * 16 + hi * 8]);
    const bf16* ksrc = Kh + (long)lane * A.kpitch + wid * 8;
    const bf16* ksrc2 = (VAR == 0) ? A.KR + (rowbase + lane) * 32 + (wid & 3) * 8 : nullptr;
    const bf16* vsrc = Vh + (long)(16 * (wid & 3) + (lane >> 2)) * A.vpitch + (wid >> 2) * 32 + (lane & 3) * 8;
    const unsigned kdst = lds0 + LDS_K + wid * 1024, kdst2 = lds0 + LDS_K + (8 + (wid & 3)) * 1024, vdst = lds0 + LDS_V + wid * 1024;
#define DMA_T(t, sl) do { glds16(ksrc + (long)(t) * KVBLK * A.kpitch, (unsigned)__builtin_amdgcn_readfirstlane(kdst + (sl) * KSLOT)); \
        if (VAR == 0) glds16(ksrc2 + (long)(t) * KVBLK * 32, (unsigned)__builtin_amdgcn_readfirstlane(kdst2 + (sl) * KSLOT)); \
        glds16(vsrc + (long)(t) * KVBLK * A.vpitch, (unsigned)__builtin_amdgcn_readfirstlane(vdst + (sl) * VSLOT)); } while (0)
#define TILE_OF(i) (((i) < 4) ? (NT - 4 + (i)) : (NT - 1 - (i)))
    if (VAR == 1) { const float* cu = A.CUM + ((long)b * 8 + h) * SEQ; const float c0 = cu[q0]; const int nk = q0 + QB; LAS float* CB = (LAS float*)((lds_ptr)shm + LDS_CB);
        for (int s = tid; s < nk; s += NW * 64) CB[s] = (c0 - cu[s]) * LOG2E; }
    if (VAR == 2) { const int idx = tid * 2, blk = idx >> 6, d = idx & 63; const f32x2 km = *(const f32x2*)(A.KMEAN + ((long)b * 16 + blk) * 512 + h * 64 + d);
        *(LAS unsigned*)((lds_ptr)shm + LDS_KM + (d >> 3) * 1024 + blk * 16 + (d & 7) * 2) = cvtpk_s(km[0], km[1]); }
    float qn2 = 0.f;
    if (VAR == 1) { float sq = 0.f;
#pragma unroll
        for (int d0 = 0; d0 < ND; ++d0)
#pragma unroll
            for (int e = 0; e < 8; ++e) { const float x = __uint_as_float((unsigned)(unsigned short)qr[d0][e] << 16); sq += x * x; }
        { auto rr = __builtin_amdgcn_permlane32_swap(__float_as_uint(sq), __float_as_uint(sq), false, false); sq = __uint_as_float(rr[0]) + __uint_as_float(rr[1]); }
#pragma unroll
        for (int o = 1; o < 32; o <<= 1) sq = fmaxf(sq, __shfl_xor(sq, o));
        qn2 = sq; if (lane == 0) ((LAS float*)((lds_ptr)shm + LDS_KM))[wid] = sq; }
    asm volatile("s_waitcnt vmcnt(0)" ::: "memory");
    DMA_T(TILE_OF(0), 0); DMA_T(TILE_OF(1), 1);
    float mhat = 0.f; f32x16 o0 = f32x16{}, o1 = f32x16{}, o2 = f32x16{};
    const int qrel = wid * QBLK + r32;
    const lds_cptr kb0 = shm3 + LDS_K + hi * 1024 + r32 * 16;
    const int vb0 = (int)(lds0 + LDS_V) + ((lane >> 4) & 1) * 32 + (lane & 3) * 8 + (4 * hi + ((lane & 15) >> 2)) * 64;
    const lds_cptr cb0 = shm3 + LDS_CB + 16 * hi;
    unsigned selmask = 0u;
    if (VAR == 0) WAIT_BAR(3); else WAIT_BAR(2);
    int NTe = NT;
    if (VAR == 1 && NT > 4) {
        const LAS float* qs = (const LAS float*)((lds_ptr)shm + LDS_KM); float q2 = 0.f;
#pragma unroll
        for (int w = 0; w < 8; ++w) q2 = fmaxf(q2, qs[w]);
        const float thr = -(64.0f + 2.05f * sqrtf(q2) * A.KMEAN[b * 8 + h]);
        const LAS float* CBt = (const LAS float*)((lds_ptr)shm + LDS_CB);
        const bool sk = (lane < NT - 4) && (CBt[64 * lane + 63] < thr);
        NTe = NT - (int)__builtin_popcountll(__builtin_amdgcn_ballot_w64(sk));
    }
    if (2 < NTe) DMA_T(TILE_OF(2), 2);
    if (VAR == 2 && qb > 0) {
        f32x16 pg = f32x16{}; const lds_cptr km = shm3 + LDS_KM + hi * 1024 + r32 * 16;
#pragma unroll
        for (int d0 = 0; d0 < 4; ++d0) pg = __builtin_amdgcn_mfma_f32_32x32x16_bf16(*(const LAS bf16x8*)(km + d0 * 2048), qr[d0], pg, 0, 0, 0);
        float G[16];
#pragma unroll
        for (int r = 0; r < 8; ++r) { auto rr = __builtin_amdgcn_permlane32_swap(__float_as_uint(pg[r]), __float_as_uint(pg[r]), false, false);
            const int blk = (r & 3) + 8 * (r >> 2); G[blk] = (blk < qb) ? __uint_as_float(rr[0]) : -INFINITY; G[blk + 4] = (blk + 4 < qb) ? __uint_as_float(rr[1]) : -INFINITY; }
#pragma unroll
        for (int k = 0; k < 3; ++k) { float best = -INFINITY; int bi = -1;
#pragma unroll
            for (int n = 0; n < 16; ++n) if (G[n] > best) { best = G[n]; bi = n; }
            if (bi >= 0) selmask |= 1u << bi;
#pragma unroll
            for (int n = 0; n < 16; ++n) if (n == bi) G[n] = -INFINITY; }
    }
    tile_step<VAR, true, true>(o0, o1, o2, mhat, qr, kb0, vb0, wsf, cb0 + (NT - 4) * 256, true, 0, qrel, hi, r32);
#pragma unroll 1
    for (int i = 1; i < 4; ++i) {
        if (i + 1 < NTe) { if (VAR == 0) WAIT_BAR(3); else WAIT_BAR(2); } else WAIT_BAR(0);
        if (i + 2 < NTe) DMA_T(TILE_OF(i + 2), (i + 2) % 3);
        if (64 * i <= 32 * wid + 31) tile_step<VAR, false, true>(o0, o1, o2, mhat, qr, kb0 + (i % 3) * KSLOT, vb0 + (i % 3) * VSLOT, wsf, cb0 + (NT - 4 + i) * 256, true, i, qrel, hi, r32);
    }
    int sl = 1;
#pragma unroll 1
    for (int i = 4; i < NTe; ++i) {
        const int t = NT - 1 - i;
        if (i + 1 < NTe) { if (VAR == 0) WAIT_BAR(3); else WAIT_BAR(2); } else WAIT_BAR(0);
        if (i + 2 < NTe) { const int s2 = (sl == 0) ? 2 : sl - 1; DMA_T(TILE_OF(i + 2), s2); }
        const bool take = (VAR == 2) ? (((selmask >> (t >> 2)) & 1u) != 0u) : true;
        tile_step<VAR, false, false>(o0, o1, o2, mhat, qr, kb0 + sl * KSLOT, vb0 + sl * VSLOT, wsf, cb0 + t * 256, take, 0, qrel, hi, r32);
        sl = (sl == 2) ? 0 : sl + 1;
    }
    float rli[16];
#pragma unroll
    for (int r = 0; r < 16; ++r) rli[r] = __builtin_amdgcn_rcpf(o2[r]);
    bf16* Ow = A.O + (rowbase + q0 + wid * QBLK) * A.opitch + h * 64;
    { LAS unsigned short* stg = (LAS unsigned short*)((lds_ptr)shm + LDS_OST) + wid * 2048;
#pragma unroll
        for (int r = 0; r < 16; ++r) { const int orow = crow(r, hi);
            const unsigned pk = cvtpk_s(o0[r] * rli[r], o1[r] * rli[r]); stg[orow * 64 + r32] = (unsigned short)(pk & 0xffffu); stg[orow * 64 + 32 + r32] = (unsigned short)(pk >> 16); }
        asm volatile("s_waitcnt lgkmcnt(0)" ::: "memory");
#pragma unroll
        for (int i = 0; i < 4; ++i) { const int row = i * 8 + (lane >> 3), ch = lane & 7; const u32x4 v = *(const LAS u32x4*)(stg + row * 64 + ch * 8); __builtin_nontemporal_store(v, (u32x4*)(Ow + (long)row * A.opitch + ch * 8)); } }
    asm volatile("s_waitcnt lgkmcnt(0)\n\ts_barrier" ::: "memory");
#undef DMA_T
#undef TILE_OF
}
#undef SBAR
#undef WAIT_BAR
}
constexpr int RING_OFF = 0, RING_BYTES = 131072;
constexpr int LDSCTL_OFF = RING_BYTES, MISC_OFF = LDSCTL_OFF + 320;
constexpr int LDS_BYTES = 147456;
constexpr int NWAVES = 8;

typedef unsigned v4u __attribute__((ext_vector_type(4)));
typedef unsigned v2u __attribute__((ext_vector_type(2)));
typedef float f32x4 __attribute__((ext_vector_type(4)));
typedef float f32x2 __attribute__((ext_vector_type(2)));
typedef int i32x4 __attribute__((ext_vector_type(4)));
typedef int i32x2 __attribute__((ext_vector_type(2)));
typedef GAS unsigned gu32;
#define RLX_AGENT __ATOMIC_RELAXED, __HIP_MEMORY_SCOPE_AGENT
#define LDS_WAIT() asm volatile("s_waitcnt lgkmcnt(0)" ::: "memory")
#define VM_WAIT() asm volatile("s_waitcnt vmcnt(0)" ::: "memory")
__device__ __forceinline__ unsigned f2bf(float f) { unsigned u = __builtin_bit_cast(unsigned, f); return (u + 0x7fffu + ((u >> 16) & 1u)) >> 16; }
__device__ __forceinline__ unsigned pk2(float lo, float hi) { return f2bf(lo) | (f2bf(hi) << 16); }
__device__ __forceinline__ float bfl(unsigned w) { return __uint_as_float(w << 16); }
__device__ __forceinline__ float bfh(unsigned w) { return __uint_as_float(w & 0xffff0000u); }

#define XB_TMO      128
#define XB_XCNT(j)  (256  + 64 * (j))
#define XB_XSUB(j)  (1280 + 64 * (j))
#define XB_XGEN(j)  (2304 + 64 * (j))
#define XB_TOP      3328
#define XB_TOPGEN   3392
#define XCD_BAR_WORDS 3456
#define XB_SPIN_CAP (1u << 18)
__device__ __forceinline__ unsigned xb_ld(unsigned* p)              { return __hip_atomic_load(p, __ATOMIC_RELAXED, __HIP_MEMORY_SCOPE_AGENT); }
__device__ __forceinline__ unsigned xb_add(unsigned* p, unsigned v) { return __hip_atomic_fetch_add(p, v, __ATOMIC_RELAXED, __HIP_MEMORY_SCOPE_AGENT); }
__device__ __forceinline__ unsigned xb_xcc_id() { return (unsigned)__builtin_amdgcn_s_getreg((3 << 11) | 20) & 0xFu; }
#define XB_SPIN(cond, bar) do { unsigned _sp = 0; while (cond) { __builtin_amdgcn_s_sleep(1); \
    if ((++_sp & 255u) == 0u) { if (xb_ld(&(bar)[XB_TMO])) break; if (_sp > XB_SPIN_CAP) { atomicAdd(&(bar)[XB_TMO], 1u); break; } } } } while (0)
struct XcdBarrier { unsigned* bar; unsigned x; volatile LAS unsigned* st; };
__device__ __forceinline__ XcdBarrier xcd_barrier_post(unsigned* bar, volatile LAS unsigned* st) {
    XcdBarrier b; b.bar = bar; b.x = xb_xcc_id(); b.st = st;
    if (threadIdx.x == 0) (void)xb_add(&bar[XB_XCNT(b.x)], 1u);
    return b;
}
__device__ __forceinline__ void xcd_barrier_complete(unsigned* bar, unsigned x, unsigned& nloc, unsigned& nx) {
    const unsigned G = gridDim.x * gridDim.y * gridDim.z;
    unsigned sum, cnt, mine, sp = 0u;
    for (;;) {
        sum = 0u; cnt = 0u; mine = 0u;
#pragma unroll
        for (unsigned j = 0; j < 16; ++j) { const unsigned c = xb_ld(&bar[XB_XCNT(j)]); sum += c; cnt += (c > 0u) ? 1u : 0u; mine = (j == x) ? c : mine; }
        if (sum == G) break;
        __builtin_amdgcn_s_sleep(1);
        if ((++sp & 255u) == 0u) { if (xb_ld(&bar[XB_TMO])) break; if (sp > XB_SPIN_CAP) { atomicAdd(&bar[XB_TMO], 1u); break; } }
    }
    nloc = mine > 0u ? mine : 1u; nx = cnt > 0u ? cnt : 1u;
}
__device__ __forceinline__ void xcd_barrier(const XcdBarrier& b, int wave) {
    asm volatile("s_waitcnt vmcnt(0)" ::: "memory");
    __syncthreads();
    if (wave == 0 && pg8::lane_id_opaque() == 0) {
        unsigned* bar = b.bar; asm volatile("" : "+s"(bar));
        __builtin_amdgcn_s_waitcnt(0);
        unsigned nloc = b.st[0], nx = b.st[1];
        if (nloc == 0u) { xcd_barrier_complete(bar, b.x, nloc, nx); b.st[0] = nloc; b.st[1] = nx; }
        const unsigned old = xb_add(&bar[XB_XSUB(b.x)], 1u);
        const unsigned gen = old / nloc;
        if (old + 1u == (gen + 1u) * nloc) {
            __builtin_amdgcn_fence(__ATOMIC_RELEASE, "agent");
            asm volatile("s_waitcnt vmcnt(0)" ::: "memory");
            const unsigned og = xb_add(&bar[XB_TOP], 1u);
            const unsigned tg = og / nx;
            if (og + 1u == (tg + 1u) * nx) xb_add(&bar[XB_TOPGEN], 1u);
            else XB_SPIN(xb_ld(&bar[XB_TOPGEN]) == tg, bar);
            __builtin_amdgcn_fence(__ATOMIC_ACQUIRE, "agent");
            xb_add(&bar[XB_XGEN(b.x)], 1u);
            asm volatile("s_waitcnt vmcnt(0)" ::: "memory");
        } else {
            XB_SPIN(xb_ld(&bar[XB_XGEN(b.x)]) == gen, bar);
            __builtin_amdgcn_fence(__ATOMIC_ACQUIRE, "agent");
            asm volatile("s_waitcnt vmcnt(0)" ::: "memory");
        }
    }
    __syncthreads();
}

struct Frame {
    LAS unsigned char* lds;
    int tid, lane, wave, vcu, G, bid;
};
__device__ __forceinline__ float wave_sum(float v) {
#pragma unroll
    for (int o = 1; o < 64; o <<= 1) v += __shfl_xor(v, o);
    return v;
}

struct WJob { const float* W; const float* ksc; bf16* Bt; int Ks, Ns, Kd, Nd, kind, p0; float f8s; };
__device__ __forceinline__ int srccol(int kind, int p0, int R) {
    const int P8 = (R & ~31) + pg8::perm32(R & 31);
    switch (kind) {
    case 0: return R;
    case 1: return P8;
    case 2: {
        if (R < 256) return P8;
        if (R < 384) return P8;
        if (R < 416) return R;
        if (R < 424) return 1952 + (R - 416);
        if (R < 512) return -1;
        if (R < 2048) return 416 + (P8 - 512);
        if (R < 3072) { const int idx = R - 2048, head = idx >> 6, hp = idx & 63, s = hp >> 5, n = (hp >> 4) & 1, q4 = hp & 15; return 1960 + head * 64 + 32 * n + 16 * s + q4; }
        if (R < 3584) return 2984 + (P8 - 3072);
        return 3496 + (P8 - 3584); }
    case 3: { const int g = R >> 5; return (g % 3 == 2) ? R : P8; }
    case 4: { const int t = R >> 8, p = R & 255, bj = p >> 7, hp = p & 127; return bj * p0 + t * 128 + (hp & ~31) + pg8::perm32(hp & 31); }
    }
    return -1;
}
__device__ __forceinline__ void wconv_load(const WJob& J, int item, int lane, f32x4 (&v)[8]) {
    const int nkb = J.Kd / 64, rb = item / nkb, kb = item % nkb, k0 = 64 * kb + 8 * (lane >> 3), R = 32 * rb + 4 * (lane & 7);
    const int sc = srccol(J.kind, J.p0, R);
    const bool live = sc >= 0; const float* wp = J.W + (size_t)k0 * J.Ns + (live ? sc : 0);
#pragma unroll
    for (int i = 0; i < 8; ++i) v[i] = (live && k0 + i < J.Ks) ? *(const f32x4*)(wp + (size_t)i * J.Ns) : (f32x4){0.f, 0.f, 0.f, 0.f};
    if (J.ksc) {
#pragma unroll
        for (int i = 0; i < 8; ++i) if (k0 + i < J.Ks) v[i] = v[i] * J.ksc[k0 + i]; }
}
__device__ __forceinline__ void wconv_store(const WJob& J, int item, int lane, const f32x4 (&v)[8]) {
    const int nkb = J.Kd / 64, rb = item / nkb, kb = item % nkb, k0 = 64 * kb + 8 * (lane >> 3), R = 32 * rb + 4 * (lane & 7);
    if (J.f8s > 0.f) { const float f = J.f8s;
#pragma unroll
        for (int j = 0; j < 4; ++j) { v2u o; o.x = pg8::pk4_f8(v[0][j] * f, v[1][j] * f, v[2][j] * f, v[3][j] * f); o.y = pg8::pk4_f8(v[4][j] * f, v[5][j] * f, v[6][j] * f, v[7][j] * f);
            *(v2u*)((unsigned char*)J.Bt + (size_t)(R + j) * J.Kd + k0) = o; }
    } else {
#pragma unroll
        for (int j = 0; j < 4; ++j) { v4u o; o.x = pk2(v[0][j], v[1][j]); o.y = pk2(v[2][j], v[3][j]); o.z = pk2(v[4][j], v[5][j]); o.w = pk2(v[6][j], v[7][j]);
            *(v4u*)(J.Bt + (size_t)(R + j) * J.Kd + k0) = o; } }
}

__device__ __forceinline__ void rms_row_to_bf16(const float* xrow, const float* g, bf16* orow, int lane) {
    const f32x4* xr = (const f32x4*)xrow + lane; const f32x4* gr = (const f32x4*)g + lane;
    f32x4 v[4]; float s = 0.f;
#pragma unroll
    for (int j = 0; j < 4; ++j) { v[j] = xr[64 * j]; s += (v[j].x * v[j].x + v[j].y * v[j].y) + (v[j].z * v[j].z + v[j].w * v[j].w); }
    const float r = rsqrtf(wave_sum(s) * (1.f / DM) + RMS_EPS);
    unsigned long long* o8 = (unsigned long long*)orow + lane;
#pragma unroll
    for (int j = 0; j < 4; ++j) { const f32x4 gg = gr[64 * j]; o8[64 * j] = (unsigned long long)pk2(v[j].x * r * gg.x, v[j].y * r * gg.y) | ((unsigned long long)pk2(v[j].z * r * gg.z, v[j].w * r * gg.w) << 32); }
}

__device__ __forceinline__ void rms_row_to_f8(const float* xrow, const float* g, unsigned char* orow, float* rs, int lane) {
    const f32x4* xr = (const f32x4*)xrow + lane; const f32x4* gr = (const f32x4*)g + lane;
    f32x4 v[4]; float s = 0.f;
#pragma unroll
    for (int j = 0; j < 4; ++j) { v[j] = xr[64 * j]; s += (v[j].x * v[j].x + v[j].y * v[j].y) + (v[j].z * v[j].z + v[j].w * v[j].w); }
    const float r = rsqrtf(wave_sum(s) * (1.f / DM) + RMS_EPS); float mx = 0.f;
#pragma unroll
    for (int j = 0; j < 4; ++j) { const f32x4 gg = gr[64 * j]; v[j] = (f32x4){v[j].x * r * gg.x, v[j].y * r * gg.y, v[j].z * r * gg.z, v[j].w * r * gg.w};
        mx = fmaxf(fmaxf(mx, fmaxf(fabsf(v[j].x), fabsf(v[j].y))), fmaxf(fabsf(v[j].z), fabsf(v[j].w))); }
#pragma unroll
    for (int o = 1; o < 64; o <<= 1) mx = fmaxf(mx, __shfl_xor(mx, o));
    const float sc = mx > 0.f ? A8_ROWMAX / mx : 1.0f;
    unsigned* o4 = (unsigned*)orow + lane;
#pragma unroll
    for (int j = 0; j < 4; ++j) o4[64 * j] = pg8::pk4_f8(v[j].x * sc, v[j].y * sc, v[j].z * sc, v[j].w * sc);
    if (lane == 0) *rs = mx > 0.f ? mx * (1.0f / A8_ROWMAX) : 1.0f;
}

__device__ __forceinline__ void ld_row16(const bf16* row, int lane, f32x4 (&v)[4]) {
    const v2u* xr = (const v2u*)row + lane;
#pragma unroll
    for (int j = 0; j < 4; ++j) { const v2u w = xr[64 * j]; v[j] = (f32x4){bfl(w.x), bfh(w.x), bfl(w.y), bfh(w.y)}; }
}
__device__ __forceinline__ void rms_row16_to_bf16(const bf16* xrow, const float* g, bf16* orow, int lane) {
    const f32x4* gr = (const f32x4*)g + lane; f32x4 v[4]; ld_row16(xrow, lane, v); float s = 0.f;
#pragma unroll
    for (int j = 0; j < 4; ++j) s += (v[j].x * v[j].x + v[j].y * v[j].y) + (v[j].z * v[j].z + v[j].w * v[j].w);
    const float r = rsqrtf(wave_sum(s) * (1.f / DM) + RMS_EPS);
    unsigned long long* o8 = (unsigned long long*)orow + lane;
#pragma unroll
    for (int j = 0; j < 4; ++j) { const f32x4 gg = gr[64 * j]; o8[64 * j] = (unsigned long long)pk2(v[j].x * r * gg.x, v[j].y * r * gg.y) | ((unsigned long long)pk2(v[j].z * r * gg.z, v[j].w * r * gg.w) << 32); }
}

__device__ __forceinline__ unsigned pk4_i8(float a, float b, float c, float d) {
    const int ia = (int)rintf(a), ib = (int)rintf(b), ic = (int)rintf(c), id = (int)rintf(d);
    return (unsigned)(ia & 255) | ((unsigned)(ib & 255) << 8) | ((unsigned)(ic & 255) << 16) | ((unsigned)(id & 255) << 24);
}
__device__ __forceinline__ void rms_row16_to_i8(const bf16* xrow, const float* g, unsigned char* orow, float* rs, int lane) {
    const f32x4* gr = (const f32x4*)g + lane; f32x4 v[4]; ld_row16(xrow, lane, v); float s = 0.f;
#pragma unroll
    for (int j = 0; j < 4; ++j) s += (v[j].x * v[j].x + v[j].y * v[j].y) + (v[j].z * v[j].z + v[j].w * v[j].w);
    const float r = rsqrtf(wave_sum(s) * (1.f / DM) + RMS_EPS); float mx = 0.f;
#pragma unroll
    for (int j = 0; j < 4; ++j) { const f32x4 gg = gr[64 * j]; v[j] = (f32x4){v[j].x * r * gg.x, v[j].y * r * gg.y, v[j].z * r * gg.z, v[j].w * r * gg.w};
        mx = fmaxf(fmaxf(mx, fmaxf(fabsf(v[j].x), fabsf(v[j].y))), fmaxf(fabsf(v[j].z), fabsf(v[j].w))); }
#pragma unroll
    for (int o = 1; o < 64; o <<= 1) mx = fmaxf(mx, __shfl_xor(mx, o));
    const float sc = mx > 0.f ? 127.0f / mx : 0.f;
    unsigned* o4 = (unsigned*)orow + lane;
#pragma unroll
    for (int j = 0; j < 4; ++j) o4[64 * j] = pk4_i8(v[j].x * sc, v[j].y * sc, v[j].z * sc, v[j].w * sc);
    if (lane == 0) *rs = mx * (1.0f / 127.0f);
}
template <bool F32IN>
__device__ __forceinline__ void rms_rows_to_i8(const void* X, const float* g, unsigned char* O, float* RS, int m0, int step, int lane) {
    const f32x4* gr = (const f32x4*)g + lane; f32x4 gg[4];
#pragma unroll
    for (int j = 0; j < 4; ++j) gg[j] = gr[64 * j];
    v2u nw[4]; f32x4 nf[4];
    auto issue = [&](int m) __attribute__((always_inline)) {
        if (F32IN) { const f32x4* xr = (const f32x4*)((const float*)X + (size_t)m * DM) + lane;
#pragma unroll
            for (int j = 0; j < 4; ++j) nf[j] = xr[64 * j]; }
        else { const v2u* xr = (const v2u*)((const bf16*)X + (size_t)m * DM) + lane;
#pragma unroll
            for (int j = 0; j < 4; ++j) nw[j] = xr[64 * j]; } };
    if (m0 < MTOK) issue(m0);
    for (int m = m0; m < MTOK; m += step) { f32x4 v[4];
#pragma unroll
        for (int j = 0; j < 4; ++j) v[j] = F32IN ? nf[j] : (f32x4){bfl(nw[j].x), bfh(nw[j].x), bfl(nw[j].y), bfh(nw[j].y)};
        if (m + step < MTOK) issue(m + step);
        float s = 0.f;
#pragma unroll
        for (int j = 0; j < 4; ++j) s += (v[j].x * v[j].x + v[j].y * v[j].y) + (v[j].z * v[j].z + v[j].w * v[j].w);
        const float r = rsqrtf(wave_sum(s) * (1.f / DM) + RMS_EPS); float mx = 0.f;
#pragma unroll
        for (int j = 0; j < 4; ++j) { v[j] = (f32x4){v[j].x * r * gg[j].x, v[j].y * r * gg[j].y, v[j].z * r * gg[j].z, v[j].w * r * gg[j].w};
            mx = fmaxf(fmaxf(mx, fmaxf(fabsf(v[j].x), fabsf(v[j].y))), fmaxf(fabsf(v[j].z), fabsf(v[j].w))); }
#pragma unroll
        for (int o = 1; o < 64; o <<= 1) mx = fmaxf(mx, __shfl_xor(mx, o));
        const float sc = mx > 0.f ? 127.0f / mx : 0.f;
        unsigned* o4 = (unsigned*)(O + (size_t)m * DM) + lane;
#pragma unroll
        for (int j = 0; j < 4; ++j) o4[64 * j] = pk4_i8(v[j].x * sc, v[j].y * sc, v[j].z * sc, v[j].w * sc);
        if (lane == 0) RS[m] = mx * (1.0f / 127.0f); }
}
__device__ __forceinline__ void wconv_i8_item(const float* W, int Ks, int Ns, int kind, int p0, unsigned char* Bt, float* CS, int item, int lane) {
    const int R = 16 * item + 4 * (lane & 3), ko = lane >> 2; const int sc = srccol(kind, p0, R);
    const float* wp = W + (size_t)(8 * ko) * Ns + (sc >= 0 ? sc : 0);
    f32x4 mx = {0.f, 0.f, 0.f, 0.f};
    for (int kb = 0; kb < Ks / 128; ++kb) {
#pragma unroll
        for (int i = 0; i < 8; ++i) { const f32x4 v = *(const f32x4*)(wp + (size_t)(128 * kb + i) * Ns);
            mx[0] = fmaxf(mx[0], fabsf(v[0])); mx[1] = fmaxf(mx[1], fabsf(v[1])); mx[2] = fmaxf(mx[2], fabsf(v[2])); mx[3] = fmaxf(mx[3], fabsf(v[3])); } }
#pragma unroll
    for (int o = 4; o < 64; o <<= 1)
#pragma unroll
        for (int j = 0; j < 4; ++j) mx[j] = fmaxf(mx[j], __shfl_xor(mx[j], o));
    if (sc < 0) mx = (f32x4){0.f, 0.f, 0.f, 0.f};
    f32x4 qs;
#pragma unroll
    for (int j = 0; j < 4; ++j) qs[j] = mx[j] > 0.f ? 127.0f / mx[j] : 0.f;
    if (ko == 0) *(f32x4*)(CS + R) = mx * (1.0f / 127.0f);
    for (int kb = 0; kb < Ks / 128; ++kb) { f32x4 v[8];
#pragma unroll
        for (int i = 0; i < 8; ++i) v[i] = *(const f32x4*)(wp + (size_t)(128 * kb + i) * Ns);
#pragma unroll
        for (int j = 0; j < 4; ++j) { v2u o; o.x = pk4_i8(v[0][j] * qs[j], v[1][j] * qs[j], v[2][j] * qs[j], v[3][j] * qs[j]); o.y = pk4_i8(v[4][j] * qs[j], v[5][j] * qs[j], v[6][j] * qs[j], v[7][j] * qs[j]);
            *(v2u*)(Bt + (size_t)(R + j) * Ks + 128 * kb + 8 * ko) = o; } }
}

struct I8Job { const float* W; int Ns, kind, p0; unsigned char* Bt; float* CS; int item; };
__device__ __forceinline__ void wconv_i8_load(const I8Job& J, int wave, int lane, f32x4 (&v)[8]) {
    const int nq = lane & 3, ko = lane >> 2; const int sc = srccol(J.kind, J.p0, 16 * J.item + 4 * nq);
    const float* wp = J.W + (size_t)(128 * wave + 8 * ko) * J.Ns + (sc >= 0 ? sc : 0);
#pragma unroll
    for (int i = 0; i < 8; ++i) v[i] = *(const f32x4*)(wp + (size_t)i * J.Ns);
}
__device__ __forceinline__ void wconv_i8_finish(const I8Job& J, int wave, int lane, f32x4 (&v)[8], LAS float* mxs) {
    const int nq = lane & 3, ko = lane >> 2; const int R = 16 * J.item + 4 * nq; const int sc = srccol(J.kind, J.p0, R);
    f32x4 mx = {0.f, 0.f, 0.f, 0.f};
#pragma unroll
    for (int i = 0; i < 8; ++i) { if (sc < 0) v[i] = (f32x4){0.f, 0.f, 0.f, 0.f};
        mx[0] = fmaxf(mx[0], fabsf(v[i][0])); mx[1] = fmaxf(mx[1], fabsf(v[i][1])); mx[2] = fmaxf(mx[2], fabsf(v[i][2])); mx[3] = fmaxf(mx[3], fabsf(v[i][3])); }
#pragma unroll
    for (int o = 4; o < 64; o <<= 1)
#pragma unroll
        for (int j = 0; j < 4; ++j) mx[j] = fmaxf(mx[j], __shfl_xor(mx[j], o));
    if (ko == 0) *(LAS f32x4*)(mxs + wave * 16 + 4 * nq) = mx;
    LDS_WAIT(); __builtin_amdgcn_s_barrier();
#pragma unroll
    for (int w2 = 0; w2 < 8; ++w2) { const f32x4 o = *(const LAS f32x4*)(mxs + w2 * 16 + 4 * nq); mx[0] = fmaxf(mx[0], o[0]); mx[1] = fmaxf(mx[1], o[1]); mx[2] = fmaxf(mx[2], o[2]); mx[3] = fmaxf(mx[3], o[3]); }
    f32x4 qs;
#pragma unroll
    for (int j = 0; j < 4; ++j) qs[j] = mx[j] > 0.f ? 127.0f / mx[j] : 0.f;
    if (wave == 0 && ko == 0) *(f32x4*)(J.CS + R) = mx * (1.0f / 127.0f);
#pragma unroll
    for (int j = 0; j < 4; ++j) { v2u o; o.x = pk4_i8(v[0][j] * qs[j], v[1][j] * qs[j], v[2][j] * qs[j], v[3][j] * qs[j]); o.y = pk4_i8(v[4][j] * qs[j], v[5][j] * qs[j], v[6][j] * qs[j], v[7][j] * qs[j]);
        *(v2u*)(J.Bt + (size_t)(R + j) * 1024 + 128 * wave + 8 * ko) = o; }
}

__device__ __forceinline__ void rms_row_to_i8(const float* xrow, const float* g, unsigned char* orow, float* rs, int lane) {
    const f32x4* xr = (const f32x4*)xrow + lane; const f32x4* gr = (const f32x4*)g + lane; f32x4 v[4]; float s = 0.f;
#pragma unroll
    for (int j = 0; j < 4; ++j) { v[j] = xr[64 * j]; s += (v[j].x * v[j].x + v[j].y * v[j].y) + (v[j].z * v[j].z + v[j].w * v[j].w); }
    const float r = rsqrtf(wave_sum(s) * (1.f / DM) + RMS_EPS); float mx = 0.f;
#pragma unroll
    for (int j = 0; j < 4; ++j) { const f32x4 gg = gr[64 * j]; v[j] = (f32x4){v[j].x * r * gg.x, v[j].y * r * gg.y, v[j].z * r * gg.z, v[j].w * r * gg.w};
        mx = fmaxf(fmaxf(mx, fmaxf(fabsf(v[j].x), fabsf(v[j].y))), fmaxf(fabsf(v[j].z), fabsf(v[j].w))); }
#pragma unroll
    for (int o = 1; o < 64; o <<= 1) mx = fmaxf(mx, __shfl_xor(mx, o));
    const float sc = mx > 0.f ? 127.0f / mx : 0.f;
    unsigned* o4 = (unsigned*)orow + lane;
#pragma unroll
    for (int j = 0; j < 4; ++j) o4[64 * j] = pk4_i8(v[j].x * sc, v[j].y * sc, v[j].z * sc, v[j].w * sc);
    if (lane == 0) *rs = mx * (1.0f / 127.0f);
}
struct KArgs { const void* in[18]; float* out; unsigned char* ws; int ph_lo, ph_hi; };
#ifndef MK_N_LAUNCHES
#define MK_N_LAUNCHES 1
#endif
constexpr int NPHASE = 20;
constexpr int NJOBS = 10 + 2 + 16;

__device__ __forceinline__ void get_job(int j, const __attribute__((address_space(4))) KArgs* ap, WJob& J) {
    unsigned char* ws = ap->ws;
    if (j < 10) { const int l = j / 5, ty = j % 5; bf16* wl = (bf16*)(ws + OFF_WL) + (size_t)l * W_LAYER_E;
        if (ty == 0) { J.W = (const float*)ap->in[3] + (size_t)l * DM * IN_COLS; J.ksc = nullptr; J.Bt = wl; J.Ks = DM; J.Ns = IN_COLS; J.Kd = DM; J.Nd = IN_N; J.kind = 2; J.p0 = 0; J.f8s = 0.f; }
        else if (ty == 1) { J.W = (const float*)ap->in[6] + (size_t)l * 256 * QM_W; J.ksc = (const float*)ap->in[4] + l * 256; J.Bt = wl + W_IN_E; J.Ks = 256; J.Ns = QM_W; J.Kd = 256; J.Nd = QM_W; J.kind = 3; J.p0 = 0; J.f8s = 0.f; }
        else if (ty == 2) { J.W = (const float*)ap->in[7] + (size_t)l * 128 * KVM_W; J.ksc = (const float*)ap->in[5] + l * 128; J.Bt = wl + W_IN_E + (size_t)QM_W * 256; J.Ks = 128; J.Ns = KVM_W; J.Kd = 256; J.Nd = KVM_W; J.kind = 1; J.p0 = 0; J.f8s = 0.f; }
        else if (ty == 3) { J.W = (const float*)ap->in[9] + (size_t)l * Y3_W * DM; J.ksc = nullptr; J.Bt = wl + W_IN_E + W_UP_E; J.Ks = Y3_W; J.Ns = DM; J.Kd = Y3_W; J.Nd = DM; J.kind = 1; J.p0 = 0; J.f8s = 0.f; }
        else { J.W = (const float*)ap->in[10] + (size_t)l * DM * DM; J.ksc = nullptr; J.Bt = wl + W_IN_E + W_UP_E + W_BR_E; J.Ks = DM; J.Ns = DM; J.Kd = DM; J.Nd = DM; J.kind = 1; J.p0 = 0; J.f8s = 0.f; }
    } else if (j == 10) { J.W = (const float*)ap->in[12]; J.ksc = nullptr; J.Bt = (bf16*)(ws + OFF_WDGU); J.Ks = DM; J.Ns = 2 * DFF; J.Kd = DM; J.Nd = 2 * DFF; J.kind = 4; J.p0 = DFF; J.f8s = 0.f; }
    else if (j == 11) { J.W = (const float*)ap->in[13]; J.ksc = nullptr; J.Bt = (bf16*)(ws + OFF_WDDN); J.Ks = DFF; J.Ns = DM; J.Kd = DFF; J.Nd = DM; J.kind = 1; J.p0 = 0; J.f8s = DENSE_DOWN_F8 ? W8S_DN : 0.f; }
    else if (j < 20) { const int e = j - 12; J.W = (const float*)ap->in[15] + (size_t)e * DM * 2 * EFF; J.ksc = nullptr; J.Bt = (bf16*)(ws + OFF_WEGU + (size_t)e * 2 * EFF * DM); J.Ks = DM; J.Ns = 2 * EFF; J.Kd = DM; J.Nd = 2 * EFF; J.kind = 4; J.p0 = EFF; J.f8s = W8S_GU; }
    else { const int e = j - 20; J.W = (const float*)ap->in[16] + (size_t)e * EFF * DM; J.ksc = nullptr; J.Bt = (bf16*)(ws + OFF_WEDN + (size_t)e * DM * EFF); J.Ks = EFF; J.Ns = DM; J.Kd = EFF; J.Nd = DM; J.kind = 1; J.p0 = 0; J.f8s = W8S_DN; }
}
__device__ __forceinline__ int job_items(int j) {
    if (j < 10) { const int ty = j % 5; return ty == 0 ? 0   : ty == 1 ? (QM_W / 32) * 4 : ty == 2 ? (KVM_W / 32) * 4 : ty == 3 ? (DM / 32) * (Y3_W / 64) : (DM / 32) * (DM / 64); }
    if (j == 10) return 0;
    if (j == 11) return (DM / 32) * (DFF / 64);
    if (j < 20) return 0;
    return (DM / 32) * (EFF / 64);
}

#define SSQ ((float*)(ws + OFF_SSQ))
#define LOGF ((float*)(ws + OFF_LOGF))
#define CUM ((float*)(ws + OFF_CUM))
#define KMEAN ((float*)(ws + OFF_KMEAN))
#define KNM ((float*)(ws + OFF_KNM))
#define R64C ((float*)(ws + OFF_R64C))
#define R64S ((float*)(ws + OFF_R64S))
#define R32C ((float*)(ws + OFF_R32C))
#define R32S ((float*)(ws + OFF_R32S))
#define TOKI ((int*)(ws + OFF_TOKI))
#define TOKW ((float*)(ws + OFF_TOKW))
#define TOKR ((int*)(ws + OFF_TOKR))
#define CNT ((int*)(ws + OFF_CNT))
#define MTAB ((int*)(ws + OFF_MTAB))
#define XN8 ((unsigned char*)(ws + OFF_XN8))
#define RSX ((float*)(ws + OFF_RSX))
#define RSG ((float*)(ws + OFF_RSG))
#define XS16 ((bf16*)(ws + OFF_XS))
#define XNQ ((unsigned char*)(ws + OFF_XN))
#define CSC ((float*)(ws + OFF_CSC))
#define CSIN ((float*)(ws + OFF_CSIN))
#define RSIN ((float*)(ws + OFF_RSIN))
#define XN ((bf16*)(ws + OFF_XN))
#define QM ((bf16*)(ws + OFF_QM))
#define LAT ((bf16*)(ws + OFF_LAT))
#define KR ((bf16*)(ws + OFF_KR))
#define FQ ((bf16*)(ws + OFF_FQ))
#define FK ((bf16*)(ws + OFF_FK))
#define FV ((bf16*)(ws + OFF_FV))
#define MQ ((bf16*)(ws + OFF_MQ))
#define MK ((bf16*)(ws + OFF_MK))
#define MV ((bf16*)(ws + OFF_MV))
#define GT ((bf16*)(ws + OFF_GT))
#define KVM ((bf16*)(ws + OFF_KVM))
#define MERGED ((bf16*)(ws + OFF_MERGED))
#define Y3 ((bf16*)(ws + OFF_Y3))
#define ACTD ((bf16*)(ws + OFF_ACTD))
#define ACTM ((unsigned char*)(ws + OFF_ACTM))
#define XG ((unsigned char*)(ws + OFF_XG))
#define YE ((bf16*)(ws + OFF_YE))
__global__ void __launch_bounds__(NWAVES * 64, 2) mega_fwd(KArgs args) {
    extern __shared__ __attribute__((aligned(16))) unsigned char lds[];
    Frame F;
    F.lds = (LAS unsigned char*)lds;
    volatile LAS unsigned* MISC = (volatile LAS unsigned*)(F.lds + MISC_OFF);
    F.tid = threadIdx.x; F.lane = F.tid & 63; F.wave = __builtin_amdgcn_readfirstlane(F.tid >> 6);
    F.G = gridDim.x; F.bid = blockIdx.x; { const int bx = blockIdx.x; F.vcu = (F.G % 8 == 0) ? (bx % 8) * (F.G / 8) + bx / 8 : bx; }
    unsigned char* ws0 = args.ws;
    gu32* ctl = (gu32*)(ws0 + WS_CTL);
    for (int u = F.tid; u < (LDS_BYTES - LDSCTL_OFF) / 4; u += NWAVES * 64) ((LAS unsigned*)(F.lds + LDSCTL_OFF))[u] = 0u;
    __syncthreads();
    XcdBarrier bar = xcd_barrier_post((unsigned*)(ctl + CW_BAR), MISC + 8);
    const int lo = args.ph_lo, hi = args.ph_hi;
#ifndef PH_MASK
#define PH_MASK 0xFFFFFFu
#endif
#ifndef REP_MASK
#define REP_MASK 0u
#endif
#ifndef REP_ATT
#define REP_ATT 0u
#endif
#define REPEAT(k) for (int rep_ = 0; rep_ < ((((unsigned)REP_MASK >> (k)) & 1u) ? 2 : 1); ++rep_)
#define IN(k) (lo <= (k) && (k) < hi && ((PH_MASK >> (k)) & 1u))
#define SEAM(k) do { if (IN(k) && IN((k) + 1)) xcd_barrier(bar, F.wave); } while (0)
#define INL(j) (lo <= pb + (j) && pb + (j) < hi && ((PH_MASK >> (1 + (j))) & 1u))
#define SEAML(j) do { if (lo <= pb + (j) && pb + (j) + 1 < hi) xcd_barrier(bar, F.wave); } while (0)
#define PHB const int wave = F.wave; const int lane = pg8::lane_id_opaque(); const int tid = wave * 64 + lane; const int gw = F.vcu * NWAVES + wave; (void)lane; (void)gw; (void)tid; \
    const __attribute__((address_space(4))) KArgs* ka = (const __attribute__((address_space(4))) KArgs*)__builtin_amdgcn_kernarg_segment_ptr(); asm volatile("" : "+s"(ka)); unsigned char* ws = ka->ws; float* xs = ka->out; const float* x_in = (const float*)ka->in[0]; \
    int G = F.G, bid = F.bid, NGW; asm volatile("" : "+s"(G), "+s"(bid)); NGW = G * NWAVES; (void)xs; (void)x_in; (void)NGW; (void)bid
    if (IN(0)) { asm volatile("; PHASE_MARK 0" ::: "memory"); PHB;
        REPEAT(0) {
        {
            WJob Jc, Jn; int itc = 0, itn = 0; f32x4 vc[8], vn[8];
            auto decode = [&](int git, WJob& J, int& it) -> bool { int jb = 0;
                for (int j = 0; j < NJOBS; ++j) { const int ni = job_items(j); if (git < jb + ni) { get_job(j, ka, J); it = git - jb; return true; } jb += ni; }
                return false; };
            int git = gw; bool have = decode(git, Jc, itc);
            if (have) wconv_load(Jc, itc, lane, vc);
            while (have) {
                const bool hn = decode(git + NGW, Jn, itn);
                if (hn) wconv_load(Jn, itn, lane, vn);
                wconv_store(Jc, itc, lane, vc);
                Jc = Jn; itc = itn; have = hn; git += NGW;
#pragma unroll
                for (int i = 0; i < 8; ++i) vc[i] = vn[i];
            } }
        { LAS float* mxs = (LAS float*)(F.lds + RING_OFF); int par = 0;
          constexpr int NI_IN = 2 * (IN_N / 16), NI_DG = 2 * DFF / 16, NI_EG = 2 * EFF / 16, NI_ALL = NI_IN + NI_DG + 8 * NI_EG;
          auto getj = [&](int it, I8Job& J) __attribute__((always_inline)) {
              if (it < NI_IN) { const int l2 = it / (IN_N / 16); J.W = (const float*)ka->in[3] + (size_t)l2 * DM * IN_COLS; J.Ns = IN_COLS; J.kind = 2; J.p0 = 0; J.Bt = (unsigned char*)((bf16*)(ws + OFF_WL) + (size_t)l2 * W_LAYER_E); J.CS = CSIN + l2 * IN_N; J.item = it - l2 * (IN_N / 16); }
              else if (it < NI_IN + NI_DG) { J.W = (const float*)ka->in[12]; J.Ns = 2 * DFF; J.kind = 4; J.p0 = DFF; J.Bt = (unsigned char*)(ws + OFF_WDGU); J.CS = CSC; J.item = it - NI_IN; }
              else { const int i2 = it - NI_IN - NI_DG, e = i2 / NI_EG; J.W = (const float*)ka->in[15] + (size_t)e * DM * 2 * EFF; J.Ns = 2 * EFF; J.kind = 4; J.p0 = EFF; J.Bt = (unsigned char*)(ws + OFF_WEGU + (size_t)e * 2 * EFF * DM); J.CS = (float*)(ws + OFF_CSE) + e * 2 * EFF; J.item = i2 - e * NI_EG; } };
          I8Job Jc, Jn; f32x4 vc[8], vn[8]; int it = bid; bool have = it < NI_ALL;
          if (have) { getj(it, Jc); wconv_i8_load(Jc, wave, lane, vc); }
          while (have) { const bool hn = it + G < NI_ALL;
              if (hn) { getj(it + G, Jn); wconv_i8_load(Jn, wave, lane, vn); }
              wconv_i8_finish(Jc, wave, lane, vc, mxs + par * 128);
              Jc = Jn; have = hn; it += G; par ^= 1;
#pragma unroll
              for (int i = 0; i < 8; ++i) vc[i] = vn[i]; }
          LDS_WAIT(); __syncthreads(); }
        const int* pos = (const int*)ka->in[1];
        for (int i = bid * (NWAVES * 64) + tid; i < MTOK * 32; i += G * NWAVES * 64) { const int tok = i >> 5, f = i & 31;
            const float p = (float)pos[tok];
            { const float inv = expf(-9.210340371976184f * (float)f * (2.0f / 64.0f)); const float ang = p * inv; const float n = rintf(ang * 0.15915494309189535f);
              float r = fmaf(-n, 6.28318548202514648f, ang); r = fmaf(-n, -1.7484555e-7f, r); R64C[i] = __cosf(r); R64S[i] = __sinf(r); }
            if (f < 16) { const float inv = expf(-9.210340371976184f * (float)f * (2.0f / 32.0f)); const float ang = p * inv; const float n = rintf(ang * 0.15915494309189535f);
              float r = fmaf(-n, 6.28318548202514648f, ang); r = fmaf(-n, -1.7484555e-7f, r); R32C[tok * 16 + f] = __cosf(r); R32S[tok * 16 + f] = __sinf(r); } }
        rms_rows_to_i8<true>(x_in, (const float*)ka->in[2], XNQ, RSIN, gw, NGW, lane);
        }
    }
    SEAM(0);

    {
        constexpr int l = 0;
        const int pb = 1 + 9 * l;
        if (INL(0)) { asm volatile("; PHASE_MARK L0" ::: "memory"); PHB;
            pg8::Gemm g{(const bf16*)XNQ, (const bf16*)(ws + OFF_WL) + (size_t)l * W_LAYER_E, DM / 2, DM / 2}; pg8::GridOrder S; S.init(MTOK / 256, IN_N / 256, G, bid);
            pg8::EpiIn E{ws, (const float*)ka->in[8] + l * 8, CSIN + l * IN_N};
            REPEAT(pb + 0) pg8::gemm_phase<pg8::EpiIn, pg8::GridOrder, false, true, true, true>(F.lds + RING_OFF, g, S, E, wave);
#ifdef PROBE_NULL_EPI_IN
            { pg8::EpiNull EN; pg8::gemm_phase<pg8::EpiNull, pg8::GridOrder, false, true, true, true>(F.lds + RING_OFF, g, S, EN, wave); }
#endif
        }
        SEAML(0);
        if (INL(1)) { asm volatile("; PHASE_MARK L1" ::: "memory"); PHB;
            for (int it = F.vcu; it < 64; it += G) {
                const int b = it >> 3, h = it & 7; LAS float* part = (LAS float*)(F.lds + RING_OFF);
                float v[8]; float run = 0.f;
#pragma unroll
                for (int k = 0; k < 8; ++k) { run += LOGF[((size_t)b * SEQ + tid * 8 + k) * 8 + h]; v[k] = run; }
                float inc = run;
#pragma unroll
                for (int o = 1; o < 64; o <<= 1) { const float t = __shfl_up(inc, o); if (lane >= o) inc += t; }
                if (lane == 63) part[wave] = inc;
                LDS_WAIT(); __syncthreads();
                float base = inc - run;
                for (int w = 0; w < wave; ++w) base += part[w];
                float* dst = CUM + ((size_t)b * 8 + h) * SEQ + tid * 8;
                *(f32x4*)dst = (f32x4){v[0] + base, v[1] + base, v[2] + base, v[3] + base}; *(f32x4*)(dst + 4) = (f32x4){v[4] + base, v[5] + base, v[6] + base, v[7] + base};
                __syncthreads();
                float kn = 0.f;
                for (int k = 0; k < 8; ++k) { const v4u* kp = (const v4u*)(FK + ((size_t)b * SEQ + tid * 8 + k) * BR_W + h * 64); float sq = 0.f;
#pragma unroll
                    for (int c = 0; c < 8; ++c) { const v4u w = kp[c];
#pragma unroll
                        for (int e = 0; e < 4; ++e) { const float lo = bfl(w[e]), hi2 = bfh(w[e]); sq += lo * lo + hi2 * hi2; } }
                    kn = fmaxf(kn, sq); }
#pragma unroll
                for (int o = 1; o < 64; o <<= 1) kn = fmaxf(kn, __shfl_xor(kn, o));
                if (lane == 0) part[8 + wave] = kn;
                LDS_WAIT(); __syncthreads();
                if (tid == 0) { float m = 0.f; for (int w = 0; w < 8; ++w) m = fmaxf(m, part[8 + w]); KNM[it] = sqrtf(m); }
                __syncthreads();
            }
            for (int it = F.vcu - 64; it < 128; it += G) { if (it < 0) continue;
                const bf16* src = MK + (size_t)it * 256 * BR_W + tid; float s = 0.f;
#pragma unroll 8
                for (int r = 0; r < 256; ++r) s += __uint_as_float((unsigned)src[(size_t)r * BR_W] << 16);
                KMEAN[(size_t)it * 512 + tid] = s * (1.0f / 256.0f); }
            VM_WAIT(); __syncthreads();
            pg8::Gemm g{LAT, ((const bf16*)(ws + OFF_WL) + (size_t)l * W_LAYER_E) + W_IN_E, LAT_W, 256}; pg8::MidOrder S; S.init(MTOK / 256, UP_N / 256, G, bid);
            pg8::EpiUp E{ws};
            REPEAT(pb + 1) pg8::gemm_phase<pg8::EpiUp, pg8::MidOrder>(F.lds + RING_OFF, g, S, E, wave);
        }
        SEAML(1);
        if (INL(2)) { asm volatile("; PHASE_MARK L2" ::: "memory"); PHB;
            att::Args A0{(const att::bf16*)QM, (const att::bf16*)KVM, (const att::bf16*)KR, (const att::bf16*)KVM + 64, (att::bf16*)Y3, nullptr, nullptr, QM_W, KVM_W, KVM_W, Y3_W, 96, 128};
            att::Args A1{(const att::bf16*)FQ, (const att::bf16*)FK, nullptr, (const att::bf16*)FV, (att::bf16*)Y3 + 512, CUM, KNM, BR_W, BR_W, BR_W, Y3_W, 64, 64};
            att::Args A2{(const att::bf16*)MQ, (const att::bf16*)MK, nullptr, (const att::bf16*)MV, (att::bf16*)Y3 + 1024, nullptr, KMEAN, BR_W, BR_W, BR_W, Y3_W, 64, 64};
            char* shm = (char*)lds + RING_OFF;
            for (int rep_ = 0; rep_ < (((REP_ATT >> 0) & 1u) ? 2 : 1); ++rep_)
            for (int v = F.vcu; v < 512; v += G) { const int bh = v >> 3, s = v & 7;
                att::attn_unit<0>(bh >> 3, bh & 7, 15 - s, A0, shm, wave); att::attn_unit<0>(bh >> 3, bh & 7, s, A0, shm, wave); }
            for (int rep_ = 0; rep_ < (((REP_ATT >> 1) & 1u) ? 2 : 1); ++rep_)
            for (int v = F.vcu; v < 512; v += G) { const int bh = v >> 3, s = v & 7;
                att::attn_unit<1>(bh >> 3, bh & 7, 15 - s, A1, shm, wave); att::attn_unit<1>(bh >> 3, bh & 7, s, A1, shm, wave); }
            for (int rep_ = 0; rep_ < (((REP_ATT >> 2) & 1u) ? 2 : 1); ++rep_)
            for (int v = F.vcu; v < 512; v += G) { const int bh = v >> 3, s = v & 7;
                att::attn_unit<2>(bh >> 3, bh & 7, 15 - s, A2, shm, wave); att::attn_unit<2>(bh >> 3, bh & 7, s, A2, shm, wave); }
        }
        SEAML(2);
        if (INL(3)) { asm volatile("; PHASE_MARK L3" ::: "memory"); PHB;
            pg8::Gemm g{Y3, ((const bf16*)(ws + OFF_WL) + (size_t)l * W_LAYER_E) + W_IN_E + W_UP_E, Y3_W, Y3_W}; pg8::GridOrder S; S.init(MTOK / 256, DM / 256, G, bid);
            pg8::EpiMerge E{GT, MERGED};
            REPEAT(pb + 3) pg8::gemm_phase<pg8::EpiMerge, pg8::GridOrder>(F.lds + RING_OFF, g, S, E, wave);
        }
        SEAML(3);
        if (INL(4)) { asm volatile("; PHASE_MARK L4" ::: "memory"); PHB;
            pg8::Gemm g{MERGED, ((const bf16*)(ws + OFF_WL) + (size_t)l * W_LAYER_E) + W_IN_E + W_UP_E + W_BR_E, DM, DM}; pg8::GridOrder S; S.init(MTOK / 256, DM / 256, G, bid);
            pg8::EpiResidB<l == 0> E{l == 0 ? (const void*)x_in : (const void*)XS16, XS16, 1.0f};
            REPEAT(l == 0 ? pb + 4 : 31) pg8::gemm_phase<pg8::EpiResidB<l == 0>, pg8::GridOrder>(F.lds + RING_OFF, g, S, E, wave);
        }
        SEAML(4);
        if (l == 0) {
            if (IN(6)) { asm volatile("; PHASE_MARK 6" ::: "memory"); PHB; const float* gf = (const float*)ka->in[11]; REPEAT(6) rms_rows_to_i8<false>(XS16, gf, XNQ, RSX, gw, NGW, lane); }
            SEAM(6);
            if (IN(7)) { asm volatile("; PHASE_MARK 7" ::: "memory"); PHB;
                pg8::Gemm g{(const bf16*)XNQ, (const bf16*)(ws + OFF_WDGU), DM / 2, DM / 2}; pg8::GridOrder S; S.init(MTOK / 256, 2 * DFF / 256, G, bid);
#if DENSE_DOWN_F8
                pg8::EpiSwigluI8 E{(unsigned char*)ACTD, DFF, RSX, CSC};
                REPEAT(7) pg8::gemm_phase<pg8::EpiSwigluI8, pg8::GridOrder, false, true, true, true>(F.lds + RING_OFF, g, S, E, wave);
#else
                pg8::EpiSwigluI8B E{ACTD, DFF, RSX, CSC};
                REPEAT(7) pg8::gemm_phase<pg8::EpiSwigluI8B, pg8::GridOrder, false, true, true, true>(F.lds + RING_OFF, g, S, E, wave);
#endif
            }
            SEAM(7);
            if (IN(8)) { asm volatile("; PHASE_MARK 8" ::: "memory"); PHB;
#if DENSE_DOWN_F8
                pg8::Gemm g{(const bf16*)ACTD, (const bf16*)(ws + OFF_WDDN), DFF / 2, DFF / 2}; pg8::GridOrder S; S.init(MTOK / 256, DM / 256, G, bid);
                pg8::EpiResidB<false> E{(const void*)XS16, XS16, 1.0f / (A8S_ACT * W8S_DN)};
                pg8::gemm_phase<pg8::EpiResidB<false>, pg8::GridOrder, true, true, true, false, false, false>(F.lds + RING_OFF, g, S, E, wave);
#else
                pg8::Gemm g{ACTD, (const bf16*)(ws + OFF_WDDN), DFF, DFF}; pg8::GridOrder S; S.init(MTOK / 256, DM / 256, G, bid);
                pg8::EpiResidB<false> E{(const void*)XS16, XS16, 1.0f};
                pg8::gemm_phase<pg8::EpiResidB<false>, pg8::GridOrder>(F.lds + RING_OFF, g, S, E, wave);
#endif
            }
            SEAM(8);
            if (IN(9)) { asm volatile("; PHASE_MARK 9" ::: "memory"); PHB; const float* gm = (const float*)ka->in[2] + DM; REPEAT(9) rms_rows_to_i8<false>(XS16, gm, XNQ, RSIN, gw, NGW, lane); }
            SEAM(9);
        } else {
            if (IN(15)) { asm volatile("; PHASE_MARK 15" ::: "memory"); PHB;
                const float* gf = (const float*)ka->in[11] + DM;
                LAS int* cnt = (LAS int*)(F.lds + RING_OFF + 32768);
                const float* wr = (const float*)ka->in[14];
                f32x4 w0[4][4], w1[4][4], gg[4];
#pragma unroll
                for (int j = 0; j < 4; ++j) { gg[j] = ((const f32x4*)gf + lane)[64 * j];
#pragma unroll
                    for (int q = 0; q < 4; ++q) { const f32x4* wp = (const f32x4*)(wr + (size_t)(256 * j + 4 * lane + q) * 8); w0[j][q] = wp[0]; w1[j][q] = wp[1]; } }
                const bool b0_ = (lane & 1) != 0, b1_ = (lane & 2) != 0, b2_ = (lane & 4) != 0;
                REPEAT(15) for (int c = bid; c < 256; c += G) {
                    if (tid < 64) cnt[tid] = 0;
                    LDS_WAIT(); __syncthreads();
                    const int t0 = c * 128 + wave * 16;
                    auto row_do = [&](int t, f32x4 (&v)[4]) __attribute__((always_inline)) {
                        float s = 0.f;
#pragma unroll
                        for (int j = 0; j < 4; ++j) s += (v[j].x * v[j].x + v[j].y * v[j].y) + (v[j].z * v[j].z + v[j].w * v[j].w);
                        const float r = rsqrtf(wave_sum(s) * (1.f / DM) + RMS_EPS);
                        float lg[8];
#pragma unroll
                        for (int e = 0; e < 8; ++e) lg[e] = 0.f;
                        float mx = 0.f;
#pragma unroll
                        for (int j = 0; j < 4; ++j) { const f32x4 hv = {v[j].x * r * gg[j].x, v[j].y * r * gg[j].y, v[j].z * r * gg[j].z, v[j].w * r * gg[j].w}; v[j] = hv;
                            mx = fmaxf(fmaxf(mx, fmaxf(fabsf(hv.x), fabsf(hv.y))), fmaxf(fabsf(hv.z), fabsf(hv.w)));
#pragma unroll
                            for (int q = 0; q < 4; ++q) { const f32x4 a0 = w0[j][q], a1 = w1[j][q]; const float hh = hv[q];
                                lg[0] += hh * a0.x; lg[1] += hh * a0.y; lg[2] += hh * a0.z; lg[3] += hh * a0.w; lg[4] += hh * a1.x; lg[5] += hh * a1.y; lg[6] += hh * a1.z; lg[7] += hh * a1.w; } }
#pragma unroll
                        for (int o = 1; o < 64; o <<= 1) mx = fmaxf(mx, __shfl_xor(mx, o));
                        { const float sc = mx > 0.f ? 127.0f / mx : 0.f; unsigned* o4 = (unsigned*)(XN8 + (size_t)t * DM) + lane;
#pragma unroll
                          for (int j = 0; j < 4; ++j) o4[64 * j] = pk4_i8(v[j].x * sc, v[j].y * sc, v[j].z * sc, v[j].w * sc);
                          if (lane == 0) RSX[t] = mx * (1.0f / 127.0f); }
                        float y4[4], y2[2], y1;
#pragma unroll
                        for (int k = 0; k < 4; ++k) { const float keep = b0_ ? lg[4 + k] : lg[k], send = b0_ ? lg[k] : lg[4 + k]; y4[k] = keep + __shfl_xor(send, 1); }
#pragma unroll
                        for (int k = 0; k < 2; ++k) { const float keep = b1_ ? y4[2 + k] : y4[k], send = b1_ ? y4[k] : y4[2 + k]; y2[k] = keep + __shfl_xor(send, 2); }
                        { const float keep = b2_ ? y2[1] : y2[0], send = b2_ ? y2[0] : y2[1]; y1 = keep + __shfl_xor(send, 4); }
                        y1 += __shfl_xor(y1, 8); y1 += __shfl_xor(y1, 16); y1 += __shfl_xor(y1, 32);
#pragma unroll
                        for (int e = 0; e < 8; ++e) lg[e] = __uint_as_float(__builtin_amdgcn_readlane(__float_as_uint(y1), ((e >> 2) & 1) | (((e >> 1) & 1) << 1) | ((e & 1) << 2)));
                        int e0 = 0; float b0 = lg[0];
#pragma unroll
                        for (int e = 1; e < 8; ++e) if (lg[e] > b0) { b0 = lg[e]; e0 = e; }
                        int e1 = 0; float b1 = -INFINITY;
#pragma unroll
                        for (int e = 0; e < 8; ++e) if (e != e0 && lg[e] > b1) { b1 = lg[e]; e1 = e; }
                        if (lane == 0) { const float w1v = 1.0f / (1.0f + __expf(b0 - b1)); const float w0v = 1.0f - w1v;
                            volatile LAS int* cw = cnt + wave * 8; const int i0 = cw[e0]; cw[e0] = i0 + 1; const int i1 = cw[e1]; cw[e1] = i1 + 1;
                            *(i32x4*)(TOKI + (size_t)t * 4) = (i32x4){e0, e1, i0, i1}; *(f32x2*)(TOKW + (size_t)t * 2) = (f32x2){w0v, w1v}; }
                    };
                    f32x4 na[4], nb[4]; ld_row16(XS16 + (size_t)t0 * DM, lane, na); ld_row16(XS16 + (size_t)(t0 + 1) * DM, lane, nb);
                    for (int i = 0; i < 16; i += 2) { const int t = t0 + i;
                        f32x4 va[4], vb[4];
#pragma unroll
                        for (int j = 0; j < 4; ++j) { va[j] = na[j]; vb[j] = nb[j]; }
                        if (i + 2 < 16) { ld_row16(XS16 + (size_t)(t + 2) * DM, lane, na); ld_row16(XS16 + (size_t)(t + 3) * DM, lane, nb); }
                        row_do(t, va); row_do(t + 1, vb);
                    }
                    LDS_WAIT(); __syncthreads();
                    if (tid < 8) { int* wp = (int*)(ws + OFF_WPRE) + c * 64 + tid; int run = 0;
#pragma unroll
                        for (int w = 0; w < 8; ++w) { wp[w * 8] = run; run += cnt[w * 8 + tid]; }
                        CNT[c * 8 + tid] = run; }
                    __syncthreads();
                }
            }
            SEAM(15);
            if (IN(16)) { asm volatile("; PHASE_MARK 16" ::: "memory"); PHB;
                LAS int* PRE = (LAS int*)(F.lds + RING_OFF);
                LAS int* TOT = PRE + 2048;
                { const int e = wave; int cv[4]; int run = 0;
#pragma unroll
                    for (int k = 0; k < 4; ++k) { cv[k] = CNT[(lane * 4 + k) * 8 + e]; run += cv[k]; }
                    int inc = run;
#pragma unroll
                    for (int o = 1; o < 64; o <<= 1) { const int t = __shfl_up(inc, o); if (lane >= o) inc += t; }
                    int ex = inc - run;
#pragma unroll
                    for (int k = 0; k < 4; ++k) { PRE[e * 256 + lane * 4 + k] = ex; ex += cv[k]; }
                    if (lane == 63) TOT[e] = inc; }
                LDS_WAIT(); __syncthreads();
                if (tid == 0) { int st = 0;
                    for (int e = 0; e < 8; ++e) { TOT[8 + e] = st; const int nb = (TOT[e] + 255) >> 8;
                        if (bid == 0) for (int k = 0; k < nb; ++k) MTAB[(st >> 8) + k] = e;
                        st += nb << 8; }
                    if (bid == 0) MTAB[264] = st >> 8; }
                LDS_WAIT(); __syncthreads();
                REPEAT(16) for (int c = bid; c < 256; c += G)
                    for (int i = 0; i < 16; ++i) { const int t = c * 128 + wave * 16 + i; const i32x4 ti = *(const i32x4*)(TOKI + (size_t)t * 4);
                        const int* wpre = (const int*)(ws + OFF_WPRE) + (c * 8 + wave) * 8;
                        const int r0 = TOT[8 + ti.x] + PRE[ti.x * 256 + c] + wpre[ti.x] + ti.z, r1 = TOT[8 + ti.y] + PRE[ti.y * 256 + c] + wpre[ti.y] + ti.w;
                        if (lane == 0) { *(i32x2*)(TOKR + (size_t)t * 2) = (i32x2){r0, r1}; const float rsv = RSX[t]; RSG[r0] = rsv; RSG[r1] = rsv; }
                        const v4u a = *((const v4u*)(XN8 + (size_t)t * DM) + lane);
                        *((v4u*)(XG + (size_t)r0 * DM) + lane) = a; *((v4u*)(XG + (size_t)r1 * DM) + lane) = a; }
            }
            SEAM(16);
            if (IN(17)) { asm volatile("; PHASE_MARK 17" ::: "memory"); PHB;
                const __attribute__((address_space(4))) int* mtab = (const __attribute__((address_space(4))) int*)(ws + OFF_MTAB); const int nblk = mtab[264];
                pg8::Gemm g{(const bf16*)XG, (const bf16*)(ws + OFF_WEGU), DM / 2, DM / 2}; pg8::MoeOrder S; S.init(nblk, 2 * EFF / 256, G, bid); S.tab = mtab;
                pg8::EpiSwigluI8 E{ACTM, EFF, RSG, (const float*)(ws + OFF_CSE)};
                REPEAT(17) pg8::gemm_phase<pg8::EpiSwigluI8, pg8::MoeOrder, false, true, true, true>(F.lds + RING_OFF, g, S, E, wave);
#ifdef PROBE_NULL_EPI
                { pg8::EpiNull EN; pg8::gemm_phase<pg8::EpiNull, pg8::MoeOrder, true>(F.lds + RING_OFF, g, S, EN, wave); }
#endif
            }
            SEAM(17);
            if (IN(18)) { asm volatile("; PHASE_MARK 18" ::: "memory"); PHB;
                const __attribute__((address_space(4))) int* mtab = (const __attribute__((address_space(4))) int*)(ws + OFF_MTAB); const int nblk = mtab[264];
                pg8::Gemm g{(const bf16*)ACTM, (const bf16*)(ws + OFF_WEDN), EFF / 2, EFF / 2}; pg8::MoeDownOrder S; S.init(nblk, G, bid); S.tab = mtab;
                pg8::EpiBf8K E{YE, (float*)(ws + OFF_XG), 1.0f / (A8S_ACT * W8S_DN)};
                REPEAT(18) pg8::gemm_phase<pg8::EpiBf8K, pg8::MoeDownOrder, true, true, true, false, true, false>(F.lds + RING_OFF, g, S, E, wave);
            }
            SEAM(18);
            if (IN(19)) { asm volatile("; PHASE_MARK 19" ::: "memory"); PHB;
                {
                    const __attribute__((address_space(4))) int* mtab = (const __attribute__((address_space(4))) int*)(ws + OFF_MTAB); const int ntail = (mtab[264] - 256) * 256;
                    const float* PART = (const float*)(ws + OFF_XG);
                    for (int r = gw; r < ntail; r += NGW) { const float* pp = PART + (size_t)(((r >> 8) * 7) * 256 + (r & 255)) * DM; f32x4 pv[7][4];
#pragma unroll
                        for (int k = 0; k < 7; ++k)
#pragma unroll
                            for (int j = 0; j < 4; ++j) pv[k][j] = ((const f32x4*)(pp + (size_t)k * 256 * DM) + lane)[64 * j];
#pragma unroll
                        for (int j = 0; j < 4; ++j) { f32x4 a = pv[0][j];
#pragma unroll
                            for (int k = 1; k < 7; ++k) a += pv[k][j];
                            ((v2u*)(YE + (size_t)(65536 + r) * DM) + lane)[64 * j] = (v2u){pg8::cvt_pk_bf16(a.x, a.y), pg8::cvt_pk_bf16(a.z, a.w)}; } }
                    xcd_barrier(bar, F.wave); }
                const f32x4* gr = (const f32x4*)ka->in[17] + lane;
                {   f32x4 gg[4];
#pragma unroll
                    for (int j = 0; j < 4; ++j) gg[j] = gr[64 * j];
                    v2u cx[4], c0[4], c1[4], nx[4], n0[4], n1[4]; i32x2 rrn = {0, 0}; f32x2 wwc = {0.f, 0.f}, wwn = {0.f, 0.f};
                    auto rows = [&](int t, i32x2 rr, v2u (&ax)[4], v2u (&a0)[4], v2u (&a1)[4]) __attribute__((always_inline)) {
                        const v2u* px = (const v2u*)(XS16 + (size_t)t * DM) + lane; const v2u* p0 = (const v2u*)(YE + (size_t)rr.x * DM) + lane; const v2u* p1 = (const v2u*)(YE + (size_t)rr.y * DM) + lane;
#pragma unroll
                        for (int j = 0; j < 4; ++j) { ax[j] = px[64 * j]; a0[j] = p0[64 * j]; a1[j] = p1[64 * j]; } };
                    int t = gw;
                    if (t < MTOK) { const i32x2 rr = *(const i32x2*)(TOKR + (size_t)t * 2); wwc = *(const f32x2*)(TOKW + (size_t)t * 2); rows(t, rr, cx, c0, c1); }
                    if (t + NGW < MTOK) { rrn = *(const i32x2*)(TOKR + (size_t)(t + NGW) * 2); wwn = *(const f32x2*)(TOKW + (size_t)(t + NGW) * 2); }
                    for (; t < MTOK; t += NGW) {
                        i32x2 rrnn = {0, 0}; f32x2 wwnn = {0.f, 0.f};
                        if (t + NGW < MTOK) rows(t + NGW, rrn, nx, n0, n1);
                        if (t + 2 * NGW < MTOK) { rrnn = *(const i32x2*)(TOKR + (size_t)(t + 2 * NGW) * 2); wwnn = *(const f32x2*)(TOKW + (size_t)(t + 2 * NGW) * 2); }
                        f32x4* xr = (f32x4*)(xs + (size_t)t * DM) + lane; f32x4 v[4]; float s = 0.f; const f32x2 ww = wwc;
#pragma unroll
                        for (int j = 0; j < 4; ++j) { const v2u x = cx[j], a = c0[j], b2 = c1[j];
                            v[j].x = bfl(x.x) + ww.x * bfl(a.x) + ww.y * bfl(b2.x); v[j].y = bfh(x.x) + ww.x * bfh(a.x) + ww.y * bfh(b2.x); v[j].z = bfl(x.y) + ww.x * bfl(a.y) + ww.y * bfl(b2.y); v[j].w = bfh(x.y) + ww.x * bfh(a.y) + ww.y * bfh(b2.y);
                            s += (v[j].x * v[j].x + v[j].y * v[j].y) + (v[j].z * v[j].z + v[j].w * v[j].w); }
                        const float r = rsqrtf(wave_sum(s) * (1.f / DM) + RMS_EPS);
#pragma unroll
                        for (int j = 0; j < 4; ++j) xr[64 * j] = (f32x4){v[j].x * r * gg[j].x, v[j].y * r * gg[j].y, v[j].z * r * gg[j].z, v[j].w * r * gg[j].w};
#pragma unroll
                        for (int j = 0; j < 4; ++j) { cx[j] = nx[j]; c0[j] = n0[j]; c1[j] = n1[j]; }
                        wwc = wwn; rrn = rrnn; wwn = wwnn; } }
            }
        }
    }
    {
        constexpr int l = 1;
        const int pb = 1 + 9 * l;
        if (INL(0)) { asm volatile("; PHASE_MARK L0" ::: "memory"); PHB;
            pg8::Gemm g{(const bf16*)XNQ, (const bf16*)(ws + OFF_WL) + (size_t)l * W_LAYER_E, DM / 2, DM / 2}; pg8::GridOrder S; S.init(MTOK / 256, IN_N / 256, G, bid);
            pg8::EpiIn E{ws, (const float*)ka->in[8] + l * 8, CSIN + l * IN_N};
            REPEAT(pb + 0) pg8::gemm_phase<pg8::EpiIn, pg8::GridOrder, false, true, true, true>(F.lds + RING_OFF, g, S, E, wave);
#ifdef PROBE_NULL_EPI_IN
            { pg8::EpiNull EN; pg8::gemm_phase<pg8::EpiNull, pg8::GridOrder, false, true, true, true>(F.lds + RING_OFF, g, S, EN, wave); }
#endif
        }
        SEAML(0);
        if (INL(1)) { asm volatile("; PHASE_MARK L1" ::: "memory"); PHB;
            for (int it = F.vcu; it < 64; it += G) {
                const int b = it >> 3, h = it & 7; LAS float* part = (LAS float*)(F.lds + RING_OFF);
                float v[8]; float run = 0.f;
#pragma unroll
                for (int k = 0; k < 8; ++k) { run += LOGF[((size_t)b * SEQ + tid * 8 + k) * 8 + h]; v[k] = run; }
                float inc = run;
#pragma unroll
                for (int o = 1; o < 64; o <<= 1) { const float t = __shfl_up(inc, o); if (lane >= o) inc += t; }
                if (lane == 63) part[wave] = inc;
                LDS_WAIT(); __syncthreads();
                float base = inc - run;
                for (int w = 0; w < wave; ++w) base += part[w];
                float* dst = CUM + ((size_t)b * 8 + h) * SEQ + tid * 8;
                *(f32x4*)dst = (f32x4){v[0] + base, v[1] + base, v[2] + base, v[3] + base}; *(f32x4*)(dst + 4) = (f32x4){v[4] + base, v[5] + base, v[6] + base, v[7] + base};
                __syncthreads();
                float kn = 0.f;
                for (int k = 0; k < 8; ++k) { const v4u* kp = (const v4u*)(FK + ((size_t)b * SEQ + tid * 8 + k) * BR_W + h * 64); float sq = 0.f;
#pragma unroll
                    for (int c = 0; c < 8; ++c) { const v4u w = kp[c];
#pragma unroll
                        for (int e = 0; e < 4; ++e) { const float lo = bfl(w[e]), hi2 = bfh(w[e]); sq += lo * lo + hi2 * hi2; } }
                    kn = fmaxf(kn, sq); }
#pragma unroll
                for (int o = 1; o < 64; o <<= 1) kn = fmaxf(kn, __shfl_xor(kn, o));
                if (lane == 0) part[8 + wave] = kn;
                LDS_WAIT(); __syncthreads();
                if (tid == 0) { float m = 0.f; for (int w = 0; w < 8; ++w) m = fmaxf(m, part[8 + w]); KNM[it] = sqrtf(m); }
                __syncthreads();
            }
            for (int it = F.vcu - 64; it < 128; it += G) { if (it < 0) continue;
                const bf16* src = MK + (size_t)it * 256 * BR_W + tid; float s = 0.f;
#pragma unroll 8
                for (int r = 0; r < 256; ++r) s += __uint_as_float((unsigned)src[(size_t)r * BR_W] << 16);
                KMEAN[(size_t)it * 512 + tid] = s * (1.0f / 256.0f); }
            VM_WAIT(); __syncthreads();
            pg8::Gemm g{LAT, ((const bf16*)(ws + OFF_WL) + (size_t)l * W_LAYER_E) + W_IN_E, LAT_W, 256}; pg8::MidOrder S; S.init(MTOK / 256, UP_N / 256, G, bid);
            pg8::EpiUp E{ws};
            REPEAT(pb + 1) pg8::gemm_phase<pg8::EpiUp, pg8::MidOrder>(F.lds + RING_OFF, g, S, E, wave);
        }
        SEAML(1);
        if (INL(2)) { asm volatile("; PHASE_MARK L2" ::: "memory"); PHB;
            att::Args A0{(const att::bf16*)QM, (const att::bf16*)KVM, (const att::bf16*)KR, (const att::bf16*)KVM + 64, (att::bf16*)Y3, nullptr, nullptr, QM_W, KVM_W, KVM_W, Y3_W, 96, 128};
            att::Args A1{(const att::bf16*)FQ, (const att::bf16*)FK, nullptr, (const att::bf16*)FV, (att::bf16*)Y3 + 512, CUM, KNM, BR_W, BR_W, BR_W, Y3_W, 64, 64};
            att::Args A2{(const att::bf16*)MQ, (const att::bf16*)MK, nullptr, (const att::bf16*)MV, (att::bf16*)Y3 + 1024, nullptr, KMEAN, BR_W, BR_W, BR_W, Y3_W, 64, 64};
            char* shm = (char*)lds + RING_OFF;
            for (int rep_ = 0; rep_ < (((REP_ATT >> 0) & 1u) ? 2 : 1); ++rep_)
            for (int v = F.vcu; v < 512; v += G) { const int bh = v >> 3, s = v & 7;
                att::attn_unit<0>(bh >> 3, bh & 7, 15 - s, A0, shm, wave); att::attn_unit<0>(bh >> 3, bh & 7, s, A0, shm, wave); }
            for (int rep_ = 0; rep_ < (((REP_ATT >> 1) & 1u) ? 2 : 1); ++rep_)
            for (int v = F.vcu; v < 512; v += G) { const int bh = v >> 3, s = v & 7;
                att::attn_unit<1>(bh >> 3, bh & 7, 15 - s, A1, shm, wave); att::attn_unit<1>(bh >> 3, bh & 7, s, A1, shm, wave); }
            for (int rep_ = 0; rep_ < (((REP_ATT >> 2) & 1u) ? 2 : 1); ++rep_)
            for (int v = F.vcu; v < 512; v += G) { const int bh = v >> 3, s = v & 7;
                att::attn_unit<2>(bh >> 3, bh & 7, 15 - s, A2, shm, wave); att::attn_unit<2>(bh >> 3, bh & 7, s, A2, shm, wave); }
        }
        SEAML(2);
        if (INL(3)) { asm volatile("; PHASE_MARK L3" ::: "memory"); PHB;
            pg8::Gemm g{Y3, ((const bf16*)(ws + OFF_WL) + (size_t)l * W_LAYER_E) + W_IN_E + W_UP_E, Y3_W, Y3_W}; pg8::GridOrder S; S.init(MTOK / 256, DM / 256, G, bid);
            pg8::EpiMerge E{GT, MERGED};
            REPEAT(pb + 3) pg8::gemm_phase<pg8::EpiMerge, pg8::GridOrder>(F.lds + RING_OFF, g, S, E, wave);
        }
        SEAML(3);
        if (INL(4)) { asm volatile("; PHASE_MARK L4" ::: "memory"); PHB;
            pg8::Gemm g{MERGED, ((const bf16*)(ws + OFF_WL) + (size_t)l * W_LAYER_E) + W_IN_E + W_UP_E + W_BR_E, DM, DM}; pg8::GridOrder S; S.init(MTOK / 256, DM / 256, G, bid);
            pg8::EpiResidB<l == 0> E{l == 0 ? (const void*)x_in : (const void*)XS16, XS16, 1.0f};
            REPEAT(l == 0 ? pb + 4 : 31) pg8::gemm_phase<pg8::EpiResidB<l == 0>, pg8::GridOrder>(F.lds + RING_OFF, g, S, E, wave);
        }
        SEAML(4);
        if (l == 0) {
            if (IN(6)) { asm volatile("; PHASE_MARK 6" ::: "memory"); PHB; const float* gf = (const float*)ka->in[11]; REPEAT(6) rms_rows_to_i8<false>(XS16, gf, XNQ, RSX, gw, NGW, lane); }
            SEAM(6);
            if (IN(7)) { asm volatile("; PHASE_MARK 7" ::: "memory"); PHB;
                pg8::Gemm g{(const bf16*)XNQ, (const bf16*)(ws + OFF_WDGU), DM / 2, DM / 2}; pg8::GridOrder S; S.init(MTOK / 256, 2 * DFF / 256, G, bid);
#if DENSE_DOWN_F8
                pg8::EpiSwigluI8 E{(unsigned char*)ACTD, DFF, RSX, CSC};
                REPEAT(7) pg8::gemm_phase<pg8::EpiSwigluI8, pg8::GridOrder, false, true, true, true>(F.lds + RING_OFF, g, S, E, wave);
#else
                pg8::EpiSwigluI8B E{ACTD, DFF, RSX, CSC};
                REPEAT(7) pg8::gemm_phase<pg8::EpiSwigluI8B, pg8::GridOrder, false, true, true, true>(F.lds + RING_OFF, g, S, E, wave);
#endif
            }
            SEAM(7);
            if (IN(8)) { asm volatile("; PHASE_MARK 8" ::: "memory"); PHB;
#if DENSE_DOWN_F8
                pg8::Gemm g{(const bf16*)ACTD, (const bf16*)(ws + OFF_WDDN), DFF / 2, DFF / 2}; pg8::GridOrder S; S.init(MTOK / 256, DM / 256, G, bid);
                pg8::EpiResidB<false> E{(const void*)XS16, XS16, 1.0f / (A8S_ACT * W8S_DN)};
                pg8::gemm_phase<pg8::EpiResidB<false>, pg8::GridOrder, true, true, true, false, false, false>(F.lds + RING_OFF, g, S, E, wave);
#else
                pg8::Gemm g{ACTD, (const bf16*)(ws + OFF_WDDN), DFF, DFF}; pg8::GridOrder S; S.init(MTOK / 256, DM / 256, G, bid);
                pg8::EpiResidB<false> E{(const void*)XS16, XS16, 1.0f};
                pg8::gemm_phase<pg8::EpiResidB<false>, pg8::GridOrder>(F.lds + RING_OFF, g, S, E, wave);
#endif
            }
            SEAM(8);
            if (IN(9)) { asm volatile("; PHASE_MARK 9" ::: "memory"); PHB; const float* gm = (const float*)ka->in[2] + DM; REPEAT(9) rms_rows_to_i8<false>(XS16, gm, XNQ, RSIN, gw, NGW, lane); }
            SEAM(9);
        } else {
            if (IN(15)) { asm volatile("; PHASE_MARK 15" ::: "memory"); PHB;
                const float* gf = (const float*)ka->in[11] + DM;
                LAS int* cnt = (LAS int*)(F.lds + RING_OFF + 32768);
                const float* wr = (const float*)ka->in[14];
                f32x4 w0[4][4], w1[4][4], gg[4];
#pragma unroll
                for (int j = 0; j < 4; ++j) { gg[j] = ((const f32x4*)gf + lane)[64 * j];
#pragma unroll
                    for (int q = 0; q < 4; ++q) { const f32x4* wp = (const f32x4*)(wr + (size_t)(256 * j + 4 * lane + q) * 8); w0[j][q] = wp[0]; w1[j][q] = wp[1]; } }
                const bool b0_ = (lane & 1) != 0, b1_ = (lane & 2) != 0, b2_ = (lane & 4) != 0;
                REPEAT(15) for (int c = bid; c < 256; c += G) {
                    if (tid < 64) cnt[tid] = 0;
                    LDS_WAIT(); __syncthreads();
                    const int t0 = c * 128 + wave * 16;
                    auto row_do = [&](int t, f32x4 (&v)[4]) __attribute__((always_inline)) {
                        float s = 0.f;
#pragma unroll
                        for (int j = 0; j < 4; ++j) s += (v[j].x * v[j].x + v[j].y * v[j].y) + (v[j].z * v[j].z + v[j].w * v[j].w);
                        const float r = rsqrtf(wave_sum(s) * (1.f / DM) + RMS_EPS);
                        float lg[8];
#pragma unroll
                        for (int e = 0; e < 8; ++e) lg[e] = 0.f;
                        float mx = 0.f;
#pragma unroll
                        for (int j = 0; j < 4; ++j) { const f32x4 hv = {v[j].x * r * gg[j].x, v[j].y * r * gg[j].y, v[j].z * r * gg[j].z, v[j].w * r * gg[j].w}; v[j] = hv;
                            mx = fmaxf(fmaxf(mx, fmaxf(fabsf(hv.x), fabsf(hv.y))), fmaxf(fabsf(hv.z), fabsf(hv.w)));
#pragma unroll
                            for (int q = 0; q < 4; ++q) { const f32x4 a0 = w0[j][q], a1 = w1[j][q]; const float hh = hv[q];
                                lg[0] += hh * a0.x; lg[1] += hh * a0.y; lg[2] += hh * a0.z; lg[3] += hh * a0.w; lg[4] += hh * a1.x; lg[5] += hh * a1.y; lg[6] += hh * a1.z; lg[7] += hh * a1.w; } }
#pragma unroll
                        for (int o = 1; o < 64; o <<= 1) mx = fmaxf(mx, __shfl_xor(mx, o));
                        { const float sc = mx > 0.f ? 127.0f / mx : 0.f; unsigned* o4 = (unsigned*)(XN8 + (size_t)t * DM) + lane;
#pragma unroll
                          for (int j = 0; j < 4; ++j) o4[64 * j] = pk4_i8(v[j].x * sc, v[j].y * sc, v[j].z * sc, v[j].w * sc);
                          if (lane == 0) RSX[t] = mx * (1.0f / 127.0f); }
                        float y4[4], y2[2], y1;
#pragma unroll
                        for (int k = 0; k < 4; ++k) { const float keep = b0_ ? lg[4 + k] : lg[k], send = b0_ ? lg[k] : lg[4 + k]; y4[k] = keep + __shfl_xor(send, 1); }
#pragma unroll
                        for (int k = 0; k < 2; ++k) { const float keep = b1_ ? y4[2 + k] : y4[k], send = b1_ ? y4[k] : y4[2 + k]; y2[k] = keep + __shfl_xor(send, 2); }
                        { const float keep = b2_ ? y2[1] : y2[0], send = b2_ ? y2[0] : y2[1]; y1 = keep + __shfl_xor(send, 4); }
                        y1 += __shfl_xor(y1, 8); y1 += __shfl_xor(y1, 16); y1 += __shfl_xor(y1, 32);
#pragma unroll
                        for (int e = 0; e < 8; ++e) lg[e] = __uint_as_float(__builtin_amdgcn_readlane(__float_as_uint(y1), ((e >> 2) & 1) | (((e >> 1) & 1) << 1) | ((e & 1) << 2)));
                        int e0 = 0; float b0 = lg[0];
#pragma unroll
                        for (int e = 1; e < 8; ++e) if (lg[e] > b0) { b0 = lg[e]; e0 = e; }
                        int e1 = 0; float b1 = -INFINITY;
#pragma unroll
                        for (int e = 0; e < 8; ++e) if (e != e0 && lg[e] > b1) { b1 = lg[e]; e1 = e; }
                        if (lane == 0) { const float w1v = 1.0f / (1.0f + __expf(b0 - b1)); const float w0v = 1.0f - w1v;
                            volatile LAS int* cw = cnt + wave * 8; const int i0 = cw[e0]; cw[e0] = i0 + 1; const int i1 = cw[e1]; cw[e1] = i1 + 1;
                            *(i32x4*)(TOKI + (size_t)t * 4) = (i32x4){e0, e1, i0, i1}; *(f32x2*)(TOKW + (size_t)t * 2) = (f32x2){w0v, w1v}; }
                    };
                    f32x4 na[4], nb[4]; ld_row16(XS16 + (size_t)t0 * DM, lane, na); ld_row16(XS16 + (size_t)(t0 + 1) * DM, lane, nb);
                    for (int i = 0; i < 16; i += 2) { const int t = t0 + i;
                        f32x4 va[4], vb[4];
#pragma unroll
                        for (int j = 0; j < 4; ++j) { va[j] = na[j]; vb[j] = nb[j]; }
                        if (i + 2 < 16) { ld_row16(XS16 + (size_t)(t + 2) * DM, lane, na); ld_row16(XS16 + (size_t)(t + 3) * DM, lane, nb); }
                        row_do(t, va); row_do(t + 1, vb);
                    }
                    LDS_WAIT(); __syncthreads();
                    if (tid < 8) { int* wp = (int*)(ws + OFF_WPRE) + c * 64 + tid; int run = 0;
#pragma unroll
                        for (int w = 0; w < 8; ++w) { wp[w * 8] = run; run += cnt[w * 8 + tid]; }
                        CNT[c * 8 + tid] = run; }
                    __syncthreads();
                }
            }
            SEAM(15);
            if (IN(16)) { asm volatile("; PHASE_MARK 16" ::: "memory"); PHB;
                LAS int* PRE = (LAS int*)(F.lds + RING_OFF);
                LAS int* TOT = PRE + 2048;
                { const int e = wave; int cv[4]; int run = 0;
#pragma unroll
                    for (int k = 0; k < 4; ++k) { cv[k] = CNT[(lane * 4 + k) * 8 + e]; run += cv[k]; }
                    int inc = run;
#pragma unroll
                    for (int o = 1; o < 64; o <<= 1) { const int t = __shfl_up(inc, o); if (lane >= o) inc += t; }
                    int ex = inc - run;
#pragma unroll
                    for (int k = 0; k < 4; ++k) { PRE[e * 256 + lane * 4 + k] = ex; ex += cv[k]; }
                    if (lane == 63) TOT[e] = inc; }
                LDS_WAIT(); __syncthreads();
                if (tid == 0) { int st = 0;
                    for (int e = 0; e < 8; ++e) { TOT[8 + e] = st; const int nb = (TOT[e] + 255) >> 8;
                        if (bid == 0) for (int k = 0; k < nb; ++k) MTAB[(st >> 8) + k] = e;
                        st += nb << 8; }
                    if (bid == 0) MTAB[264] = st >> 8; }
                LDS_WAIT(); __syncthreads();
                REPEAT(16) for (int c = bid; c < 256; c += G)
                    for (int i = 0; i < 16; ++i) { const int t = c * 128 + wave * 16 + i; const i32x4 ti = *(const i32x4*)(TOKI + (size_t)t * 4);
                        const int* wpre = (const int*)(ws + OFF_WPRE) + (c * 8 + wave) * 8;
                        const int r0 = TOT[8 + ti.x] + PRE[ti.x * 256 + c] + wpre[ti.x] + ti.z, r1 = TOT[8 + ti.y] + PRE[ti.y * 256 + c] + wpre[ti.y] + ti.w;
                        if (lane == 0) { *(i32x2*)(TOKR + (size_t)t * 2) = (i32x2){r0, r1}; const float rsv = RSX[t]; RSG[r0] = rsv; RSG[r1] = rsv; }
                        const v4u a = *((const v4u*)(XN8 + (size_t)t * DM) + lane);
                        *((v4u*)(XG + (size_t)r0 * DM) + lane) = a; *((v4u*)(XG + (size_t)r1 * DM) + lane) = a; }
            }
            SEAM(16);
            if (IN(17)) { asm volatile("; PHASE_MARK 17" ::: "memory"); PHB;
                const __attribute__((address_space(4))) int* mtab = (const __attribute__((address_space(4))) int*)(ws + OFF_MTAB); const int nblk = mtab[264];
                pg8::Gemm g{(const bf16*)XG, (const bf16*)(ws + OFF_WEGU), DM / 2, DM / 2}; pg8::MoeOrder S; S.init(nblk, 2 * EFF / 256, G, bid); S.tab = mtab;
                pg8::EpiSwigluI8 E{ACTM, EFF, RSG, (const float*)(ws + OFF_CSE)};
                REPEAT(17) pg8::gemm_phase<pg8::EpiSwigluI8, pg8::MoeOrder, false, true, true, true>(F.lds + RING_OFF, g, S, E, wave);
#ifdef PROBE_NULL_EPI
                { pg8::EpiNull EN; pg8::gemm_phase<pg8::EpiNull, pg8::MoeOrder, true>(F.lds + RING_OFF, g, S, EN, wave); }
#endif
            }
            SEAM(17);
            if (IN(18)) { asm volatile("; PHASE_MARK 18" ::: "memory"); PHB;
                const __attribute__((address_space(4))) int* mtab = (const __attribute__((address_space(4))) int*)(ws + OFF_MTAB); const int nblk = mtab[264];
                pg8::Gemm g{(const bf16*)ACTM, (const bf16*)(ws + OFF_WEDN), EFF / 2, EFF / 2}; pg8::MoeDownOrder S; S.init(nblk, G, bid); S.tab = mtab;
                pg8::EpiBf8K E{YE, (float*)(ws + OFF_XG), 1.0f / (A8S_ACT * W8S_DN)};
                REPEAT(18) pg8::gemm_phase<pg8::EpiBf8K, pg8::MoeDownOrder, true, true, true, false, true, false>(F.lds + RING_OFF, g, S, E, wave);
            }
            SEAM(18);
            if (IN(19)) { asm volatile("; PHASE_MARK 19" ::: "memory"); PHB;
                {
                    const __attribute__((address_space(4))) int* mtab = (const __attribute__((address_space(4))) int*)(ws + OFF_MTAB); const int ntail = (mtab[264] - 256) * 256;
                    const float* PART = (const float*)(ws + OFF_XG);
                    for (int r = gw; r < ntail; r += NGW) { const float* pp = PART + (size_t)(((r >> 8) * 7) * 256 + (r & 255)) * DM; f32x4 pv[7][4];
#pragma unroll
                        for (int k = 0; k < 7; ++k)
#pragma unroll
                            for (int j = 0; j < 4; ++j) pv[k][j] = ((const f32x4*)(pp + (size_t)k * 256 * DM) + lane)[64 * j];
#pragma unroll
                        for (int j = 0; j < 4; ++j) { f32x4 a = pv[0][j];
#pragma unroll
                            for (int k = 1; k < 7; ++k) a += pv[k][j];
                            ((v2u*)(YE + (size_t)(65536 + r) * DM) + lane)[64 * j] = (v2u){pg8::cvt_pk_bf16(a.x, a.y), pg8::cvt_pk_bf16(a.z, a.w)}; } }
                    xcd_barrier(bar, F.wave); }
                const f32x4* gr = (const f32x4*)ka->in[17] + lane;
                {   f32x4 gg[4];
#pragma unroll
                    for (int j = 0; j < 4; ++j) gg[j] = gr[64 * j];
                    v2u cx[4], c0[4], c1[4], nx[4], n0[4], n1[4]; i32x2 rrn = {0, 0}; f32x2 wwc = {0.f, 0.f}, wwn = {0.f, 0.f};
                    auto rows = [&](int t, i32x2 rr, v2u (&ax)[4], v2u (&a0)[4], v2u (&a1)[4]) __attribute__((always_inline)) {
                        const v2u* px = (const v2u*)(XS16 + (size_t)t * DM) + lane; const v2u* p0 = (const v2u*)(YE + (size_t)rr.x * DM) + lane; const v2u* p1 = (const v2u*)(YE + (size_t)rr.y * DM) + lane;
#pragma unroll
                        for (int j = 0; j < 4; ++j) { ax[j] = px[64 * j]; a0[j] = p0[64 * j]; a1[j] = p1[64 * j]; } };
                    int t = gw;
                    if (t < MTOK) { const i32x2 rr = *(const i32x2*)(TOKR + (size_t)t * 2); wwc = *(const f32x2*)(TOKW + (size_t)t * 2); rows(t, rr, cx, c0, c1); }
                    if (t + NGW < MTOK) { rrn = *(const i32x2*)(TOKR + (size_t)(t + NGW) * 2); wwn = *(const f32x2*)(TOKW + (size_t)(t + NGW) * 2); }
                    for (; t < MTOK; t += NGW) {
                        i32x2 rrnn = {0, 0}; f32x2 wwnn = {0.f, 0.f};
                        if (t + NGW < MTOK) rows(t + NGW, rrn, nx, n0, n1);
                        if (t + 2 * NGW < MTOK) { rrnn = *(const i32x2*)(TOKR + (size_t)(t + 2 * NGW) * 2); wwnn = *(const f32x2*)(TOKW + (size_t)(t + 2 * NGW) * 2); }
                        f32x4* xr = (f32x4*)(xs + (size_t)t * DM) + lane; f32x4 v[4]; float s = 0.f; const f32x2 ww = wwc;
#pragma unroll
                        for (int j = 0; j < 4; ++j) { const v2u x = cx[j], a = c0[j], b2 = c1[j];
                            v[j].x = bfl(x.x) + ww.x * bfl(a.x) + ww.y * bfl(b2.x); v[j].y = bfh(x.x) + ww.x * bfh(a.x) + ww.y * bfh(b2.x); v[j].z = bfl(x.y) + ww.x * bfl(a.y) + ww.y * bfl(b2.y); v[j].w = bfh(x.y) + ww.x * bfh(a.y) + ww.y * bfh(b2.y);
                            s += (v[j].x * v[j].x + v[j].y * v[j].y) + (v[j].z * v[j].z + v[j].w * v[j].w); }
                        const float r = rsqrtf(wave_sum(s) * (1.f / DM) + RMS_EPS);
#pragma unroll
                        for (int j = 0; j < 4; ++j) xr[64 * j] = (f32x4){v[j].x * r * gg[j].x, v[j].y * r * gg[j].y, v[j].z * r * gg[j].z, v[j].w * r * gg[j].w};
#pragma unroll
                        for (int j = 0; j < 4; ++j) { cx[j] = nx[j]; c0[j] = n0[j]; c1[j] = n1[j]; }
                        wwc = wwn; rrn = rrnn; wwn = wwnn; } }
            }
        }
    }
#undef IN
#undef SEAM
#undef INL
#undef SEAML
}

#undef SSQ
#undef LOGF
#undef CUM
#undef KMEAN
#undef KNM
#undef R64C
#undef R64S
#undef R32C
#undef R32S
#undef TOKI
#undef TOKW
#undef TOKR
#undef CNT
#undef MTAB
#undef XN8
#undef RSX
#undef RSG
#undef XS16
#undef XNQ
#undef CSC
#undef CSIN
#undef RSIN
#undef XN
#undef QM
#undef LAT
#undef KR
#undef FQ
#undef FK
#undef FV
#undef MQ
#undef MK
#undef MV
#undef GT
#undef KVM
#undef MERGED
#undef Y3
#undef ACTD
#undef ACTM
#undef XG
#undef YE
extern "C" void kernel_launch(void* const* d_in, const int* in_sizes, int n_in, void* d_out, int out_size, void* d_ws, size_t ws_size, hipStream_t stream) {
    static int grid = 0;
    if (grid == 0) {
        if (n_in != 18 || in_sizes[0] != MTOK * DM || out_size != MTOK * DM || ws_size < WS_NEED) { fprintf(stderr, "kernel_launch: shape / workspace mismatch (n_in %d, ws %zu, need %zu); nothing launched\n", n_in, ws_size, (size_t)WS_NEED); grid = -1; return; }
        int dev = 0, cus = 0, per_cu = 0;
        if (hipGetDevice(&dev) != hipSuccess || hipDeviceGetAttribute(&cus, hipDeviceAttributeMultiprocessorCount, dev) != hipSuccess) { grid = -1; return; }
        if (hipFuncSetAttribute((const void*)mega_fwd, hipFuncAttributeMaxDynamicSharedMemorySize, LDS_BYTES) != hipSuccess) { fprintf(stderr, "kernel_launch: hipFuncSetAttribute failed\n"); grid = -1; return; }
        if (hipOccupancyMaxActiveBlocksPerMultiprocessor(&per_cu, (const void*)mega_fwd, NWAVES * 64, LDS_BYTES) != hipSuccess || per_cu < 1) fprintf(stderr, "kernel_launch: occupancy query reports %d\n", per_cu);
        (void)hipGetLastError();
        grid = cus;
    }
    if (grid < 0) return;
    if (hipMemsetAsync((char*)d_ws + WS_CTL, 0, CTL_ZERO_BYTES, stream) != hipSuccess) return;
    KArgs a; memset(&a, 0, sizeof(a));
    for (int i = 0; i < 18; ++i) a.in[i] = d_in[i];
    a.out = (float*)d_out; a.ws = (unsigned char*)d_ws;
#if MK_N_LAUNCHES == 1
    a.ph_lo = 0; a.ph_hi = NPHASE;
    hipLaunchKernelGGL(mega_fwd, dim3(grid), dim3(NWAVES * 64), LDS_BYTES, stream, a);
#else
    for (int p = 0; p < NPHASE; ++p) { a.ph_lo = p; a.ph_hi = p + 1; hipLaunchKernelGGL(mega_fwd, dim3(grid), dim3(NWAVES * 64), LDS_BYTES, stream, a); }
#endif
}
```

```cpp
#include <hip/hip_runtime.h>
#include <hip/hip_bf16.h>
#include <cstdio>
#include <cstdint>
#include <cstring>

#define LAS __attribute__((address_space(3)))
#define GAS __attribute__((address_space(1)))

namespace pg8 {
typedef unsigned short bf16_t;
typedef short bf16x8 __attribute__((ext_vector_type(8)));
typedef float f32x4 __attribute__((ext_vector_type(4)));
typedef float f32x2 __attribute__((ext_vector_type(2)));
typedef unsigned u32x4 __attribute__((ext_vector_type(4)));
typedef unsigned u32x2 __attribute__((ext_vector_type(2)));
typedef int i32x4 __attribute__((ext_vector_type(4)));
typedef int i32x8 __attribute__((ext_vector_type(8)));
constexpr int BM = 256, BK = 64, HALF = 128, HTB = HALF * BK * 2  , STAGE_BYTES = 8 * HTB, NXCD = 8, WGM = 8;

__host__ __device__ __forceinline__ int lds_byte(int r, int c) { const int st = (r >> 4) * 2 + (c >> 5), rr = r & 15, cc = c & 31, ob = rr * 64 + cc * 2; return st * 1024 + (ob ^ (((ob >> 9) & 1) << 5)); }
__host__ __device__ __forceinline__ void stage_rc(int b, int& R, int& C) { const int st = b / 1024, sb = b % 1024, swz = sb ^ (((sb >> 9) & 1) << 5); R = (st >> 1) * 16 + swz / 64; C = (st & 1) * 32 + (swz % 64) / 2; }
__host__ __device__ __forceinline__ int perm32(int rho) { const int n = rho >> 4, i = rho & 15; return 8 * (i >> 2) + 4 * n + (i & 3); }

struct Unit { int pm, pn, bt; unsigned aoff; int nt; unsigned boff; int ks; };
struct Gemm { const bf16_t* A; const bf16_t* Bt; int lda, K; };

struct GridOrder {
    int nM, nN, nwg, G, c;
    __device__ void init(int nM_, int nN_, int G_, int c_) { nM = nM_; nN = nN_; nwg = nM * nN; G = G_; c = c_; }
    __device__ __forceinline__ bool next_mn(int i, int& pm, int& pn) const {
        const int L = i * G + c; if (L >= nwg) return false;
        int wgid = L; { const int q = nwg / NXCD, r = nwg % NXCD, xcd = wgid % NXCD, off = wgid / NXCD; wgid = (xcd < r ? xcd * (q + 1) : r * (q + 1) + (xcd - r) * q) + off; }
        const int nig = WGM * nN, gid = wgid / nig, fm = gid * WGM, gsz = (nM - fm) < WGM ? (nM - fm) : WGM;
        pm = fm + ((wgid % nig) % gsz); pn = (wgid % nig) / gsz; return true;
    }
    __device__ __forceinline__ bool next(int i, Unit& u) const { if (!next_mn(i, u.pm, u.pn)) return false; u.bt = u.pn; u.aoff = 0u; return true; }
};
struct MidOrder : GridOrder {
    __device__ __forceinline__ bool next(int i, Unit& u) const { if (!next_mn(i, u.pm, u.pn)) return false; u.bt = u.pn; u.aoff = (u.pn >= 3) ? 512u : 0u; return true; }
};
struct MoeOrder : GridOrder {
    const __attribute__((address_space(4))) int* tab;
    __device__ __forceinline__ bool next(int i, Unit& u) const { if (!next_mn(i, u.pm, u.pn)) return false;
        const int e = tab[u.pm]; u.bt = e * nN + u.pn; u.aoff = 0u; return true; }
};

struct MoeDownOrder {
    GridOrder main; int nblk, G, c; const __attribute__((address_space(4))) int* tab;
    __device__ void init(int nblk_, int G_, int c_) { nblk = nblk_; G = G_; c = c_; main.init(256, 4, G_, c_); }
    __device__ __forceinline__ bool next(int i, Unit& u) const {
        const int L = i * G + c; const int j = L - 1024;
        if (j >= (nblk - 256) * 28) return false;
        int pm, pn; main.next_mn(L < 1024 ? i : 0, pm, pn);
        const int q = j / 28, r = j - q * 28, pn2 = r / 7, ks2 = r - pn2 * 7; const bool tail = j >= 0;
        pm = tail ? 256 + q : pm; pn = tail ? pn2 : pn;
        const unsigned off = tail ? (unsigned)ks2 * 512u : 0u;
        u.pm = pm; u.pn = pn; u.bt = tab[pm] * 4 + pn; u.aoff = off; u.boff = off; u.nt = tail ? 4 : 28; u.ks = tail ? ks2 : -1; return true; }
};

__device__ __forceinline__ unsigned cvt_pk_bf16(float lo, float hi) { unsigned r; asm volatile("v_cvt_pk_bf16_f32 %0, %1, %2" : "=v"(r) : "v"(lo), "v"(hi)); return r; }
__device__ __forceinline__ u32x4 pack8(const f32x4 v0, const f32x4 v1) { u32x4 w; w.x = cvt_pk_bf16(v0[0], v0[1]); w.y = cvt_pk_bf16(v0[2], v0[3]); w.z = cvt_pk_bf16(v1[0], v1[1]); w.w = cvt_pk_bf16(v1[2], v1[3]); return w; }
__device__ __forceinline__ u32x2 pack4(const f32x4 v0) { u32x2 w; w.x = cvt_pk_bf16(v0[0], v0[1]); w.y = cvt_pk_bf16(v0[2], v0[3]); return w; }
__device__ __forceinline__ float clamp8(float v) { return fminf(fmaxf(v, -448.0f), 448.0f); }
__device__ __forceinline__ unsigned pk4_f8(float a, float b, float c, float d) { int v = 0; v = __builtin_amdgcn_cvt_pk_fp8_f32(clamp8(a), clamp8(b), v, false); v = __builtin_amdgcn_cvt_pk_fp8_f32(clamp8(c), clamp8(d), v, true); return (unsigned)v; }
__device__ __forceinline__ float bf_lo(unsigned w) { return __uint_as_float(w << 16); }
__device__ __forceinline__ float bf_hi(unsigned w) { return __uint_as_float(w & 0xffff0000u); }
__device__ __forceinline__ float fast_sigmoid(float x) { return __builtin_amdgcn_rcpf(1.0f + __builtin_amdgcn_exp2f(-1.4426950408889634f * x)); }

typedef f32x4 Acc[2][2][4][2];
__device__ __forceinline__ int lane_id_opaque() { int l; asm volatile("v_mbcnt_lo_u32_b32 %0, -1, 0\n\tv_mbcnt_hi_u32_b32 %0, -1, %0" : "=v"(l)); return l; }

template <class Epi, class Sched, bool F8 = false, bool ALIGN_EPI = true, bool SP2 = true, bool I8 = false, bool VARK = false, bool PEEL = true>
__device__ __forceinline__ void gemm_phase(LAS unsigned char* lds, const Gemm g, const Sched& S, const Epi& E, int wid) {
    const int lane = lane_id_opaque();
    const int tid = wid * 64 + lane, wr = wid >> 2, wc = wid & 3, fr = lane & 15, fq = lane >> 4;
    const int K = g.K, nt = K / BK, lda = g.lda;
    unsigned voffA, voffB;
    { int R, C; stage_rc(tid * 16, R, C); voffA = (unsigned)(R * lda + C) * 2u; voffB = (unsigned)(R * K + C) * 2u; }
    const size_t rstepA = (size_t)64 * lda * 2, rstepB = (size_t)64 * K * 2;
    const size_t kstep = (size_t)(BK * 2);
    const size_t hstepA = (size_t)HALF * lda * 2, hstepB = (size_t)HALF * K * 2;
    const size_t tstepA = 2 * hstepA, tstepB = 2 * hstepB;
    const unsigned ldsw = (unsigned)wid * 1024u;
    const int aoff = lds_byte(wr * 64 + fr, fq * 8), boff = lds_byte(wc * 32 + fr, fq * 8);
#define PG8_SA(b, h) (((b) * 2 + (h)) * HTB)
#define PG8_SB(b, h) ((4 + (b) * 2 + (h)) * HTB)
#define PG8_STAGE(bufoff, gbase, X) do { _Pragma("unroll") for (int _i = 0; _i < 2; ++_i) \
        __builtin_amdgcn_global_load_lds((const unsigned*)((const char*)(gbase) + _i * rstep##X + voff##X), (LAS unsigned*)(lds + (bufoff) + ldsw + _i * 8192), 16, 0, 0); } while (0)
#define PG8_LDA(dst, b, h) do { _Pragma("unroll") for (int m = 0; m < 4; ++m) _Pragma("unroll") for (int k = 0; k < 2; ++k) dst[m][k] = *(const LAS bf16x8*)(lds + PG8_SA(b, h) + aoff + m * 2048 + k * 1024); } while (0)
#define PG8_LDB(dst, b, h) do { _Pragma("unroll") for (int n = 0; n < 2; ++n) _Pragma("unroll") for (int k = 0; k < 2; ++k) dst[n][k] = *(const LAS bf16x8*)(lds + PG8_SB(b, h) + boff + n * 2048 + k * 1024); } while (0)
#define PG8_CAT8(x) __builtin_shufflevector(__builtin_bit_cast(i32x4, x[0]), __builtin_bit_cast(i32x4, x[1]), 0, 1, 2, 3, 4, 5, 6, 7)
#define PG8_MMA(ai, bj, At, Bt) do { __builtin_amdgcn_s_setprio(1); _Pragma("unroll") for (int m = 0; m < 4; ++m) _Pragma("unroll") for (int n = 0; n < 2; ++n) { \
        if constexpr (F8) acc[ai][bj][m][n] = __builtin_amdgcn_mfma_scale_f32_16x16x128_f8f6f4(PG8_CAT8(Bt[n]), PG8_CAT8(At[m]), acc[ai][bj][m][n], 0, 0, 0, 0x7F7F7F7F, 0, 0x7F7F7F7F); \
        else if constexpr (I8) { _Pragma("unroll") for (int k = 0; k < 2; ++k) acc[ai][bj][m][n] = __builtin_bit_cast(f32x4, __builtin_amdgcn_mfma_i32_16x16x64_i8(__builtin_bit_cast(i32x4, Bt[n][k]), __builtin_bit_cast(i32x4, At[m][k]), __builtin_bit_cast(i32x4, acc[ai][bj][m][n]), 0, 0, 0)); } \
        else { _Pragma("unroll") for (int k = 0; k < 2; ++k) acc[ai][bj][m][n] = __builtin_amdgcn_mfma_f32_16x16x32_bf16(Bt[n][k], At[m][k], acc[ai][bj][m][n], 0, 0, 0); } } __builtin_amdgcn_s_setprio(0); } while (0)
#define PG8_WAIT_V(n) asm volatile("s_waitcnt vmcnt(" #n ")" ::: "memory")
#define PG8_WAIT_VE asm volatile("s_waitcnt vmcnt(%0)" :: "n"(8 + Epi::NVM) : "memory")
#define PG8_WAIT_L(n) asm volatile("s_waitcnt lgkmcnt(" #n ")" ::: "memory")
#define PG8_BAR __builtin_amdgcn_s_barrier()
#define PG8_SCHED __builtin_amdgcn_sched_barrier(0)
    Unit cur, nxt; int ui = 0;
    if (!S.next(0, cur)) return;
    Acc acc;
#pragma unroll
    for (int a = 0; a < 2; ++a)
#pragma unroll
        for (int b = 0; b < 2; ++b)
#pragma unroll
            for (int m = 0; m < 4; ++m)
#pragma unroll
                for (int n = 0; n < 2; ++n) acc[a][b][m][n] = (f32x4){0.f, 0.f, 0.f, 0.f};
    bf16x8 At[4][2], B0[2][2], B1[2][2];
    const char* cA = (const char*)g.A + (size_t)cur.pm * tstepA + cur.aoff; const char* cB = (const char*)g.Bt + (size_t)cur.bt * tstepB + (VARK ? cur.boff : 0u);
    {
        PG8_STAGE(PG8_SB(0, 0), cB, B); PG8_STAGE(PG8_SB(0, 1), cB + hstepB, B); PG8_STAGE(PG8_SA(0, 0), cA, A); PG8_STAGE(PG8_SA(0, 1), cA + hstepA, A);
        if (wr == 1) PG8_BAR;
        PG8_WAIT_V(2); PG8_BAR;
        PG8_STAGE(PG8_SB(1, 0), cB + kstep, B); PG8_STAGE(PG8_SA(1, 0), cA + kstep, A); PG8_STAGE(PG8_SB(1, 1), cB + hstepB + kstep, B);
        PG8_WAIT_V(6); PG8_BAR;
    }
    for (;;) {
        const bool has_next = S.next(ui + 1, nxt);
        const char* nA = has_next ? (const char*)g.A + (size_t)nxt.pm * tstepA + nxt.aoff : cA; const char* nB = has_next ? (const char*)g.Bt + (size_t)nxt.bt * tstepB + (VARK ? nxt.boff : 0u) : cB;
        const int ntc = VARK ? cur.nt : nt;
        if constexpr (Epi::LDSSCALE) { const int l_ = lane_id_opaque(); const float* src = (wid < 4 ? E.cs_src(cur) : E.rs_src(cur) - 256) + wid * 64 + l_;
            __builtin_amdgcn_global_load_lds((const unsigned*)src, (LAS unsigned*)(lds + 8 * HTB + 4096 + (ui & 1) * 2048 + wid * 256), 4, 0, 0); }
#define PG8_TRIP(WF) do { \
            const bool last = (t == ntc - 2); \
            const char* a1 = cA + (size_t)(t + 1) * kstep; \
            const char* a2 = last ? nA : cA + (size_t)(t + 2) * kstep; const char* b2 = last ? nB : cB + (size_t)(t + 2) * kstep; \
            const char* a3 = a2 + kstep; const char* b3 = b2 + kstep; \
            if constexpr (Epi::MIDK) { if (t == Epi::MID0 || t == Epi::MID1) { const int l_ = lane_id_opaque(); E.mid(acc, cur, t, wr, wc, l_ & 15, l_ >> 4); } } \
            PG8_LDB(B0, 0, 0); PG8_LDB(B1, 0, 1); PG8_SCHED; PG8_LDA(At, 0, 0); PG8_STAGE(PG8_SA(1, 1), a1 + hstepA, A); \
            WF; PG8_WAIT_L(0); PG8_BAR; PG8_MMA(0, 0, At, B0); PG8_MMA(0, 1, At, B1); PG8_BAR; PG8_SCHED; \
            PG8_LDA(At, 0, 1); PG8_STAGE(PG8_SB(0, 0), b2, B); PG8_STAGE(PG8_SB(0, 1), b2 + hstepB, B); PG8_STAGE(PG8_SA(0, 0), a2, A); \
            WF; PG8_WAIT_L(0); PG8_BAR; PG8_MMA(1, 0, At, B0); PG8_MMA(1, 1, At, B1); PG8_BAR; PG8_SCHED; \
            PG8_LDB(B0, 1, 0); PG8_LDB(B1, 1, 1); PG8_SCHED; PG8_LDA(At, 1, 0); PG8_STAGE(PG8_SA(0, 1), a2 + hstepA, A); \
            WF; PG8_WAIT_L(0); PG8_BAR; PG8_MMA(0, 0, At, B0); PG8_MMA(0, 1, At, B1); PG8_BAR; PG8_SCHED; \
            PG8_LDA(At, 1, 1); PG8_STAGE(PG8_SB(1, 0), b3, B); PG8_STAGE(PG8_SB(1, 1), b3 + hstepB, B); PG8_STAGE(PG8_SA(1, 0), a3, A); \
            PG8_WAIT_V(8); PG8_WAIT_L(0); PG8_BAR; PG8_MMA(1, 0, At, B0); PG8_MMA(1, 1, At, B1); PG8_BAR; PG8_SCHED; } while (0)
        int t = 0;
        if constexpr (PEEL) { if (ui > 0) { PG8_TRIP(PG8_WAIT_VE); t = 2; } }
#pragma unroll 1
        for (; t < ntc; t += 2) PG8_TRIP(PG8_WAIT_V(8));
#undef PG8_TRIP
        if constexpr (ALIGN_EPI) { if (wr == 0) PG8_BAR; }
        { const int l_ = lane_id_opaque();
          if constexpr (Epi::LDSSCALE) E.run(acc, cur, wr, wc, l_ & 15, l_ >> 4, (const LAS float*)(lds + 8 * HTB + 4096 + (ui & 1) * 2048));
          else E(acc, cur, wr, wc, l_ & 15, l_ >> 4); }
        if (!has_next) break;
#pragma unroll
        for (int a = 0; a < 2; ++a)
#pragma unroll
            for (int b = 0; b < 2; ++b)
#pragma unroll
                for (int m = 0; m < 4; ++m)
#pragma unroll
                    for (int n = 0; n < 2; ++n) acc[a][b][m][n] = (f32x4){0.f, 0.f, 0.f, 0.f};
        cur = nxt; cA = nA; cB = nB; ++ui;
        if constexpr (ALIGN_EPI) { if (wr == 1) PG8_BAR; }
    }
    PG8_WAIT_V(0);
    if constexpr (!ALIGN_EPI) { if (wr == 0) PG8_BAR; }
    PG8_BAR;
#undef PG8_SA
#undef PG8_SB
#undef PG8_STAGE
#undef PG8_LDA
#undef PG8_LDB
#undef PG8_MMA
#undef PG8_CAT8
#undef PG8_WAIT_V
#undef PG8_WAIT_VE
#undef PG8_WAIT_L
#undef PG8_BAR
#undef PG8_SCHED
}
}
constexpr int BATCH = 8, SEQ = 4096, DM = 1024, MTOK = BATCH * SEQ;
constexpr int IN_COLS = 6568, IN_N = 6656;
constexpr int LAT_W = 512;
constexpr int QM_W = 768, KVM_W = 1024, UP_N = QM_W + KVM_W;
constexpr int BR_W = 512, Y3_W = 1536, GT_W = 3072;
constexpr int DFF = 2816, EFF = 3584, NEXP = 8;
constexpr int MOE_ROWS = (MTOK * 2 / 256 + NEXP) * 256;
constexpr int MOE_BLKS = MOE_ROWS / 256;
constexpr float RMS_EPS = 1e-6f;
constexpr float LOG2E = 1.4426950408889634f;
constexpr float C2_64 = 0.125f * LOG2E;
constexpr float C2_96 = 0.10206207261596577f * LOG2E;

typedef unsigned short bf16;
constexpr size_t MiB = 1u << 20;
constexpr size_t WS_CTL = 0, CTL_ZERO_BYTES = 1 * MiB;
#ifndef DENSE_DOWN_F8
#define DENSE_DOWN_F8 1
#endif
constexpr size_t WS_SMALL = 1 * MiB;
constexpr size_t OFF_SSQ = WS_SMALL;
constexpr size_t OFF_LOGF = OFF_SSQ + (size_t)MTOK * 8 * 4;
constexpr size_t OFF_CUM = OFF_LOGF + (size_t)MTOK * 8 * 4;
constexpr size_t OFF_KMEAN = OFF_CUM + (size_t)MTOK * 8 * 4;
constexpr size_t OFF_R64C = OFF_KMEAN + (size_t)BATCH * 16 * 512 * 4;
constexpr size_t OFF_R64S = OFF_R64C + (size_t)MTOK * 32 * 4;
constexpr size_t OFF_R32C = OFF_R64S + (size_t)MTOK * 32 * 4;
constexpr size_t OFF_R32S = OFF_R32C + (size_t)MTOK * 16 * 4;
constexpr size_t OFF_TOKI = OFF_R32S + (size_t)MTOK * 16 * 4;
constexpr size_t OFF_TOKW = OFF_TOKI + (size_t)MTOK * 16;
constexpr size_t OFF_TOKR = OFF_TOKW + (size_t)MTOK * 8;
constexpr size_t OFF_CNT = OFF_TOKR + (size_t)MTOK * 8;
constexpr size_t OFF_MTAB = OFF_CNT + 256 * 8 * 4;
constexpr size_t OFF_KNM = OFF_MTAB + 512 * 4;
constexpr size_t OFF_RSX = OFF_KNM + 256;
constexpr size_t OFF_RSG = OFF_RSX + (size_t)MTOK * 4;
constexpr size_t OFF_CSC = OFF_RSG + (size_t)MOE_ROWS * 4;
constexpr size_t OFF_CSIN = OFF_CSC + (size_t)2 * DFF * 4;
constexpr size_t OFF_RSIN = OFF_CSIN + (size_t)2 * IN_N * 4;
constexpr size_t OFF_CSE = OFF_RSIN + (size_t)MTOK * 4;
constexpr size_t OFF_WPRE = OFF_CSE + (size_t)8 * 2 * EFF * 4;
constexpr size_t OFF_SMALL_END = OFF_WPRE + (size_t)256 * 8 * 8 * 4;
constexpr size_t WS_W = 20 * MiB;
constexpr size_t W_IN_E = (size_t)IN_N * DM, W_UP_E = (size_t)UP_N * 256, W_BR_E = (size_t)DM * Y3_W, W_OUT_E = (size_t)DM * DM;
constexpr size_t W_LAYER_E = W_IN_E + W_UP_E + W_BR_E + W_OUT_E;
constexpr size_t OFF_WL = WS_W;
constexpr size_t OFF_WDGU = OFF_WL + 2 * W_LAYER_E * 2;
constexpr size_t OFF_WDDN = OFF_WDGU + (size_t)2 * DFF * DM * 2;
constexpr size_t OFF_WEGU = OFF_WDDN + (size_t)DM * DFF * 2;
constexpr size_t OFF_WEDN = OFF_WEGU + (size_t)NEXP * 2 * EFF * DM;
constexpr size_t OFF_W_END = OFF_WEDN + (size_t)NEXP * DM * EFF;
constexpr float W8S_GU = 1024.0f, W8S_DN = 2048.0f, A8S_ACT = 8.0f, A8_ROWMAX = 384.0f;
constexpr size_t WS_ACT = ((OFF_W_END + MiB - 1) / MiB) * MiB;
constexpr size_t OFF_XN = WS_ACT;
constexpr size_t OFF_QM = OFF_XN;
constexpr size_t OFF_LAT = OFF_XN + (size_t)MTOK * DM * 2;
constexpr size_t OFF_KR = OFF_LAT + (size_t)MTOK * LAT_W * 2;
constexpr size_t OFF_FQ = OFF_KR + (size_t)MTOK * 32 * 2;
constexpr size_t OFF_FK = OFF_FQ + (size_t)MTOK * BR_W * 2, OFF_FV = OFF_FK + (size_t)MTOK * BR_W * 2;
constexpr size_t OFF_MQ = OFF_FV + (size_t)MTOK * BR_W * 2, OFF_MK = OFF_MQ + (size_t)MTOK * BR_W * 2, OFF_MV = OFF_MK + (size_t)MTOK * BR_W * 2;
constexpr size_t OFF_GT = OFF_MV + (size_t)MTOK * BR_W * 2;
constexpr size_t OFF_KVM = OFF_GT + (size_t)MTOK * GT_W * 2;
constexpr size_t OFF_MERGED = OFF_KVM;
constexpr size_t OFF_Y3 = OFF_KVM + (size_t)MTOK * KVM_W * 2;
constexpr size_t OFF_XN8 = OFF_Y3;
constexpr size_t OFF_XS = OFF_Y3 + (size_t)MTOK * Y3_W * 2;
constexpr size_t OFF_ACT_END = OFF_XS + (size_t)MTOK * DM * 2;
constexpr size_t OFF_ACTD = OFF_LAT;
constexpr size_t OFF_XG = OFF_LAT;
constexpr size_t OFF_ACTM = OFF_XG + (size_t)MOE_ROWS * DM;
constexpr size_t OFF_YE = OFF_ACTM + (size_t)MOE_ROWS * EFF;
constexpr size_t OFF_MOE_END = OFF_YE + (size_t)MOE_ROWS * DM * 2;
constexpr size_t WS_NEED = OFF_ACT_END;
static_assert(OFF_SMALL_END <= WS_W, "small tables");
static_assert(OFF_ACTD + (size_t)MTOK * DFF * 2 <= OFF_KVM, "dense hidden overlay must not reach MERGED");
static_assert(OFF_MOE_END <= OFF_XN8, "MoE buffers must not reach XN8 (the gather reads it)");
constexpr int CW_BAR = 4096;

namespace pg8 {
struct EpiIn {
    static constexpr bool LDSSCALE = true; static constexpr bool MIDK = false; static constexpr int MID0 = -1, MID1 = -1; static constexpr int NVM = 16;
    unsigned char* ws; const float* bfg; const float* CS;
    __device__ __forceinline__ const float* cs_src(const Unit& u) const { return CS + u.pn * BM; }
    __device__ __forceinline__ const float* rs_src(const Unit& u) const { return (const float*)(ws + OFF_RSIN) + u.pm * BM; }
    __device__ __forceinline__ void run(Acc& acc, const Unit& u, int wr, int wc, int fr, int fq, const LAS float* sl) const {
        unsigned char* w = ws; asm volatile("" : "+s"(w));
        { f32x4 cs[2][2];
#pragma unroll
            for (int bj = 0; bj < 2; ++bj)
#pragma unroll
                for (int n = 0; n < 2; ++n) cs[bj][n] = *(const LAS f32x4*)(sl + bj * HALF + wc * 32 + 16 * n + 4 * fq);
#pragma unroll
            for (int ai = 0; ai < 2; ++ai)
#pragma unroll
                for (int m = 0; m < 4; ++m) { const float rs = sl[256 + wr * 64 + fr + ai * HALF + m * 16];
#pragma unroll
                    for (int bj = 0; bj < 2; ++bj)
#pragma unroll
                        for (int n = 0; n < 2; ++n) { const i32x4 iv = __builtin_bit_cast(i32x4, acc[ai][bj][m][n]);
                            acc[ai][bj][m][n] = (f32x4){(float)iv[0], (float)iv[1], (float)iv[2], (float)iv[3]} * (cs[bj][n] * rs); } } }
        bf16_t* LAT = (bf16_t*)(w + OFF_LAT); bf16_t* KR = (bf16_t*)(w + OFF_KR); bf16_t* FQ = (bf16_t*)(w + OFF_FQ); bf16_t* GT = (bf16_t*)(w + OFF_GT);
        float* LOGF = (float*)(w + OFF_LOGF); float* SSQ = (float*)(w + OFF_SSQ);
        const float* R64C = (const float*)(w + OFF_R64C); const float* R64S = (const float*)(w + OFF_R64S); const float* R32C = (const float*)(w + OFF_R32C); const float* R32S = (const float*)(w + OFF_R32S);
        const int pn = u.pn; const int row0 = u.pm * BM + wr * 64 + fr;
        if (pn == 0) {
#pragma unroll
            for (int ai = 0; ai < 2; ++ai)
#pragma unroll
                for (int m = 0; m < 4; ++m) { const int row = row0 + ai * HALF + m * 16; float s = 0.f;
#pragma unroll
                    for (int bj = 0; bj < 2; ++bj) { const f32x4 v0 = acc[ai][bj][m][0], v1 = acc[ai][bj][m][1];
                        s += (v0[0] * v0[0] + v0[1] * v0[1]) + (v0[2] * v0[2] + v0[3] * v0[3]) + (v1[0] * v1[0] + v1[1] * v1[1]) + (v1[2] * v1[2] + v1[3] * v1[3]);
                        *(u32x4*)(LAT + (size_t)row * LAT_W + bj * HALF + wc * 32 + 8 * fq) = pack8(v0, v1); }
                    s += __shfl_xor(s, 16); s += __shfl_xor(s, 32);
                    if (fq == 0) SSQ[(size_t)row * 8 + wc] = s; asm volatile("" ::: "memory"); }
        } else if (pn == 1) {
#pragma unroll
            for (int ai = 0; ai < 2; ++ai)
#pragma unroll
                for (int m = 0; m < 4; ++m) { const int row = row0 + ai * HALF + m * 16;
                    { const f32x4 v0 = acc[ai][0][m][0], v1 = acc[ai][0][m][1];
                      float s = (v0[0] * v0[0] + v0[1] * v0[1]) + (v0[2] * v0[2] + v0[3] * v0[3]) + (v1[0] * v1[0] + v1[1] * v1[1]) + (v1[2] * v1[2] + v1[3] * v1[3]);
                      *(u32x4*)(LAT + (size_t)row * LAT_W + 256 + wc * 32 + 8 * fq) = pack8(v0, v1);
                      s += __shfl_xor(s, 16); s += __shfl_xor(s, 32);
                      if (fq == 0) SSQ[(size_t)row * 8 + 4 + wc] = s; }
                    *(u32x4*)(LAT + (size_t)row * LAT_W + 384 + wc * 32 + 8 * fq) = (u32x4){0u, 0u, 0u, 0u};
                    if (wc == 0) {
                        const f32x4 x1 = acc[ai][1][m][0], x2 = acc[ai][1][m][1];
                        const f32x4 c = *(const f32x4*)(R32C + (size_t)row * 16 + 4 * fq), s = *(const f32x4*)(R32S + (size_t)row * 16 + 4 * fq);
                        *(u32x2*)(KR + (size_t)row * 32 + 4 * fq) = pack4(x1 * c - x2 * s);
                        *(u32x2*)(KR + (size_t)row * 32 + 16 + 4 * fq) = pack4(x2 * c + x1 * s);
                    } else if (wc == 1 && fq < 2) {
                        const f32x4 z = acc[ai][1][m][0] + *(const f32x4*)(bfg + 4 * fq); f32x4 o;
#pragma unroll
                        for (int j = 0; j < 4; ++j) o[j] = fminf(z[j], 0.f) - log1pf(__expf(-fabsf(z[j])));
                        *(f32x4*)(LOGF + (size_t)row * 8 + 4 * fq) = o; }
                    asm volatile("" ::: "memory"); }
        } else if (pn >= 8 && pn < 12) {
            bf16_t* dst = FQ + (size_t)(3 + ((pn - 8) >> 1)) * ((size_t)MTOK * BR_W); const float sc = (pn < 10) ? C2_64 : 1.0f; const int colt = ((pn - 8) & 1) * 256;
            const int i0 = 16 * (wc & 1) + 4 * fq;
#pragma unroll
            for (int ai = 0; ai < 2; ++ai)
#pragma unroll
                for (int m = 0; m < 4; ++m) { const int row = row0 + ai * HALF + m * 16;
                    const f32x4 c = *(const f32x4*)(R64C + (size_t)row * 32 + i0) * sc, s = *(const f32x4*)(R64S + (size_t)row * 32 + i0) * sc;
#pragma unroll
                    for (int bj = 0; bj < 2; ++bj) { const f32x4 x1 = acc[ai][bj][m][0], x2 = acc[ai][bj][m][1];
                        bf16_t* p = dst + (size_t)row * BR_W + colt + (2 * bj + (wc >> 1)) * 64 + i0;
                        *(u32x2*)p = pack4(x1 * c - x2 * s); *(u32x2*)(p + 32) = pack4(x2 * c + x1 * s); } asm volatile("" ::: "memory"); }
        } else {
            bf16_t* dst; int pitch, colt; float sc = 1.0f; const bool sig = pn >= 14;
            if (!sig) { const int bi = (pn - 2) >> 1; dst = FQ + (size_t)bi * ((size_t)MTOK * BR_W); pitch = BR_W; colt = (pn & 1) * 256; if (pn < 4) sc = C2_64; }
            else { dst = GT; pitch = GT_W; colt = (pn - 14) * 256; }
#pragma unroll
            for (int ai = 0; ai < 2; ++ai)
#pragma unroll
                for (int m = 0; m < 4; ++m) { const int row = row0 + ai * HALF + m * 16;
#pragma unroll
                    for (int bj = 0; bj < 2; ++bj) { f32x4 v0 = acc[ai][bj][m][0], v1 = acc[ai][bj][m][1];
                        if (sig) {
#pragma unroll
                            for (int j = 0; j < 4; ++j) { v0[j] = fmaxf(fast_sigmoid(v0[j]), 1e-7f); v1[j] = fmaxf(fast_sigmoid(v1[j]), 1e-7f); }
                        } else { v0 = v0 * sc; v1 = v1 * sc; }
                        __builtin_nontemporal_store(pack8(v0, v1), (u32x4*)(dst + (size_t)row * pitch + colt + bj * HALF + wc * 32 + 8 * fq)); } }
        }
    }
};

struct EpiUp {
    static constexpr bool LDSSCALE = false; static constexpr bool MIDK = false; static constexpr int MID0 = -1, MID1 = -1; static constexpr int NVM = 16;
    unsigned char* ws;
    __device__ __forceinline__ void operator()(const Acc& acc, const Unit& u, int wr, int wc, int fr, int fq) const {
        unsigned char* w = ws; asm volatile("" : "+s"(w));
        bf16_t* QM = (bf16_t*)(w + OFF_QM); bf16_t* KVM = (bf16_t*)(w + OFF_KVM); const float* SSQ = (const float*)(w + OFF_SSQ); const float* R32C = (const float*)(w + OFF_R32C); const float* R32S = (const float*)(w + OFF_R32S);
        const int pn = u.pn; const int row0 = u.pm * BM + wr * 64 + fr; const bool isq = pn < 3;
#pragma unroll
        for (int ai = 0; ai < 2; ++ai)
#pragma unroll
            for (int m = 0; m < 4; ++m) { const int row = row0 + ai * HALF + m * 16;
                const f32x4 ss = *(const f32x4*)(SSQ + (size_t)row * 8 + (isq ? 0 : 4));
                const float tot = (ss[0] + ss[1]) + (ss[2] + ss[3]);
                const float r = isq ? rsqrtf(tot * (1.0f / 256.0f) + RMS_EPS) * C2_96 : rsqrtf(tot * (1.0f / 128.0f) + RMS_EPS);
#pragma unroll
                for (int bj = 0; bj < 2; ++bj) { const f32x4 v0 = acc[ai][bj][m][0] * r, v1 = acc[ai][bj][m][1] * r;
                    if (isq) { const int g = 8 * pn + 4 * bj + wc;
                        if (g % 3 == 2) { const f32x4 c = *(const f32x4*)(R32C + (size_t)row * 16 + 4 * fq), s = *(const f32x4*)(R32S + (size_t)row * 16 + 4 * fq);
                            bf16_t* p = QM + (size_t)row * QM_W + g * 32 + 4 * fq;
                            *(u32x2*)p = pack4(v0 * c - v1 * s); *(u32x2*)(p + 16) = pack4(v1 * c + v0 * s);
                        } else __builtin_nontemporal_store(pack8(v0, v1), (u32x4*)(QM + (size_t)row * QM_W + g * 32 + 8 * fq));
                    } else __builtin_nontemporal_store(pack8(v0, v1), (u32x4*)(KVM + (size_t)row * KVM_W + (pn - 3) * 256 + bj * HALF + wc * 32 + 8 * fq)); } asm volatile("" ::: "memory"); }
    }
};

struct EpiMerge {
    static constexpr bool LDSSCALE = false; static constexpr bool MIDK = true; static constexpr int MID0 = 8, MID1 = 16; static constexpr int NVM = 16;
    const bf16_t* GT; bf16_t* OUT;
    __device__ __forceinline__ void mid(Acc& acc, const Unit& u, int t, int wr, int wc, int fr, int fq) const {
        const int nb = (t == MID0) ? 0 : 1; const bf16_t* gbase = GT + (size_t)(u.pm * BM + wr * 64 + fr) * GT_W + nb * DM + u.pn * BM + wc * 32 + 8 * fq;
#pragma unroll
        for (int ai = 0; ai < 2; ++ai) { u32x4 ga[4][2], gb[4][2];
#pragma unroll
            for (int m = 0; m < 4; ++m)
#pragma unroll
                for (int bj = 0; bj < 2; ++bj) { const bf16_t* gp = gbase + (size_t)(ai * HALF + m * 16) * GT_W + bj * HALF; ga[m][bj] = *(const u32x4*)gp; gb[m][bj] = *(const u32x4*)(gp + DM); }
#pragma unroll
            for (int m = 0; m < 4; ++m) {
#pragma unroll
                for (int bj = 0; bj < 2; ++bj)
#pragma unroll
                    for (int j = 0; j < 4; ++j) { const unsigned wa = ga[m][bj][j], wb = gb[m][bj][j]; const int n = j >> 1, e = (j & 1) * 2;
                        acc[ai][bj][m][n][e] *= bf_lo(wa) * __builtin_amdgcn_rcpf(bf_lo(wb)); acc[ai][bj][m][n][e + 1] *= bf_hi(wa) * __builtin_amdgcn_rcpf(bf_hi(wb)); }
                asm volatile("" : "+v"(acc[ai][0][m][0]), "+v"(acc[ai][0][m][1]), "+v"(acc[ai][1][m][0]), "+v"(acc[ai][1][m][1])); }
            asm volatile("" ::: "memory"); }
    }
    __device__ __forceinline__ void operator()(const Acc& acc, const Unit& u, int wr, int wc, int fr, int fq) const {
        const int row0 = u.pm * BM + wr * 64 + fr; const int col0 = u.pn * BM + wc * 32 + 8 * fq;
#pragma unroll
        for (int ai = 0; ai < 2; ++ai) { u32x4 g[4][2];
#pragma unroll
            for (int m = 0; m < 4; ++m)
#pragma unroll
                for (int bj = 0; bj < 2; ++bj) g[m][bj] = *(const u32x4*)(GT + (size_t)(row0 + ai * HALF + m * 16) * GT_W + 2 * DM + col0 + bj * HALF);
#pragma unroll
            for (int m = 0; m < 4; ++m) { const int row = row0 + ai * HALF + m * 16;
#pragma unroll
                for (int bj = 0; bj < 2; ++bj) { const u32x4 gg = g[m][bj]; f32x4 v0 = acc[ai][bj][m][0], v1 = acc[ai][bj][m][1];
                    v0[0] *= bf_lo(gg[0]); v0[1] *= bf_hi(gg[0]); v0[2] *= bf_lo(gg[1]); v0[3] *= bf_hi(gg[1]); v1[0] *= bf_lo(gg[2]); v1[1] *= bf_hi(gg[2]); v1[2] *= bf_lo(gg[3]); v1[3] *= bf_hi(gg[3]);
                    *(u32x4*)(OUT + (size_t)row * DM + col0 + bj * HALF) = pack8(v0, v1); } }
            asm volatile("" ::: "memory"); }
    }
};

struct EpiResid {
    static constexpr bool LDSSCALE = false; static constexpr bool MIDK = false; static constexpr int MID0 = -1, MID1 = -1; static constexpr int NVM = 0;
    const float* base; float* out;
    __device__ __forceinline__ void operator()(const Acc& acc, const Unit& u, int wr, int wc, int fr, int fq) const {
        const int row0 = u.pm * BM + wr * 64 + fr; const int col0 = u.pn * BM + wc * 32 + 4 * fq;
#pragma unroll
        for (int ai = 0; ai < 2; ++ai)
#pragma unroll
            for (int m = 0; m < 4; ++m) { const size_t off = (size_t)(row0 + ai * HALF + m * 16) * DM + col0;
#pragma unroll
                for (int bj = 0; bj < 2; ++bj)
#pragma unroll
                    for (int n = 0; n < 2; ++n) { const f32x4 b = *(const f32x4*)(base + off + bj * HALF + n * 16); *(f32x4*)(out + off + bj * HALF + n * 16) = b + acc[ai][bj][m][n]; } asm volatile("" ::: "memory"); }
    }
};

template <bool BASE32> struct EpiResidB {
    static constexpr bool LDSSCALE = false; static constexpr bool MIDK = false; static constexpr int MID0 = -1, MID1 = -1; static constexpr int NVM = 16;
    const void* base; bf16_t* out; float sc;
    __device__ __forceinline__ void operator()(const Acc& acc, const Unit& u, int wr, int wc, int fr, int fq) const {
        const size_t off0 = (size_t)(u.pm * BM + wr * 64 + fr) * DM + u.pn * BM + wc * 32 + 8 * fq;
        if constexpr (BASE32) {
#pragma unroll
            for (int ai = 0; ai < 2; ++ai) { f32x4 b[4][2][2];
#pragma unroll
                for (int m = 0; m < 4; ++m)
#pragma unroll
                    for (int bj = 0; bj < 2; ++bj) { const float* bp = (const float*)base + off0 + (size_t)(ai * HALF + m * 16) * DM + bj * HALF; b[m][bj][0] = *(const f32x4*)bp; b[m][bj][1] = *(const f32x4*)(bp + 4); }
#pragma unroll
                for (int m = 0; m < 4; ++m)
#pragma unroll
                    for (int bj = 0; bj < 2; ++bj) *(u32x4*)(out + off0 + (size_t)(ai * HALF + m * 16) * DM + bj * HALF) = pack8(b[m][bj][0] + acc[ai][bj][m][0] * sc, b[m][bj][1] + acc[ai][bj][m][1] * sc);
                asm volatile("" ::: "memory"); }
        } else {
            u32x4 w[2][4][2];
#pragma unroll
            for (int ai = 0; ai < 2; ++ai)
#pragma unroll
                for (int m = 0; m < 4; ++m)
#pragma unroll
                    for (int bj = 0; bj < 2; ++bj) w[ai][m][bj] = *(const u32x4*)((const bf16_t*)base + off0 + (size_t)(ai * HALF + m * 16) * DM + bj * HALF);
            asm volatile("" ::: "memory");
#pragma unroll
            for (int ai = 0; ai < 2; ++ai)
#pragma unroll
                for (int m = 0; m < 4; ++m) {
#pragma unroll
                    for (int bj = 0; bj < 2; ++bj) { const u32x4 ww = w[ai][m][bj]; const f32x4 b0 = {bf_lo(ww.x), bf_hi(ww.x), bf_lo(ww.y), bf_hi(ww.y)}, b1 = {bf_lo(ww.z), bf_hi(ww.z), bf_lo(ww.w), bf_hi(ww.w)};
                        *(u32x4*)(out + off0 + (size_t)(ai * HALF + m * 16) * DM + bj * HALF) = pack8(b0 + acc[ai][bj][m][0] * sc, b1 + acc[ai][bj][m][1] * sc); }
                    asm volatile("" ::: "memory"); }
        }
    }
};
struct EpiSwiglu {
    static constexpr bool LDSSCALE = false; static constexpr bool MIDK = false; static constexpr int MID0 = -1, MID1 = -1; static constexpr int NVM = 0;
    bf16_t* ACT; int pitch;
    __device__ __forceinline__ void operator()(const Acc& acc, const Unit& u, int wr, int wc, int fr, int fq) const {
        const int row0 = u.pm * BM + wr * 64 + fr; const int col = u.pn * HALF + wc * 32 + 8 * fq;
#pragma unroll
        for (int ai = 0; ai < 2; ++ai)
#pragma unroll
            for (int m = 0; m < 4; ++m) { f32x4 o[2];
#pragma unroll
                for (int n = 0; n < 2; ++n)
#pragma unroll
                    for (int j = 0; j < 4; ++j) { const float gv = acc[ai][0][m][n][j], uv = acc[ai][1][m][n][j]; o[n][j] = gv * fast_sigmoid(gv) * uv; }
                *(u32x4*)(ACT + (size_t)(row0 + ai * HALF + m * 16) * pitch + col) = pack8(o[0], o[1]); }
    }
};

struct EpiSwigluB8 {
    static constexpr bool LDSSCALE = false; static constexpr bool MIDK = false; static constexpr int MID0 = -1, MID1 = -1; static constexpr int NVM = 0;
    unsigned char* ACT; int pitch;
    __device__ __forceinline__ void operator()(const Acc& acc, const Unit& u, int wr, int wc, int fr, int fq) const {
        const int row0 = u.pm * BM + wr * 64 + fr; const int col = u.pn * HALF + wc * 32 + 8 * fq;
#pragma unroll
        for (int ai = 0; ai < 2; ++ai)
#pragma unroll
            for (int m = 0; m < 4; ++m) { float o[8];
#pragma unroll
                for (int n = 0; n < 2; ++n)
#pragma unroll
                    for (int j = 0; j < 4; ++j) { const float gv = acc[ai][0][m][n][j], uv = acc[ai][1][m][n][j]; o[4 * n + j] = gv * fast_sigmoid(gv) * uv * A8S_ACT; }
                u32x2 w; w.x = pk4_f8(o[0], o[1], o[2], o[3]); w.y = pk4_f8(o[4], o[5], o[6], o[7]);
                *(u32x2*)(ACT + (size_t)(row0 + ai * HALF + m * 16) * pitch + col) = w; }
    }
};
struct SwigluI8Core {
    __device__ static __forceinline__ f32x2 pair(int g0, int g1, int u0, int u1, f32x2 cg, f32x2 cu, float a, float irs2) {
        const f32x2 t = (f32x2){(float)g0, (float)g1} * cg, w = (f32x2){(float)u0, (float)u1} * cu, ar = t * (f32x2){a, a};
        const f32x2 e = {__builtin_amdgcn_exp2f(ar.x), __builtin_amdgcn_exp2f(ar.y)};
        const f32x2 d = e * (f32x2){irs2, irs2} + (f32x2){irs2, irs2};
        const f32x2 r = {__builtin_amdgcn_rcpf(d.x), __builtin_amdgcn_rcpf(d.y)};
        return (t * w) * r; }
};
struct EpiSwigluI8 {
    static constexpr bool LDSSCALE = true; static constexpr bool MIDK = false; static constexpr int MID0 = -1, MID1 = -1; static constexpr int NVM = 8;
    unsigned char* ACT; int pitch; const float* RS; const float* CS;
    __device__ __forceinline__ const float* cs_src(const Unit& u) const { return CS + u.bt * BM; }
    __device__ __forceinline__ const float* rs_src(const Unit& u) const { return RS + u.pm * BM; }
    __device__ __forceinline__ void run(const Acc& acc, const Unit& u, int wr, int wc, int fr, int fq, const LAS float* sl) const {
        const int row0 = u.pm * BM + wr * 64 + fr; const int col = u.pn * HALF + wc * 32 + 8 * fq;
        f32x4 cg[2], cu[2]; float rsv[8];
#pragma unroll
        for (int n = 0; n < 2; ++n) { cg[n] = *(const LAS f32x4*)(sl + wc * 32 + 16 * n + 4 * fq); cu[n] = *(const LAS f32x4*)(sl + HALF + wc * 32 + 16 * n + 4 * fq) * A8S_ACT; }
#pragma unroll
        for (int i = 0; i < 8; ++i) rsv[i] = sl[256 + wr * 64 + fr + (i >> 2) * HALF + (i & 3) * 16];
#pragma unroll
        for (int ai = 0; ai < 2; ++ai)
#pragma unroll
            for (int m = 0; m < 4; ++m) { const int row = row0 + ai * HALF + m * 16; const float rs = rsv[ai * 4 + m]; const float a = rs * -1.4426950408889634f, irs2 = __builtin_amdgcn_rcpf(rs * rs); u32x2 w;
#pragma unroll
                for (int n = 0; n < 2; ++n) { const i32x4 ig = __builtin_bit_cast(i32x4, acc[ai][0][m][n]), iu = __builtin_bit_cast(i32x4, acc[ai][1][m][n]);
                    const f32x2 o0 = SwigluI8Core::pair(ig[0], ig[1], iu[0], iu[1], (f32x2){cg[n][0], cg[n][1]}, (f32x2){cu[n][0], cu[n][1]}, a, irs2);
                    const f32x2 o1 = SwigluI8Core::pair(ig[2], ig[3], iu[2], iu[3], (f32x2){cg[n][2], cg[n][3]}, (f32x2){cu[n][2], cu[n][3]}, a, irs2);
                    w[n] = pk4_f8(o0.x, o0.y, o1.x, o1.y); }
                *(u32x2*)(ACT + (size_t)row * pitch + col) = w; asm volatile("" ::: "memory"); }
    }
};
struct EpiSwigluI8B {
    static constexpr bool LDSSCALE = true; static constexpr bool MIDK = false; static constexpr int MID0 = -1, MID1 = -1; static constexpr int NVM = 8;
    bf16_t* ACT; int pitch; const float* RS; const float* CS;
    __device__ __forceinline__ const float* cs_src(const Unit& u) const { return CS + u.bt * BM; }
    __device__ __forceinline__ const float* rs_src(const Unit& u) const { return RS + u.pm * BM; }
    __device__ __forceinline__ void run(const Acc& acc, const Unit& u, int wr, int wc, int fr, int fq, const LAS float* sl) const {
        const int row0 = u.pm * BM + wr * 64 + fr; const int col = u.pn * HALF + wc * 32 + 8 * fq;
        f32x4 cg[2], cu[2]; float rsv[8];
#pragma unroll
        for (int n = 0; n < 2; ++n) { cg[n] = *(const LAS f32x4*)(sl + wc * 32 + 16 * n + 4 * fq); cu[n] = *(const LAS f32x4*)(sl + HALF + wc * 32 + 16 * n + 4 * fq); }
#pragma unroll
        for (int i = 0; i < 8; ++i) rsv[i] = sl[256 + wr * 64 + fr + (i >> 2) * HALF + (i & 3) * 16];
#pragma unroll
        for (int ai = 0; ai < 2; ++ai)
#pragma unroll
            for (int m = 0; m < 4; ++m) { const int row = row0 + ai * HALF + m * 16; const float rs = rsv[ai * 4 + m]; const float a = rs * -1.4426950408889634f, irs2 = __builtin_amdgcn_rcpf(rs * rs); f32x4 o[2];
#pragma unroll
                for (int n = 0; n < 2; ++n) { const i32x4 ig = __builtin_bit_cast(i32x4, acc[ai][0][m][n]), iu = __builtin_bit_cast(i32x4, acc[ai][1][m][n]);
                    const f32x2 o0 = SwigluI8Core::pair(ig[0], ig[1], iu[0], iu[1], (f32x2){cg[n][0], cg[n][1]}, (f32x2){cu[n][0], cu[n][1]}, a, irs2);
                    const f32x2 o1 = SwigluI8Core::pair(ig[2], ig[3], iu[2], iu[3], (f32x2){cg[n][2], cg[n][3]}, (f32x2){cu[n][2], cu[n][3]}, a, irs2);
                    o[n] = (f32x4){o0.x, o0.y, o1.x, o1.y}; }
                *(u32x4*)(ACT + (size_t)row * pitch + col) = pack8(o[0], o[1]); asm volatile("" ::: "memory"); }
    }
};
struct EpiSwiglu8 {
    static constexpr bool LDSSCALE = false; static constexpr bool MIDK = false; static constexpr int MID0 = -1, MID1 = -1; static constexpr int NVM = 0;
    unsigned char* ACT; int pitch; const float* RS;
    __device__ __forceinline__ void operator()(const Acc& acc, const Unit& u, int wr, int wc, int fr, int fq) const {
        const int row0 = u.pm * BM + wr * 64 + fr; const int col = u.pn * HALF + wc * 32 + 8 * fq;
        float rsv[8];
#pragma unroll
        for (int i = 0; i < 8; ++i) rsv[i] = RS[row0 + (i >> 2) * HALF + (i & 3) * 16];
#pragma unroll
        for (int ai = 0; ai < 2; ++ai)
#pragma unroll
            for (int m = 0; m < 4; ++m) { const int row = row0 + ai * HALF + m * 16; const float rs = rsv[ai * 4 + m] * (1.0f / W8S_GU); float o[8];
#pragma unroll
                for (int n = 0; n < 2; ++n)
#pragma unroll
                    for (int j = 0; j < 4; ++j) { const float gv = acc[ai][0][m][n][j] * rs, uv = acc[ai][1][m][n][j] * rs; o[4 * n + j] = gv * fast_sigmoid(gv) * uv * A8S_ACT; }
                u32x2 w; w.x = pk4_f8(o[0], o[1], o[2], o[3]); w.y = pk4_f8(o[4], o[5], o[6], o[7]);
                *(u32x2*)(ACT + (size_t)row * pitch + col) = w; asm volatile("" ::: "memory"); }
    }
};
struct EpiNull {
    static constexpr bool LDSSCALE = false; static constexpr bool MIDK = false; static constexpr int MID0 = -1, MID1 = -1; static constexpr int NVM = 0;
    __device__ __forceinline__ void operator()(const Acc& acc, const Unit& u, int wr, int wc, int fr, int fq) const {
#pragma unroll
        for (int a = 0; a < 2; ++a)
#pragma unroll
            for (int b = 0; b < 2; ++b)
#pragma unroll
                for (int m = 0; m < 4; ++m)
#pragma unroll
                    for (int n = 0; n < 2; ++n) asm volatile("" :: "v"(acc[a][b][m][n]));
    }
};
struct EpiResid8 {
    static constexpr bool LDSSCALE = false; static constexpr bool MIDK = false; static constexpr int MID0 = -1, MID1 = -1; static constexpr int NVM = 0;
    const float* base; float* out; float sc;
    __device__ __forceinline__ void operator()(const Acc& acc, const Unit& u, int wr, int wc, int fr, int fq) const {
        const int row0 = u.pm * BM + wr * 64 + fr; const int col0 = u.pn * BM + wc * 32 + 4 * fq;
#pragma unroll
        for (int ai = 0; ai < 2; ++ai)
#pragma unroll
            for (int m = 0; m < 4; ++m) { const size_t off = (size_t)(row0 + ai * HALF + m * 16) * DM + col0;
#pragma unroll
                for (int bj = 0; bj < 2; ++bj)
#pragma unroll
                    for (int n = 0; n < 2; ++n) { const f32x4 b = *(const f32x4*)(base + off + bj * HALF + n * 16); *(f32x4*)(out + off + bj * HALF + n * 16) = b + acc[ai][bj][m][n] * sc; } asm volatile("" ::: "memory"); }
    }
};
struct EpiBf8 {
    static constexpr bool LDSSCALE = false; static constexpr bool MIDK = false; static constexpr int MID0 = -1, MID1 = -1; static constexpr int NVM = 16;
    bf16_t* OUT; int pitch; float sc;
    __device__ __forceinline__ void operator()(const Acc& acc, const Unit& u, int wr, int wc, int fr, int fq) const {
        const int row0 = u.pm * BM + wr * 64 + fr;
#pragma unroll
        for (int ai = 0; ai < 2; ++ai)
#pragma unroll
            for (int m = 0; m < 4; ++m)
#pragma unroll
                for (int bj = 0; bj < 2; ++bj) *(u32x4*)(OUT + (size_t)(row0 + ai * HALF + m * 16) * pitch + u.pn * BM + bj * HALF + wc * 32 + 8 * fq) = pack8(acc[ai][bj][m][0] * sc, acc[ai][bj][m][1] * sc);
    }
};
struct EpiBf8K {
    static constexpr bool LDSSCALE = false; static constexpr bool MIDK = false; static constexpr int MID0 = -1, MID1 = -1; static constexpr int NVM = 16;
    bf16_t* OUT; float* PART; float sc;
    __device__ __forceinline__ void operator()(const Acc& acc, const Unit& u, int wr, int wc, int fr, int fq) const {
        const int r0 = wr * 64 + fr; const int col = u.pn * BM + wc * 32 + 8 * fq;
        if (u.ks < 0) {
#pragma unroll
            for (int ai = 0; ai < 2; ++ai)
#pragma unroll
                for (int m = 0; m < 4; ++m)
#pragma unroll
                    for (int bj = 0; bj < 2; ++bj) *(u32x4*)(OUT + (size_t)(u.pm * BM + r0 + ai * HALF + m * 16) * DM + col + bj * HALF) = pack8(acc[ai][bj][m][0] * sc, acc[ai][bj][m][1] * sc);
        } else { float* pb = PART + (size_t)(((u.pm - 256) * 7 + u.ks) * 256 + r0) * DM + col;
#pragma unroll
            for (int ai = 0; ai < 2; ++ai)
#pragma unroll
                for (int m = 0; m < 4; ++m)
#pragma unroll
                    for (int bj = 0; bj < 2; ++bj) { float* q = pb + (size_t)(ai * HALF + m * 16) * DM + bj * HALF; *(f32x4*)q = acc[ai][bj][m][0] * sc; *(f32x4*)(q + 4) = acc[ai][bj][m][1] * sc; } }
    }
};
}
namespace att {
using bf16 = __hip_bfloat16;
using bf16x8 = __attribute__((ext_vector_type(8))) short;
using s16x4 = __attribute__((ext_vector_type(4))) short;
using f32x16 = __attribute__((ext_vector_type(16))) float;
using f32x4 = __attribute__((ext_vector_type(4))) float;
using f32x2 = __attribute__((ext_vector_type(2))) float;
using u32x4 = __attribute__((ext_vector_type(4))) unsigned;
typedef LAS const char* lds_cptr;
typedef LAS char* lds_ptr;
constexpr int NW = 8, QBLK = 32, QB = QBLK * NW, KVBLK = 64, NQB = SEQ / QB, NSLOT = 3;
constexpr int KSLOT = 12288, VSLOT = 8192;
constexpr int LDS_K = 0, LDS_V = NSLOT * KSLOT, LDS_CB = LDS_V + NSLOT * VSLOT, LDS_KM = LDS_CB + SEQ * 4, LDS_WS = LDS_KM + 8192, LDS_OST = LDS_WS + NW * 64 * 4, LDS_BYTES = LDS_OST + NW * 4096;
static_assert(LDS_BYTES <= 131072, "attention LDS");
constexpr float NEGBIG = -1.0e30f;
constexpr float THR = 8.0f;
#define SBAR() __builtin_amdgcn_sched_barrier(0)
__device__ __forceinline__ int crow(int r, int hi) { return (r & 3) + 8 * (r >> 2) + 4 * hi; }
__device__ __forceinline__ void glds16(const void* gsrc, unsigned lds_dst) { unsigned keep;
    asm volatile("s_mov_b32 %0, m0\n\ts_mov_b32 m0, %2\n\ts_nop 0\n\tglobal_load_lds_dwordx4 %1, off\n\ts_mov_b32 m0, %0" : "=&s"(keep) : "v"(gsrc), "s"(lds_dst) : "memory"); }
typedef float f32x2_t __attribute__((ext_vector_type(2))); typedef __bf16 bf16x2_t __attribute__((ext_vector_type(2)));
__device__ __forceinline__ unsigned cvtpk_s(float lo, float hi) { f32x2_t v = {lo, hi}; bf16x2_t b = __builtin_convertvector(v, bf16x2_t); return __builtin_bit_cast(unsigned, b); }
#define WAIT_BAR(N) asm volatile("s_waitcnt vmcnt(" #N ") lgkmcnt(0)\n\ts_barrier" ::: "memory")

struct Args { const bf16* Q; const bf16* K; const bf16* KR; const bf16* V; bf16* O; const float* CUM; const float* KMEAN; int qpitch, kpitch, vpitch, opitch, qhs, khs; };

template <int ND> __device__ __forceinline__ void qkt(f32x16& p0, f32x16& p1, lds_cptr kb, const bf16x8* qr, const f32x16& cin) {
#pragma unroll
    for (int d0 = 0; d0 < ND; ++d0) {
        const bf16x8 b0 = *(const LAS bf16x8*)(kb + d0 * 2048); const bf16x8 b1 = *(const LAS bf16x8*)(kb + d0 * 2048 + 512);
        if (d0 == 0) { p0 = __builtin_amdgcn_mfma_f32_32x32x16_bf16(b0, qr[0], cin, 0, 0, 0); p1 = __builtin_amdgcn_mfma_f32_32x32x16_bf16(b1, qr[0], cin, 0, 0, 0); }
        else { p0 = __builtin_amdgcn_mfma_f32_32x32x16_bf16(b0, qr[d0], p0, 0, 0, 0); p1 = __builtin_amdgcn_mfma_f32_32x32x16_bf16(b1, qr[d0], p1, 0, 0, 0); } }
}
__device__ __forceinline__ float rowmax(const f32x16& p0, const f32x16& p1) {
    float a = fmaxf(fmaxf(p0[0], p0[1]), p1[0]), b = fmaxf(fmaxf(p0[2], p0[3]), p1[1]); a = fmaxf(fmaxf(a, p1[2]), p1[3]);
#pragma unroll
    for (int r = 4; r < 16; r += 4) { a = fmaxf(fmaxf(a, p0[r]), p0[r + 1]); b = fmaxf(fmaxf(b, p0[r + 2]), p0[r + 3]); a = fmaxf(fmaxf(a, p1[r]), p1[r + 1]); b = fmaxf(fmaxf(b, p1[r + 2]), p1[r + 3]); }
    const float m = fmaxf(a, b);
    auto rr = __builtin_amdgcn_permlane32_swap(__float_as_uint(m), __float_as_uint(m), false, false);
    return fmaxf(__uint_as_float(rr[0]), __uint_as_float(rr[1]));
}
struct VFrag { s16x4 lo[2][4], hi[2][4]; };
__device__ __forceinline__ void pv_issue(VFrag& f, int vb) {
#pragma unroll
    for (int d0 = 0; d0 < 2; ++d0)
#pragma unroll
        for (int ks = 0; ks < 4; ++ks) {
            asm volatile("ds_read_b64_tr_b16 %0,%1 offset:%c2" : "=&v"(f.lo[d0][ks]) : "v"(vb), "i"(d0 * 4096 + ks * 1024) : "memory");
            asm volatile("ds_read_b64_tr_b16 %0,%1 offset:%c2" : "=&v"(f.hi[d0][ks]) : "v"(vb), "i"(d0 * 4096 + ks * 1024 + 512) : "memory"); }
}
__device__ __forceinline__ void pv_mma(f32x16& o0, f32x16& o1, f32x16& o2, VFrag& f, bf16x8 pa0, bf16x8 pa1, bf16x8 pa2, bf16x8 pa3) {
    asm volatile("s_waitcnt lgkmcnt(0)" : "+v"(f.lo[0][0]), "+v"(f.lo[0][1]), "+v"(f.lo[0][2]), "+v"(f.lo[0][3]), "+v"(f.hi[0][0]), "+v"(f.hi[0][1]), "+v"(f.hi[0][2]), "+v"(f.hi[0][3]),
                 "+v"(f.lo[1][0]), "+v"(f.lo[1][1]), "+v"(f.lo[1][2]), "+v"(f.lo[1][3]), "+v"(f.hi[1][0]), "+v"(f.hi[1][1]), "+v"(f.hi[1][2]), "+v"(f.hi[1][3]) :: "memory");
#define PK(d, k) (bf16x8){f.lo[d][k][0], f.lo[d][k][1], f.lo[d][k][2], f.lo[d][k][3], f.hi[d][k][0], f.hi[d][k][1], f.hi[d][k][2], f.hi[d][k][3]}
    o0 = __builtin_amdgcn_mfma_f32_32x32x16_bf16(pa0, PK(0, 0), o0, 0, 0, 0); o1 = __builtin_amdgcn_mfma_f32_32x32x16_bf16(pa0, PK(1, 0), o1, 0, 0, 0);
    o0 = __builtin_amdgcn_mfma_f32_32x32x16_bf16(pa1, PK(0, 1), o0, 0, 0, 0); o1 = __builtin_amdgcn_mfma_f32_32x32x16_bf16(pa1, PK(1, 1), o1, 0, 0, 0);
    o0 = __builtin_amdgcn_mfma_f32_32x32x16_bf16(pa2, PK(0, 2), o0, 0, 0, 0); o1 = __builtin_amdgcn_mfma_f32_32x32x16_bf16(pa2, PK(1, 2), o1, 0, 0, 0);
    o0 = __builtin_amdgcn_mfma_f32_32x32x16_bf16(pa3, PK(0, 3), o0, 0, 0, 0); o1 = __builtin_amdgcn_mfma_f32_32x32x16_bf16(pa3, PK(1, 3), o1, 0, 0, 0);
#undef PK
    const bf16x8 ones = {0x3F80, 0x3F80, 0x3F80, 0x3F80, 0x3F80, 0x3F80, 0x3F80, 0x3F80};
    o2 = __builtin_amdgcn_mfma_f32_32x32x16_bf16(pa0, ones, o2, 0, 0, 0);
    o2 = __builtin_amdgcn_mfma_f32_32x32x16_bf16(pa1, ones, o2, 0, 0, 0);
    o2 = __builtin_amdgcn_mfma_f32_32x32x16_bf16(pa2, ones, o2, 0, 0, 0);
    o2 = __builtin_amdgcn_mfma_f32_32x32x16_bf16(pa3, ones, o2, 0, 0, 0);
}

template <int VAR, bool FIRST, bool BAND>
__device__ __forceinline__ void tile_step(f32x16& o0, f32x16& o1, f32x16& o2, float& mhat, const bf16x8* qr, lds_cptr kb, int vb, LAS float* wsf, lds_cptr cbp, bool take, int jb, int qrel, int hi, int r32) {
    constexpr int ND = (VAR == 0) ? 6 : 4;
    f32x16 cin; { const float c0 = (VAR == 2 && !BAND && !take) ? NEGBIG : -mhat;
#pragma unroll
        for (int r = 0; r < 16; ++r) cin[r] = c0; }
    f32x16 p0, p1; qkt<ND>(p0, p1, kb, qr, cin);
    if (VAR == 1) {
#pragma unroll
        for (int j = 0; j < 4; ++j) { const f32x4 b0 = *(const LAS f32x4*)(cbp + j * 32), b1 = *(const LAS f32x4*)(cbp + 128 + j * 32);
#pragma unroll
            for (int e = 0; e < 4; ++e) { p0[4 * j + e] += b0[e]; p1[4 * j + e] += b1[e]; } } }
    VFrag vf; pv_issue(vf, vb);
    if (BAND) { const int kb0 = 64 * jb + 4 * hi;
#pragma unroll
        for (int r = 0; r < 16; ++r) { const int kv = kb0 + (r & 3) + 8 * (r >> 2); if (kv > qrel) p0[r] = NEGBIG; if (kv + 32 > qrel) p1[r] = NEGBIG; } }
    const float rm = rowmax(p0, p1);
    if (FIRST) { mhat = rm;
#pragma unroll
        for (int r = 0; r < 16; ++r) { p0[r] -= rm; p1[r] -= rm; }
    } else if (__builtin_amdgcn_ballot_w64(rm > THR) != 0ull) {
        const float dl = fmaxf(rm, 0.f); mhat += dl;
#pragma unroll
        for (int r = 0; r < 16; ++r) { p0[r] -= dl; p1[r] -= dl; }
        const float f = __builtin_amdgcn_exp2f(-dl); if (hi == 0) wsf[r32] = f;
#pragma unroll
        for (int j = 0; j < 4; ++j) { const f32x4 fv = *(const LAS f32x4*)(wsf + 8 * j + 4 * hi);
#pragma unroll
            for (int e = 0; e < 4; ++e) { o0[4 * j + e] *= fv[e]; o1[4 * j + e] *= fv[e]; o2[4 * j + e] *= fv[e]; } }
    }
#pragma unroll
    for (int r = 0; r < 16; ++r) { p0[r] = __builtin_amdgcn_exp2f(p0[r]); p1[r] = __builtin_amdgcn_exp2f(p1[r]); }
    u32x4 pw0, pw1, pw2, pw3;
#define PKW(P, B) cvtpk_s(P[B], P[B + 1])
    pw0 = (u32x4){PKW(p0, 0), PKW(p0, 2), PKW(p0, 4), PKW(p0, 6)}; pw1 = (u32x4){PKW(p0, 8), PKW(p0, 10), PKW(p0, 12), PKW(p0, 14)};
    pw2 = (u32x4){PKW(p1, 0), PKW(p1, 2), PKW(p1, 4), PKW(p1, 6)}; pw3 = (u32x4){PKW(p1, 8), PKW(p1, 10), PKW(p1, 12), PKW(p1, 14)};
#undef PKW
    pv_mma(o0, o1, o2, vf, __builtin_bit_cast(bf16x8, pw0), __builtin_bit_cast(bf16x8, pw1), __builtin_bit_cast(bf16x8, pw2), __builtin_bit_cast(bf16x8, pw3));
}

template <int VAR>
__device__ __forceinline__ void attn_unit(int b, int h, int qb, const Args& A, char* shm, int wid) {
    constexpr int DK = (VAR == 0) ? 96 : 64, ND = DK / 16;
    const int lane = pg8::lane_id_opaque(), tid = wid * 64 + lane, r32 = lane & 31, hi = lane >> 5;
    const long rowbase = (long)b * SEQ; const int q0 = qb * QB;
    const unsigned lds0 = (unsigned)(uintptr_t)shm;
    const lds_cptr shm3 = (lds_cptr)shm;
    LAS float* wsf = (LAS float*)((lds_ptr)shm + LDS_WS) + wid * 64;
    const bf16* Qw = A.Q + (rowbase + q0 + wid * QBLK) * A.qpitch + h * A.qhs;
    const bf16* Kh = A.K + rowbase * A.kpitch + h * A.khs; const bf16* Vh = A.V + rowbase * A.vpitch + h * A.khs;
    const int NT = (q0 + QB) / KVBLK;
    bf16x8 qr[ND];
#pragma unroll
    for (int d0 = 0; d0 < ND; ++d0) qr[d0] = *reinterpret_cast<const bf16x8*>(&Qw[(long)r32 * A.qpitch + d0 * 16 + hi * 8]);
    const bf16* ksrc = Kh + (long)lane * A.kpitch + wid * 8;
    const bf16* ksrc2 = (VAR == 0) ? A.KR + (rowbase + lane) * 32 + (wid & 3) * 8 : nullptr;
    const bf16* vsrc = Vh + (long)(16 * (wid & 3) + (lane >> 2)) * A.vpitch + (wid >> 2) * 32 + (lane & 3) * 8;
    const unsigned kdst = lds0 + LDS_K + wid * 1024, kdst2 = lds0 + LDS_K + (8 + (wid & 3)) * 1024, vdst = lds0 + LDS_V + wid * 1024;
#define DMA_T(t, sl) do { glds16(ksrc + (long)(t) * KVBLK * A.kpitch, (unsigned)__builtin_amdgcn_readfirstlane(kdst + (sl) * KSLOT)); \
        if (VAR == 0) glds16(ksrc2 + (long)(t) * KVBLK * 32, (unsigned)__builtin_amdgcn_readfirstlane(kdst2 + (sl) * KSLOT)); \
        glds16(vsrc + (long)(t) * KVBLK * A.vpitch, (unsigned)__builtin_amdgcn_readfirstlane(vdst + (sl) * VSLOT)); } while (0)
#define TILE_OF(i) (((i) < 4) ? (NT - 4 + (i)) : (NT - 1 - (i)))
    if (VAR == 1) { const float* cu = A.CUM + ((long)b * 8 + h) * SEQ; const float c0 = cu[q0]; const int nk = q0 + QB; LAS float* CB = (LAS float*)((lds_ptr)shm + LDS_CB);
        for (int s = tid; s < nk; s += NW * 64) CB[s] = (c0 - cu[s]) * LOG2E; }
    if (VAR == 2) { const int idx = tid * 2, blk = idx >> 6, d = idx & 63; const f32x2 km = *(const f32x2*)(A.KMEAN + ((long)b * 16 + blk) * 512 + h * 64 + d);
        *(LAS unsigned*)((lds_ptr)shm + LDS_KM + (d >> 3) * 1024 + blk * 16 + (d & 7) * 2) = cvtpk_s(km[0], km[1]); }
    float qn2 = 0.f;
    if (VAR == 1) { float sq = 0.f;
#pragma unroll
        for (int d0 = 0; d0 < ND; ++d0)
#pragma unroll
            for (int e = 0; e < 8; ++e) { const float x = __uint_as_float((unsigned)(unsigned short)qr[d0][e] << 16); sq += x * x; }
        { auto rr = __builtin_amdgcn_permlane32_swap(__float_as_uint(sq), __float_as_uint(sq), false, false); sq = __uint_as_float(rr[0]) + __uint_as_float(rr[1]); }
#pragma unroll
        for (int o = 1; o < 32; o <<= 1) sq = fmaxf(sq, __shfl_xor(sq, o));
        qn2 = sq; if (lane == 0) ((LAS float*)((lds_ptr)shm + LDS_KM))[wid] = sq; }
    asm volatile("s_waitcnt vmcnt(0)" ::: "memory");
    DMA_T(TILE_OF(0), 0); DMA_T(TILE_OF(1), 1);
    float mhat = 0.f; f32x16 o0 = f32x16{}, o1 = f32x16{}, o2 = f32x16{};
    const int qrel = wid * QBLK + r32;
    const lds_cptr kb0 = shm3 + LDS_K + hi * 1024 + r32 * 16;
    const int vb0 = (int)(lds0 + LDS_V) + ((lane >> 4) & 1) * 32 + (lane & 3) * 8 + (4 * hi + ((lane & 15) >> 2)) * 64;
    const lds_cptr cb0 = shm3 + LDS_CB + 16 * hi;
    unsigned selmask = 0u;
    if (VAR == 0) WAIT_BAR(3); else WAIT_BAR(2);
    int NTe = NT;
    if (VAR == 1 && NT > 4) {
        const LAS float* qs = (const LAS float*)((lds_ptr)shm + LDS_KM); float q2 = 0.f;
#pragma unroll
        for (int w = 0; w < 8; ++w) q2 = fmaxf(q2, qs[w]);
        const float thr = -(64.0f + 2.05f * sqrtf(q2) * A.KMEAN[b * 8 + h]);
        const LAS float* CBt = (const LAS float*)((lds_ptr)shm + LDS_CB);
        const bool sk = (lane < NT - 4) && (CBt[64 * lane + 63] < thr);
        NTe = NT - (int)__builtin_popcountll(__builtin_amdgcn_ballot_w64(sk));
    }
    if (2 < NTe) DMA_T(TILE_OF(2), 2);
    if (VAR == 2 && qb > 0) {
        f32x16 pg = f32x16{}; const lds_cptr km = shm3 + LDS_KM + hi * 1024 + r32 * 16;
#pragma unroll
        for (int d0 = 0; d0 < 4; ++d0) pg = __builtin_amdgcn_mfma_f32_32x32x16_bf16(*(const LAS bf16x8*)(km + d0 * 2048), qr[d0], pg, 0, 0, 0);
        float G[16];
#pragma unroll
        for (int r = 0; r < 8; ++r) { auto rr = __builtin_amdgcn_permlane32_swap(__float_as_uint(pg[r]), __float_as_uint(pg[r]), false, false);
            const int blk = (r & 3) + 8 * (r >> 2); G[blk] = (blk < qb) ? __uint_as_float(rr[0]) : -INFINITY; G[blk + 4] = (blk + 4 < qb) ? __uint_as_float(rr[1]) : -INFINITY; }
#pragma unroll
        for (int k = 0; k < 3; ++k) { float best = -INFINITY; int bi = -1;
#pragma unroll
            for (int n = 0; n < 16; ++n) if (G[n] > best) { best = G[n]; bi = n; }
            if (bi >= 0) selmask |= 1u << bi;
#pragma unroll
            for (int n = 0; n < 16; ++n) if (n == bi) G[n] = -INFINITY; }
    }
    tile_step<VAR, true, true>(o0, o1, o2, mhat, qr, kb0, vb0, wsf, cb0 + (NT - 4) * 256, true, 0, qrel, hi, r32);
#pragma unroll 1
    for (int i = 1; i < 4; ++i) {
        if (i + 1 < NTe) { if (VAR == 0) WAIT_BAR(3); else WAIT_BAR(2); } else WAIT_BAR(0);
        if (i + 2 < NTe) DMA_T(TILE_OF(i + 2), (i + 2) % 3);
        if (64 * i <= 32 * wid + 31) tile_step<VAR, false, true>(o0, o1, o2, mhat, qr, kb0 + (i % 3) * KSLOT, vb0 + (i % 3) * VSLOT, wsf, cb0 + (NT - 4 + i) * 256, true, i, qrel, hi, r32);
    }
    if (VAR == 1 && NTe > 4) {
        float mm = mhat;
#pragma unroll
        for (int o = 1; o < 64; o <<= 1) mm = fminf(mm, __shfl_xor(mm, o));
        LAS float* qs = (LAS float*)((lds_ptr)shm + LDS_KM);
        if (lane == 0) qs[16 + wid] = mm;
        asm volatile("s_waitcnt lgkmcnt(0)\n\ts_barrier" ::: "memory");
        float mmin = qs[16], q2 = qs[0];
#pragma unroll
        for (int w = 1; w < 8; ++w) { mmin = fminf(mmin, qs[16 + w]); q2 = fmaxf(q2, qs[w]); }
        const float thr2 = mmin - 56.0f - 1.03f * sqrtf(q2) * A.KMEAN[b * 8 + h];
        const LAS float* CBt = (const LAS float*)((lds_ptr)shm + LDS_CB);
        const bool sk = (lane < NT - 4) && (CBt[64 * lane + 63] < thr2);
        const int nte2 = NT - (int)__builtin_popcountll(__builtin_amdgcn_ballot_w64(sk));
        NTe = nte2 < NTe ? nte2 : NTe;
    }
    int sl = 1;
#pragma unroll 1
    for (int i = 4; i < NTe; ++i) {
        const int t = NT - 1 - i;
        if (i + 1 < NTe) { if (VAR == 0) WAIT_BAR(3); else WAIT_BAR(2); } else WAIT_BAR(0);
        if (i + 2 < NTe) { const int s2 = (sl == 0) ? 2 : sl - 1; DMA_T(TILE_OF(i + 2), s2); }
        const bool take = (VAR == 2) ? (((selmask >> (t >> 2)) & 1u) != 0u) : true;
        tile_step<VAR, false, false>(o0, o1, o2, mhat, qr, kb0 + sl * KSLOT, vb0 + sl * VSLOT, wsf, cb0 + t * 256, take, 0, qrel, hi, r32);
        sl = (sl == 2) ? 0 : sl + 1;
    }
    float rli[16];
#pragma unroll
    for (int r = 0; r < 16; ++r) rli[r] = __builtin_amdgcn_rcpf(o2[r]);
    bf16* Ow = A.O + (rowbase + q0 + wid * QBLK) * A.opitch + h * 64;
    { LAS unsigned short* stg = (LAS unsigned short*)((lds_ptr)shm + LDS_OST) + wid * 2048;
#pragma unroll
        for (int r = 0; r < 16; ++r) { const int orow = crow(r, hi);
            const unsigned pk = cvtpk_s(o0[r] * rli[r], o1[r] * rli[r]); stg[orow * 64 + r32] = (unsigned short)(pk & 0xffffu); stg[orow * 64 + 32 + r32] = (unsigned short)(pk >> 16); }
        asm volatile("s_waitcnt lgkmcnt(0)" ::: "memory");
#pragma unroll
        for (int i = 0; i < 4; ++i) { const int row = i * 8 + (lane >> 3), ch = lane & 7; const u32x4 v = *(const LAS u32x4*)(stg + row * 64 + ch * 8); __builtin_nontemporal_store(v, (u32x4*)(Ow + (long)row * A.opitch + ch * 8)); } }
    asm volatile("s_waitcnt lgkmcnt(0)\n\ts_barrier" ::: "memory");
#undef DMA_T
#undef TILE_OF
}
#undef SBAR
#undef WAIT_BAR
}
constexpr int RING_OFF = 0, RING_BYTES = 131072;
constexpr int LDSCTL_OFF = RING_BYTES, MISC_OFF = LDSCTL_OFF + 320;
constexpr int LDS_BYTES = 147456;
constexpr int NWAVES = 8;

typedef unsigned v4u __attribute__((ext_vector_type(4)));
typedef unsigned v2u __attribute__((ext_vector_type(2)));
typedef float f32x4 __attribute__((ext_vector_type(4)));
typedef float f32x2 __attribute__((ext_vector_type(2)));
typedef int i32x4 __attribute__((ext_vector_type(4)));
typedef int i32x2 __attribute__((ext_vector_type(2)));
typedef GAS unsigned gu32;
#define RLX_AGENT __ATOMIC_RELAXED, __HIP_MEMORY_SCOPE_AGENT
#define LDS_WAIT() asm volatile("s_waitcnt lgkmcnt(0)" ::: "memory")
#define VM_WAIT() asm volatile("s_waitcnt vmcnt(0)" ::: "memory")
__device__ __forceinline__ unsigned f2bf(float f) { unsigned u = __builtin_bit_cast(unsigned, f); return (u + 0x7fffu + ((u >> 16) & 1u)) >> 16; }
__device__ __forceinline__ unsigned pk2(float lo, float hi) { return f2bf(lo) | (f2bf(hi) << 16); }
__device__ __forceinline__ float bfl(unsigned w) { return __uint_as_float(w << 16); }
__device__ __forceinline__ float bfh(unsigned w) { return __uint_as_float(w & 0xffff0000u); }

#define XB_TMO      128
#define XB_XCNT(j)  (256  + 64 * (j))
#define XB_XSUB(j)  (1280 + 64 * (j))
#define XB_XGEN(j)  (2304 + 64 * (j))
#define XB_TOP      3328
#define XB_TOPGEN   3392
#define XCD_BAR_WORDS 3456
#define XB_SPIN_CAP (1u << 18)
__device__ __forceinline__ unsigned xb_ld(unsigned* p)              { return __hip_atomic_load(p, __ATOMIC_RELAXED, __HIP_MEMORY_SCOPE_AGENT); }
__device__ __forceinline__ unsigned xb_add(unsigned* p, unsigned v) { return __hip_atomic_fetch_add(p, v, __ATOMIC_RELAXED, __HIP_MEMORY_SCOPE_AGENT); }
__device__ __forceinline__ unsigned xb_xcc_id() { return (unsigned)__builtin_amdgcn_s_getreg((3 << 11) | 20) & 0xFu; }
#define XB_SPIN(cond, bar) do { unsigned _sp = 0; while (cond) { __builtin_amdgcn_s_sleep(1); \
    if ((++_sp & 255u) == 0u) { if (xb_ld(&(bar)[XB_TMO])) break; if (_sp > XB_SPIN_CAP) { atomicAdd(&(bar)[XB_TMO], 1u); break; } } } } while (0)
struct XcdBarrier { unsigned* bar; unsigned x; volatile LAS unsigned* st; };
__device__ __forceinline__ XcdBarrier xcd_barrier_post(unsigned* bar, volatile LAS unsigned* st) {
    XcdBarrier b; b.bar = bar; b.x = xb_xcc_id(); b.st = st;
    if (threadIdx.x == 0) (void)xb_add(&bar[XB_XCNT(b.x)], 1u);
    return b;
}
__device__ __forceinline__ void xcd_barrier_complete(unsigned* bar, unsigned x, unsigned& nloc, unsigned& nx) {
    const unsigned G = gridDim.x * gridDim.y * gridDim.z;
    unsigned sum, cnt, mine, sp = 0u;
    for (;;) {
        sum = 0u; cnt = 0u; mine = 0u;
#pragma unroll
        for (unsigned j = 0; j < 16; ++j) { const unsigned c = xb_ld(&bar[XB_XCNT(j)]); sum += c; cnt += (c > 0u) ? 1u : 0u; mine = (j == x) ? c : mine; }
        if (sum == G) break;
        __builtin_amdgcn_s_sleep(1);
        if ((++sp & 255u) == 0u) { if (xb_ld(&bar[XB_TMO])) break; if (sp > XB_SPIN_CAP) { atomicAdd(&bar[XB_TMO], 1u); break; } }
    }
    nloc = mine > 0u ? mine : 1u; nx = cnt > 0u ? cnt : 1u;
}
__device__ __forceinline__ void xcd_barrier(const XcdBarrier& b, int wave) {
    asm volatile("s_waitcnt vmcnt(0)" ::: "memory");
    __syncthreads();
    if (wave == 0 && pg8::lane_id_opaque() == 0) {
        unsigned* bar = b.bar; asm volatile("" : "+s"(bar));
        __builtin_amdgcn_s_waitcnt(0);
        unsigned nloc = b.st[0], nx = b.st[1];
        if (nloc == 0u) { xcd_barrier_complete(bar, b.x, nloc, nx); b.st[0] = nloc; b.st[1] = nx; }
        const unsigned old = xb_add(&bar[XB_XSUB(b.x)], 1u);
        const unsigned gen = old / nloc;
        if (old + 1u == (gen + 1u) * nloc) {
            __builtin_amdgcn_fence(__ATOMIC_RELEASE, "agent");
            asm volatile("s_waitcnt vmcnt(0)" ::: "memory");
            const unsigned og = xb_add(&bar[XB_TOP], 1u);
            const unsigned tg = og / nx;
            if (og + 1u == (tg + 1u) * nx) xb_add(&bar[XB_TOPGEN], 1u);
            else XB_SPIN(xb_ld(&bar[XB_TOPGEN]) == tg, bar);
            __builtin_amdgcn_fence(__ATOMIC_ACQUIRE, "agent");
            xb_add(&bar[XB_XGEN(b.x)], 1u);
            asm volatile("s_waitcnt vmcnt(0)" ::: "memory");
        } else {
            XB_SPIN(xb_ld(&bar[XB_XGEN(b.x)]) == gen, bar);
            __builtin_amdgcn_fence(__ATOMIC_ACQUIRE, "agent");
            asm volatile("s_waitcnt vmcnt(0)" ::: "memory");
        }
    }
    __syncthreads();
}

struct Frame {
    LAS unsigned char* lds;
    int tid, lane, wave, vcu, G, bid;
};
__device__ __forceinline__ float wave_sum(float v) {
#pragma unroll
    for (int o = 1; o < 64; o <<= 1) v += __shfl_xor(v, o);
    return v;
}

struct WJob { const float* W; const float* ksc; bf16* Bt; int Ks, Ns, Kd, Nd, kind, p0; float f8s; };
__device__ __forceinline__ int srccol(int kind, int p0, int R) {
    const int P8 = (R & ~31) + pg8::perm32(R & 31);
    switch (kind) {
    case 0: return R;
    case 1: return P8;
    case 2: {
        if (R < 256) return P8;
        if (R < 384) return P8;
        if (R < 416) return R;
        if (R < 424) return 1952 + (R - 416);
        if (R < 512) return -1;
        if (R < 2048) return 416 + (P8 - 512);
        if (R < 3072) { const int idx = R - 2048, head = idx >> 6, hp = idx & 63, s = hp >> 5, n = (hp >> 4) & 1, q4 = hp & 15; return 1960 + head * 64 + 32 * n + 16 * s + q4; }
        if (R < 3584) return 2984 + (P8 - 3072);
        return 3496 + (P8 - 3584); }
    case 3: { const int g = R >> 5; return (g % 3 == 2) ? R : P8; }
    case 4: { const int t = R >> 8, p = R & 255, bj = p >> 7, hp = p & 127; return bj * p0 + t * 128 + (hp & ~31) + pg8::perm32(hp & 31); }
    }
    return -1;
}
__device__ __forceinline__ void wconv_load(const WJob& J, int item, int lane, f32x4 (&v)[8]) {
    const int nkb = J.Kd / 64, rb = item / nkb, kb = item % nkb, k0 = 64 * kb + 8 * (lane >> 3), R = 32 * rb + 4 * (lane & 7);
    const int sc = srccol(J.kind, J.p0, R);
    const bool live = sc >= 0; const float* wp = J.W + (size_t)k0 * J.Ns + (live ? sc : 0);
#pragma unroll
    for (int i = 0; i < 8; ++i) v[i] = (live && k0 + i < J.Ks) ? *(const f32x4*)(wp + (size_t)i * J.Ns) : (f32x4){0.f, 0.f, 0.f, 0.f};
    if (J.ksc) {
#pragma unroll
        for (int i = 0; i < 8; ++i) if (k0 + i < J.Ks) v[i] = v[i] * J.ksc[k0 + i]; }
}
__device__ __forceinline__ void wconv_store(const WJob& J, int item, int lane, const f32x4 (&v)[8]) {
    const int nkb = J.Kd / 64, rb = item / nkb, kb = item % nkb, k0 = 64 * kb + 8 * (lane >> 3), R = 32 * rb + 4 * (lane & 7);
    if (J.f8s > 0.f) { const float f = J.f8s;
#pragma unroll
        for (int j = 0; j < 4; ++j) { v2u o; o.x = pg8::pk4_f8(v[0][j] * f, v[1][j] * f, v[2][j] * f, v[3][j] * f); o.y = pg8::pk4_f8(v[4][j] * f, v[5][j] * f, v[6][j] * f, v[7][j] * f);
            *(v2u*)((unsigned char*)J.Bt + (size_t)(R + j) * J.Kd + k0) = o; }
    } else {
#pragma unroll
        for (int j = 0; j < 4; ++j) { v4u o; o.x = pk2(v[0][j], v[1][j]); o.y = pk2(v[2][j], v[3][j]); o.z = pk2(v[4][j], v[5][j]); o.w = pk2(v[6][j], v[7][j]);
            *(v4u*)(J.Bt + (size_t)(R + j) * J.Kd + k0) = o; } }
}

__device__ __forceinline__ void rms_row_to_bf16(const float* xrow, const float* g, bf16* orow, int lane) {
    const f32x4* xr = (const f32x4*)xrow + lane; const f32x4* gr = (const f32x4*)g + lane;
    f32x4 v[4]; float s = 0.f;
#pragma unroll
    for (int j = 0; j < 4; ++j) { v[j] = xr[64 * j]; s += (v[j].x * v[j].x + v[j].y * v[j].y) + (v[j].z * v[j].z + v[j].w * v[j].w); }
    const float r = rsqrtf(wave_sum(s) * (1.f / DM) + RMS_EPS);
    unsigned long long* o8 = (unsigned long long*)orow + lane;
#pragma unroll
    for (int j = 0; j < 4; ++j) { const f32x4 gg = gr[64 * j]; o8[64 * j] = (unsigned long long)pk2(v[j].x * r * gg.x, v[j].y * r * gg.y) | ((unsigned long long)pk2(v[j].z * r * gg.z, v[j].w * r * gg.w) << 32); }
}

__device__ __forceinline__ void rms_row_to_f8(const float* xrow, const float* g, unsigned char* orow, float* rs, int lane) {
    const f32x4* xr = (const f32x4*)xrow + lane; const f32x4* gr = (const f32x4*)g + lane;
    f32x4 v[4]; float s = 0.f;
#pragma unroll
    for (int j = 0; j < 4; ++j) { v[j] = xr[64 * j]; s += (v[j].x * v[j].x + v[j].y * v[j].y) + (v[j].z * v[j].z + v[j].w * v[j].w); }
    const float r = rsqrtf(wave_sum(s) * (1.f / DM) + RMS_EPS); float mx = 0.f;
#pragma unroll
    for (int j = 0; j < 4; ++j) { const f32x4 gg = gr[64 * j]; v[j] = (f32x4){v[j].x * r * gg.x, v[j].y * r * gg.y, v[j].z * r * gg.z, v[j].w * r * gg.w};
        mx = fmaxf(fmaxf(mx, fmaxf(fabsf(v[j].x), fabsf(v[j].y))), fmaxf(fabsf(v[j].z), fabsf(v[j].w))); }
#pragma unroll
    for (int o = 1; o < 64; o <<= 1) mx = fmaxf(mx, __shfl_xor(mx, o));
    const float sc = mx > 0.f ? A8_ROWMAX / mx : 1.0f;
    unsigned* o4 = (unsigned*)orow + lane;
#pragma unroll
    for (int j = 0; j < 4; ++j) o4[64 * j] = pg8::pk4_f8(v[j].x * sc, v[j].y * sc, v[j].z * sc, v[j].w * sc);
    if (lane == 0) *rs = mx > 0.f ? mx * (1.0f / A8_ROWMAX) : 1.0f;
}

__device__ __forceinline__ void ld_row16(const bf16* row, int lane, f32x4 (&v)[4]) {
    const v2u* xr = (const v2u*)row + lane;
#pragma unroll
    for (int j = 0; j < 4; ++j) { const v2u w = xr[64 * j]; v[j] = (f32x4){bfl(w.x), bfh(w.x), bfl(w.y), bfh(w.y)}; }
}
__device__ __forceinline__ void rms_row16_to_bf16(const bf16* xrow, const float* g, bf16* orow, int lane) {
    const f32x4* gr = (const f32x4*)g + lane; f32x4 v[4]; ld_row16(xrow, lane, v); float s = 0.f;
#pragma unroll
    for (int j = 0; j < 4; ++j) s += (v[j].x * v[j].x + v[j].y * v[j].y) + (v[j].z * v[j].z + v[j].w * v[j].w);
    const float r = rsqrtf(wave_sum(s) * (1.f / DM) + RMS_EPS);
    unsigned long long* o8 = (unsigned long long*)orow + lane;
#pragma unroll
    for (int j = 0; j < 4; ++j) { const f32x4 gg = gr[64 * j]; o8[64 * j] = (unsigned long long)pk2(v[j].x * r * gg.x, v[j].y * r * gg.y) | ((unsigned long long)pk2(v[j].z * r * gg.z, v[j].w * r * gg.w) << 32); }
}

__device__ __forceinline__ unsigned pk4_i8(float a, float b, float c, float d) {
    const int ia = (int)rintf(a), ib = (int)rintf(b), ic = (int)rintf(c), id = (int)rintf(d);
    return (unsigned)(ia & 255) | ((unsigned)(ib & 255) << 8) | ((unsigned)(ic & 255) << 16) | ((unsigned)(id & 255) << 24);
}
__device__ __forceinline__ void rms_row16_to_i8(const bf16* xrow, const float* g, unsigned char* orow, float* rs, int lane) {
    const f32x4* gr = (const f32x4*)g + lane; f32x4 v[4]; ld_row16(xrow, lane, v); float s = 0.f;
#pragma unroll
    for (int j = 0; j < 4; ++j) s += (v[j].x * v[j].x + v[j].y * v[j].y) + (v[j].z * v[j].z + v[j].w * v[j].w);
    const float r = rsqrtf(wave_sum(s) * (1.f / DM) + RMS_EPS); float mx = 0.f;
#pragma unroll
    for (int j = 0; j < 4; ++j) { const f32x4 gg = gr[64 * j]; v[j] = (f32x4){v[j].x * r * gg.x, v[j].y * r * gg.y, v[j].z * r * gg.z, v[j].w * r * gg.w};
        mx = fmaxf(fmaxf(mx, fmaxf(fabsf(v[j].x), fabsf(v[j].y))), fmaxf(fabsf(v[j].z), fabsf(v[j].w))); }
#pragma unroll
    for (int o = 1; o < 64; o <<= 1) mx = fmaxf(mx, __shfl_xor(mx, o));
    const float sc = mx > 0.f ? 127.0f / mx : 0.f;
    unsigned* o4 = (unsigned*)orow + lane;
#pragma unroll
    for (int j = 0; j < 4; ++j) o4[64 * j] = pk4_i8(v[j].x * sc, v[j].y * sc, v[j].z * sc, v[j].w * sc);
    if (lane == 0) *rs = mx * (1.0f / 127.0f);
}
template <bool F32IN>
__device__ __forceinline__ void rms_rows_to_i8(const void* X, const float* g, unsigned char* O, float* RS, int m0, int step, int lane) {
    const f32x4* gr = (const f32x4*)g + lane; f32x4 gg[4];
#pragma unroll
    for (int j = 0; j < 4; ++j) gg[j] = gr[64 * j];
    v2u nw[4]; f32x4 nf[4];
    auto issue = [&](int m) __attribute__((always_inline)) {
        if (F32IN) { const f32x4* xr = (const f32x4*)((const float*)X + (size_t)m * DM) + lane;
#pragma unroll
            for (int j = 0; j < 4; ++j) nf[j] = xr[64 * j]; }
        else { const v2u* xr = (const v2u*)((const bf16*)X + (size_t)m * DM) + lane;
#pragma unroll
            for (int j = 0; j < 4; ++j) nw[j] = xr[64 * j]; } };
    if (m0 < MTOK) issue(m0);
    for (int m = m0; m < MTOK; m += step) { f32x4 v[4];
#pragma unroll
        for (int j = 0; j < 4; ++j) v[j] = F32IN ? nf[j] : (f32x4){bfl(nw[j].x), bfh(nw[j].x), bfl(nw[j].y), bfh(nw[j].y)};
        if (m + step < MTOK) issue(m + step);
        float s = 0.f;
#pragma unroll
        for (int j = 0; j < 4; ++j) s += (v[j].x * v[j].x + v[j].y * v[j].y) + (v[j].z * v[j].z + v[j].w * v[j].w);
        const float r = rsqrtf(wave_sum(s) * (1.f / DM) + RMS_EPS); float mx = 0.f;
#pragma unroll
        for (int j = 0; j < 4; ++j) { v[j] = (f32x4){v[j].x * r * gg[j].x, v[j].y * r * gg[j].y, v[j].z * r * gg[j].z, v[j].w * r * gg[j].w};
            mx = fmaxf(fmaxf(mx, fmaxf(fabsf(v[j].x), fabsf(v[j].y))), fmaxf(fabsf(v[j].z), fabsf(v[j].w))); }
#pragma unroll
        for (int o = 1; o < 64; o <<= 1) mx = fmaxf(mx, __shfl_xor(mx, o));
        const float sc = mx > 0.f ? 127.0f / mx : 0.f;
        unsigned* o4 = (unsigned*)(O + (size_t)m * DM) + lane;
#pragma unroll
        for (int j = 0; j < 4; ++j) o4[64 * j] = pk4_i8(v[j].x * sc, v[j].y * sc, v[j].z * sc, v[j].w * sc);
        if (lane == 0) RS[m] = mx * (1.0f / 127.0f); }
}
__device__ __forceinline__ void wconv_i8_item(const float* W, int Ks, int Ns, int kind, int p0, unsigned char* Bt, float* CS, int item, int lane) {
    const int R = 16 * item + 4 * (lane & 3), ko = lane >> 2; const int sc = srccol(kind, p0, R);
    const float* wp = W + (size_t)(8 * ko) * Ns + (sc >= 0 ? sc : 0);
    f32x4 mx = {0.f, 0.f, 0.f, 0.f};
    for (int kb = 0; kb < Ks / 128; ++kb) {
#pragma unroll
        for (int i = 0; i < 8; ++i) { const f32x4 v = *(const f32x4*)(wp + (size_t)(128 * kb + i) * Ns);
            mx[0] = fmaxf(mx[0], fabsf(v[0])); mx[1] = fmaxf(mx[1], fabsf(v[1])); mx[2] = fmaxf(mx[2], fabsf(v[2])); mx[3] = fmaxf(mx[3], fabsf(v[3])); } }
#pragma unroll
    for (int o = 4; o < 64; o <<= 1)
#pragma unroll
        for (int j = 0; j < 4; ++j) mx[j] = fmaxf(mx[j], __shfl_xor(mx[j], o));
    if (sc < 0) mx = (f32x4){0.f, 0.f, 0.f, 0.f};
    f32x4 qs;
#pragma unroll
    for (int j = 0; j < 4; ++j) qs[j] = mx[j] > 0.f ? 127.0f / mx[j] : 0.f;
    if (ko == 0) *(f32x4*)(CS + R) = mx * (1.0f / 127.0f);
    for (int kb = 0; kb < Ks / 128; ++kb) { f32x4 v[8];
#pragma unroll
        for (int i = 0; i < 8; ++i) v[i] = *(const f32x4*)(wp + (size_t)(128 * kb + i) * Ns);
#pragma unroll
        for (int j = 0; j < 4; ++j) { v2u o; o.x = pk4_i8(v[0][j] * qs[j], v[1][j] * qs[j], v[2][j] * qs[j], v[3][j] * qs[j]); o.y = pk4_i8(v[4][j] * qs[j], v[5][j] * qs[j], v[6][j] * qs[j], v[7][j] * qs[j]);
            *(v2u*)(Bt + (size_t)(R + j) * Ks + 128 * kb + 8 * ko) = o; } }
}

struct I8Job { const float* W; int Ns, kind, p0; unsigned char* Bt; float* CS; int item; };
__device__ __forceinline__ void wconv_i8_load(const I8Job& J, int wave, int lane, f32x4 (&v)[8]) {
    const int nq = lane & 3, ko = lane >> 2; const int sc = srccol(J.kind, J.p0, 16 * J.item + 4 * nq);
    const float* wp = J.W + (size_t)(128 * wave + 8 * ko) * J.Ns + (sc >= 0 ? sc : 0);
#pragma unroll
    for (int i = 0; i < 8; ++i) v[i] = *(const f32x4*)(wp + (size_t)i * J.Ns);
}
__device__ __forceinline__ void wconv_i8_finish(const I8Job& J, int wave, int lane, f32x4 (&v)[8], LAS float* mxs) {
    const int nq = lane & 3, ko = lane >> 2; const int R = 16 * J.item + 4 * nq; const int sc = srccol(J.kind, J.p0, R);
    f32x4 mx = {0.f, 0.f, 0.f, 0.f};
#pragma unroll
    for (int i = 0; i < 8; ++i) { if (sc < 0) v[i] = (f32x4){0.f, 0.f, 0.f, 0.f};
        mx[0] = fmaxf(mx[0], fabsf(v[i][0])); mx[1] = fmaxf(mx[1], fabsf(v[i][1])); mx[2] = fmaxf(mx[2], fabsf(v[i][2])); mx[3] = fmaxf(mx[3], fabsf(v[i][3])); }
#pragma unroll
    for (int o = 4; o < 64; o <<= 1)
#pragma unroll
        for (int j = 0; j < 4; ++j) mx[j] = fmaxf(mx[j], __shfl_xor(mx[j], o));
    if (ko == 0) *(LAS f32x4*)(mxs + wave * 16 + 4 * nq) = mx;
    LDS_WAIT(); __builtin_amdgcn_s_barrier();
#pragma unroll
    for (int w2 = 0; w2 < 8; ++w2) { const f32x4 o = *(const LAS f32x4*)(mxs + w2 * 16 + 4 * nq); mx[0] = fmaxf(mx[0], o[0]); mx[1] = fmaxf(mx[1], o[1]); mx[2] = fmaxf(mx[2], o[2]); mx[3] = fmaxf(mx[3], o[3]); }
    f32x4 qs;
#pragma unroll
    for (int j = 0; j < 4; ++j) qs[j] = mx[j] > 0.f ? 127.0f / mx[j] : 0.f;
    if (wave == 0 && ko == 0) *(f32x4*)(J.CS + R) = mx * (1.0f / 127.0f);
#pragma unroll
    for (int j = 0; j < 4; ++j) { v2u o; o.x = pk4_i8(v[0][j] * qs[j], v[1][j] * qs[j], v[2][j] * qs[j], v[3][j] * qs[j]); o.y = pk4_i8(v[4][j] * qs[j], v[5][j] * qs[j], v[6][j] * qs[j], v[7][j] * qs[j]);
        *(v2u*)(J.Bt + (size_t)(R + j) * 1024 + 128 * wave + 8 * ko) = o; }
}

__device__ __forceinline__ void rms_row_to_i8(const float* xrow, const float* g, unsigned char* orow, float* rs, int lane) {
    const f32x4* xr = (const f32x4*)xrow + lane; const f32x4* gr = (const f32x4*)g + lane; f32x4 v[4]; float s = 0.f;
#pragma unroll
    for (int j = 0; j < 4; ++j) { v[j] = xr[64 * j]; s += (v[j].x * v[j].x + v[j].y * v[j].y) + (v[j].z * v[j].z + v[j].w * v[j].w); }
    const float r = rsqrtf(wave_sum(s) * (1.f / DM) + RMS_EPS); float mx = 0.f;
#pragma unroll
    for (int j = 0; j < 4; ++j) { const f32x4 gg = gr[64 * j]; v[j] = (f32x4){v[j].x * r * gg.x, v[j].y * r * gg.y, v[j].z * r * gg.z, v[j].w * r * gg.w};
        mx = fmaxf(fmaxf(mx, fmaxf(fabsf(v[j].x), fabsf(v[j].y))), fmaxf(fabsf(v[j].z), fabsf(v[j].w))); }
#pragma unroll
    for (int o = 1; o < 64; o <<= 1) mx = fmaxf(mx, __shfl_xor(mx, o));
    const float sc = mx > 0.f ? 127.0f / mx : 0.f;
    unsigned* o4 = (unsigned*)orow + lane;
#pragma unroll
    for (int j = 0; j < 4; ++j) o4[64 * j] = pk4_i8(v[j].x * sc, v[j].y * sc, v[j].z * sc, v[j].w * sc);
    if (lane == 0) *rs = mx * (1.0f / 127.0f);
}
struct KArgs { const void* in[18]; float* out; unsigned char* ws; int ph_lo, ph_hi; };
#ifndef MK_N_LAUNCHES
#define MK_N_LAUNCHES 1
#endif
constexpr int NPHASE = 20;
constexpr int NJOBS = 10 + 2 + 16;

__device__ __forceinline__ void get_job(int j, const __attribute__((address_space(4))) KArgs* ap, WJob& J) {
    unsigned char* ws = ap->ws;
    if (j < 10) { const int l = j / 5, ty = j % 5; bf16* wl = (bf16*)(ws + OFF_WL) + (size_t)l * W_LAYER_E;
        if (ty == 0) { J.W = (const float*)ap->in[3] + (size_t)l * DM * IN_COLS; J.ksc = nullptr; J.Bt = wl; J.Ks = DM; J.Ns = IN_COLS; J.Kd = DM; J.Nd = IN_N; J.kind = 2; J.p0 = 0; J.f8s = 0.f; }
        else if (ty == 1) { J.W = (const float*)ap->in[6] + (size_t)l * 256 * QM_W; J.ksc = (const float*)ap->in[4] + l * 256; J.Bt = wl + W_IN_E; J.Ks = 256; J.Ns = QM_W; J.Kd = 256; J.Nd = QM_W; J.kind = 3; J.p0 = 0; J.f8s = 0.f; }
        else if (ty == 2) { J.W = (const float*)ap->in[7] + (size_t)l * 128 * KVM_W; J.ksc = (const float*)ap->in[5] + l * 128; J.Bt = wl + W_IN_E + (size_t)QM_W * 256; J.Ks = 128; J.Ns = KVM_W; J.Kd = 256; J.Nd = KVM_W; J.kind = 1; J.p0 = 0; J.f8s = 0.f; }
        else if (ty == 3) { J.W = (const float*)ap->in[9] + (size_t)l * Y3_W * DM; J.ksc = nullptr; J.Bt = wl + W_IN_E + W_UP_E; J.Ks = Y3_W; J.Ns = DM; J.Kd = Y3_W; J.Nd = DM; J.kind = 1; J.p0 = 0; J.f8s = 0.f; }
        else { J.W = (const float*)ap->in[10] + (size_t)l * DM * DM; J.ksc = nullptr; J.Bt = wl + W_IN_E + W_UP_E + W_BR_E; J.Ks = DM; J.Ns = DM; J.Kd = DM; J.Nd = DM; J.kind = 1; J.p0 = 0; J.f8s = 0.f; }
    } else if (j == 10) { J.W = (const float*)ap->in[12]; J.ksc = nullptr; J.Bt = (bf16*)(ws + OFF_WDGU); J.Ks = DM; J.Ns = 2 * DFF; J.Kd = DM; J.Nd = 2 * DFF; J.kind = 4; J.p0 = DFF; J.f8s = 0.f; }
    else if (j == 11) { J.W = (const float*)ap->in[13]; J.ksc = nullptr; J.Bt = (bf16*)(ws + OFF_WDDN); J.Ks = DFF; J.Ns = DM; J.Kd = DFF; J.Nd = DM; J.kind = 1; J.p0 = 0; J.f8s = DENSE_DOWN_F8 ? W8S_DN : 0.f; }
    else if (j < 20) { const int e = j - 12; J.W = (const float*)ap->in[15] + (size_t)e * DM * 2 * EFF; J.ksc = nullptr; J.Bt = (bf16*)(ws + OFF_WEGU + (size_t)e * 2 * EFF * DM); J.Ks = DM; J.Ns = 2 * EFF; J.Kd = DM; J.Nd = 2 * EFF; J.kind = 4; J.p0 = EFF; J.f8s = W8S_GU; }
    else { const int e = j - 20; J.W = (const float*)ap->in[16] + (size_t)e * EFF * DM; J.ksc = nullptr; J.Bt = (bf16*)(ws + OFF_WEDN + (size_t)e * DM * EFF); J.Ks = EFF; J.Ns = DM; J.Kd = EFF; J.Nd = DM; J.kind = 1; J.p0 = 0; J.f8s = W8S_DN; }
}
__device__ __forceinline__ int job_items(int j) {
    if (j < 10) { const int ty = j % 5; return ty == 0 ? 0   : ty == 1 ? (QM_W / 32) * 4 : ty == 2 ? (KVM_W / 32) * 4 : ty == 3 ? (DM / 32) * (Y3_W / 64) : (DM / 32) * (DM / 64); }
    if (j == 10) return 0;
    if (j == 11) return (DM / 32) * (DFF / 64);
    if (j < 20) return 0;
    return (DM / 32) * (EFF / 64);
}

#define SSQ ((float*)(ws + OFF_SSQ))
#define LOGF ((float*)(ws + OFF_LOGF))
#define CUM ((float*)(ws + OFF_CUM))
#define KMEAN ((float*)(ws + OFF_KMEAN))
#define KNM ((float*)(ws + OFF_KNM))
#define R64C ((float*)(ws + OFF_R64C))
#define R64S ((float*)(ws + OFF_R64S))
#define R32C ((float*)(ws + OFF_R32C))
#define R32S ((float*)(ws + OFF_R32S))
#define TOKI ((int*)(ws + OFF_TOKI))
#define TOKW ((float*)(ws + OFF_TOKW))
#define TOKR ((int*)(ws + OFF_TOKR))
#define CNT ((int*)(ws + OFF_CNT))
#define MTAB ((int*)(ws + OFF_MTAB))
#define XN8 ((unsigned char*)(ws + OFF_XN8))
#define RSX ((float*)(ws + OFF_RSX))
#define RSG ((float*)(ws + OFF_RSG))
#define XS16 ((bf16*)(ws + OFF_XS))
#define XNQ ((unsigned char*)(ws + OFF_XN))
#define CSC ((float*)(ws + OFF_CSC))
#define CSIN ((float*)(ws + OFF_CSIN))
#define RSIN ((float*)(ws + OFF_RSIN))
#define XN ((bf16*)(ws + OFF_XN))
#define QM ((bf16*)(ws + OFF_QM))
#define LAT ((bf16*)(ws + OFF_LAT))
#define KR ((bf16*)(ws + OFF_KR))
#define FQ ((bf16*)(ws + OFF_FQ))
#define FK ((bf16*)(ws + OFF_FK))
#define FV ((bf16*)(ws + OFF_FV))
#define MQ ((bf16*)(ws + OFF_MQ))
#define MK ((bf16*)(ws + OFF_MK))
#define MV ((bf16*)(ws + OFF_MV))
#define GT ((bf16*)(ws + OFF_GT))
#define KVM ((bf16*)(ws + OFF_KVM))
#define MERGED ((bf16*)(ws + OFF_MERGED))
#define Y3 ((bf16*)(ws + OFF_Y3))
#define ACTD ((bf16*)(ws + OFF_ACTD))
#define ACTM ((unsigned char*)(ws + OFF_ACTM))
#define XG ((unsigned char*)(ws + OFF_XG))
#define YE ((bf16*)(ws + OFF_YE))
__global__ void __launch_bounds__(NWAVES * 64, 2) mega_fwd(KArgs args) {
    extern __shared__ __attribute__((aligned(16))) unsigned char lds[];
    Frame F;
    F.lds = (LAS unsigned char*)lds;
    volatile LAS unsigned* MISC = (volatile LAS unsigned*)(F.lds + MISC_OFF);
    F.tid = threadIdx.x; F.lane = F.tid & 63; F.wave = __builtin_amdgcn_readfirstlane(F.tid >> 6);
    F.G = gridDim.x; F.bid = blockIdx.x; { const int bx = blockIdx.x; F.vcu = (F.G % 8 == 0) ? (bx % 8) * (F.G / 8) + bx / 8 : bx; }
    unsigned char* ws0 = args.ws;
    gu32* ctl = (gu32*)(ws0 + WS_CTL);
    for (int u = F.tid; u < (LDS_BYTES - LDSCTL_OFF) / 4; u += NWAVES * 64) ((LAS unsigned*)(F.lds + LDSCTL_OFF))[u] = 0u;
    __syncthreads();
    XcdBarrier bar = xcd_barrier_post((unsigned*)(ctl + CW_BAR), MISC + 8);
    const int lo = args.ph_lo, hi = args.ph_hi;
#ifndef PH_MASK
#define PH_MASK 0xFFFFFFu
#endif
#ifndef REP_MASK
#define REP_MASK 0u
#endif
#ifndef REP_ATT
#define REP_ATT 0u
#endif
#define REPEAT(k) for (int rep_ = 0; rep_ < ((((unsigned)REP_MASK >> (k)) & 1u) ? 2 : 1); ++rep_)
#define IN(k) (lo <= (k) && (k) < hi && ((PH_MASK >> (k)) & 1u))
#define SEAM(k) do { if (IN(k) && IN((k) + 1)) xcd_barrier(bar, F.wave); } while (0)
#define INL(j) (lo <= pb + (j) && pb + (j) < hi && ((PH_MASK >> (1 + (j))) & 1u))
#define SEAML(j) do { if (lo <= pb + (j) && pb + (j) + 1 < hi) xcd_barrier(bar, F.wave); } while (0)
#define PHB const int wave = F.wave; const int lane = pg8::lane_id_opaque(); const int tid = wave * 64 + lane; const int gw = F.vcu * NWAVES + wave; (void)lane; (void)gw; (void)tid; \
    const __attribute__((address_space(4))) KArgs* ka = (const __attribute__((address_space(4))) KArgs*)__builtin_amdgcn_kernarg_segment_ptr(); asm volatile("" : "+s"(ka)); unsigned char* ws = ka->ws; float* xs = ka->out; const float* x_in = (const float*)ka->in[0]; \
    int G = F.G, bid = F.bid, NGW; asm volatile("" : "+s"(G), "+s"(bid)); NGW = G * NWAVES; (void)xs; (void)x_in; (void)NGW; (void)bid
    if (IN(0)) { asm volatile("; PHASE_MARK 0" ::: "memory"); PHB;
        REPEAT(0) {
        {
            WJob Jc, Jn; int itc = 0, itn = 0; f32x4 vc[8], vn[8];
            auto decode = [&](int git, WJob& J, int& it) -> bool { int jb = 0;
                for (int j = 0; j < NJOBS; ++j) { const int ni = job_items(j); if (git < jb + ni) { get_job(j, ka, J); it = git - jb; return true; } jb += ni; }
                return false; };
            int git = gw; bool have = decode(git, Jc, itc);
            if (have) wconv_load(Jc, itc, lane, vc);
            while (have) {
                const bool hn = decode(git + NGW, Jn, itn);
                if (hn) wconv_load(Jn, itn, lane, vn);
                wconv_store(Jc, itc, lane, vc);
                Jc = Jn; itc = itn; have = hn; git += NGW;
#pragma unroll
                for (int i = 0; i < 8; ++i) vc[i] = vn[i];
            } }
        { LAS float* mxs = (LAS float*)(F.lds + RING_OFF); int par = 0;
          constexpr int NI_IN = 2 * (IN_N / 16), NI_DG = 2 * DFF / 16, NI_EG = 2 * EFF / 16, NI_ALL = NI_IN + NI_DG + 8 * NI_EG;
          auto getj = [&](int it, I8Job& J) __attribute__((always_inline)) {
              if (it < NI_IN) { const int l2 = it / (IN_N / 16); J.W = (const float*)ka->in[3] + (size_t)l2 * DM * IN_COLS; J.Ns = IN_COLS; J.kind = 2; J.p0 = 0; J.Bt = (unsigned char*)((bf16*)(ws + OFF_WL) + (size_t)l2 * W_LAYER_E); J.CS = CSIN + l2 * IN_N; J.item = it - l2 * (IN_N / 16); }
              else if (it < NI_IN + NI_DG) { J.W = (const float*)ka->in[12]; J.Ns = 2 * DFF; J.kind = 4; J.p0 = DFF; J.Bt = (unsigned char*)(ws + OFF_WDGU); J.CS = CSC; J.item = it - NI_IN; }
              else { const int i2 = it - NI_IN - NI_DG, e = i2 / NI_EG; J.W = (const float*)ka->in[15] + (size_t)e * DM * 2 * EFF; J.Ns = 2 * EFF; J.kind = 4; J.p0 = EFF; J.Bt = (unsigned char*)(ws + OFF_WEGU + (size_t)e * 2 * EFF * DM); J.CS = (float*)(ws + OFF_CSE) + e * 2 * EFF; J.item = i2 - e * NI_EG; } };
          I8Job Jc, Jn; f32x4 vc[8], vn[8]; int it = bid; bool have = it < NI_ALL;
          if (have) { getj(it, Jc); wconv_i8_load(Jc, wave, lane, vc); }
          while (have) { const bool hn = it + G < NI_ALL;
              if (hn) { getj(it + G, Jn); wconv_i8_load(Jn, wave, lane, vn); }
              wconv_i8_finish(Jc, wave, lane, vc, mxs + par * 128);
              Jc = Jn; have = hn; it += G; par ^= 1;
#pragma unroll
              for (int i = 0; i < 8; ++i) vc[i] = vn[i]; }
          LDS_WAIT(); __syncthreads(); }
        const int* pos = (const int*)ka->in[1];
        for (int i = bid * (NWAVES * 64) + tid; i < MTOK * 32; i += G * NWAVES * 64) { const int tok = i >> 5, f = i & 31;
            const float p = (float)pos[tok];
            { const float inv = expf(-9.210340371976184f * (float)f * (2.0f / 64.0f)); const float ang = p * inv; const float n = rintf(ang * 0.15915494309189535f);
              float r = fmaf(-n, 6.28318548202514648f, ang); r = fmaf(-n, -1.7484555e-7f, r); R64C[i] = __cosf(r); R64S[i] = __sinf(r); }
            if (f < 16) { const float inv = expf(-9.210340371976184f * (float)f * (2.0f / 32.0f)); const float ang = p * inv; const float n = rintf(ang * 0.15915494309189535f);
              float r = fmaf(-n, 6.28318548202514648f, ang); r = fmaf(-n, -1.7484555e-7f, r); R32C[tok * 16 + f] = __cosf(r); R32S[tok * 16 + f] = __sinf(r); } }
        rms_rows_to_i8<true>(x_in, (const float*)ka->in[2], XNQ, RSIN, gw, NGW, lane);
        }
    }
    SEAM(0);

    {
        constexpr int l = 0;
        const int pb = 1 + 9 * l;
        if (INL(0)) { asm volatile("; PHASE_MARK L0" ::: "memory"); PHB;
            pg8::Gemm g{(const bf16*)XNQ, (const bf16*)(ws + OFF_WL) + (size_t)l * W_LAYER_E, DM / 2, DM / 2}; pg8::GridOrder S; S.init(MTOK / 256, IN_N / 256, G, bid);
            pg8::EpiIn E{ws, (const float*)ka->in[8] + l * 8, CSIN + l * IN_N};
            REPEAT(pb + 0) pg8::gemm_phase<pg8::EpiIn, pg8::GridOrder, false, true, true, true>(F.lds + RING_OFF, g, S, E, wave);
#ifdef PROBE_NULL_EPI_IN
            { pg8::EpiNull EN; pg8::gemm_phase<pg8::EpiNull, pg8::GridOrder, false, true, true, true>(F.lds + RING_OFF, g, S, EN, wave); }
#endif
        }
        SEAML(0);
        if (INL(1)) { asm volatile("; PHASE_MARK L1" ::: "memory"); PHB;
            for (int it = F.vcu; it < 64; it += G) {
                const int b = it >> 3, h = it & 7; LAS float* part = (LAS float*)(F.lds + RING_OFF);
                float v[8]; float run = 0.f;
#pragma unroll
                for (int k = 0; k < 8; ++k) { run += LOGF[((size_t)b * SEQ + tid * 8 + k) * 8 + h]; v[k] = run; }
                float inc = run;
#pragma unroll
                for (int o = 1; o < 64; o <<= 1) { const float t = __shfl_up(inc, o); if (lane >= o) inc += t; }
                if (lane == 63) part[wave] = inc;
                LDS_WAIT(); __syncthreads();
                float base = inc - run;
                for (int w = 0; w < wave; ++w) base += part[w];
                float* dst = CUM + ((size_t)b * 8 + h) * SEQ + tid * 8;
                *(f32x4*)dst = (f32x4){v[0] + base, v[1] + base, v[2] + base, v[3] + base}; *(f32x4*)(dst + 4) = (f32x4){v[4] + base, v[5] + base, v[6] + base, v[7] + base};
                __syncthreads();
                float kn = 0.f;
                for (int k = 0; k < 8; ++k) { const v4u* kp = (const v4u*)(FK + ((size_t)b * SEQ + tid * 8 + k) * BR_W + h * 64); float sq = 0.f;
#pragma unroll
                    for (int c = 0; c < 8; ++c) { const v4u w = kp[c];
#pragma unroll
                        for (int e = 0; e < 4; ++e) { const float lo = bfl(w[e]), hi2 = bfh(w[e]); sq += lo * lo + hi2 * hi2; } }
                    kn = fmaxf(kn, sq); }
#pragma unroll
                for (int o = 1; o < 64; o <<= 1) kn = fmaxf(kn, __shfl_xor(kn, o));
                if (lane == 0) part[8 + wave] = kn;
                LDS_WAIT(); __syncthreads();
                if (tid == 0) { float m = 0.f; for (int w = 0; w < 8; ++w) m = fmaxf(m, part[8 + w]); KNM[it] = sqrtf(m); }
                __syncthreads();
            }
            for (int it = F.vcu - 64; it < 128; it += G) { if (it < 0) continue;
                const bf16* src = MK + (size_t)it * 256 * BR_W + tid; float s = 0.f;
#pragma unroll 8
                for (int r = 0; r < 256; ++r) s += __uint_as_float((unsigned)src[(size_t)r * BR_W] << 16);
                KMEAN[(size_t)it * 512 + tid] = s * (1.0f / 256.0f); }
            VM_WAIT(); __syncthreads();
            pg8::Gemm g{LAT, ((const bf16*)(ws + OFF_WL) + (size_t)l * W_LAYER_E) + W_IN_E, LAT_W, 256}; pg8::MidOrder S; S.init(MTOK / 256, UP_N / 256, G, bid);
            pg8::EpiUp E{ws};
            REPEAT(pb + 1) pg8::gemm_phase<pg8::EpiUp, pg8::MidOrder>(F.lds + RING_OFF, g, S, E, wave);
        }
        SEAML(1);
        if (INL(2)) { asm volatile("; PHASE_MARK L2" ::: "memory"); PHB;
            att::Args A0{(const att::bf16*)QM, (const att::bf16*)KVM, (const att::bf16*)KR, (const att::bf16*)KVM + 64, (att::bf16*)Y3, nullptr, nullptr, QM_W, KVM_W, KVM_W, Y3_W, 96, 128};
            att::Args A1{(const att::bf16*)FQ, (const att::bf16*)FK, nullptr, (const att::bf16*)FV, (att::bf16*)Y3 + 512, CUM, KNM, BR_W, BR_W, BR_W, Y3_W, 64, 64};
            att::Args A2{(const att::bf16*)MQ, (const att::bf16*)MK, nullptr, (const att::bf16*)MV, (att::bf16*)Y3 + 1024, nullptr, KMEAN, BR_W, BR_W, BR_W, Y3_W, 64, 64};
            char* shm = (char*)lds + RING_OFF;
            for (int rep_ = 0; rep_ < (((REP_ATT >> 0) & 1u) ? 2 : 1); ++rep_)
            for (int v = F.vcu; v < 512; v += G) { const int bh = v >> 3, s = v & 7;
                att::attn_unit<0>(bh >> 3, bh & 7, 15 - s, A0, shm, wave); att::attn_unit<0>(bh >> 3, bh & 7, s, A0, shm, wave); }
            for (int rep_ = 0; rep_ < (((REP_ATT >> 1) & 1u) ? 2 : 1); ++rep_)
            for (int v = F.vcu; v < 512; v += G) { const int bh = v >> 3, s = v & 7;
                att::attn_unit<1>(bh >> 3, bh & 7, 15 - s, A1, shm, wave); att::attn_unit<1>(bh >> 3, bh & 7, s, A1, shm, wave); }
            for (int rep_ = 0; rep_ < (((REP_ATT >> 2) & 1u) ? 2 : 1); ++rep_)
            for (int v = F.vcu; v < 512; v += G) { const int bh = v >> 3, s = v & 7;
                att::attn_unit<2>(bh >> 3, bh & 7, 15 - s, A2, shm, wave); att::attn_unit<2>(bh >> 3, bh & 7, s, A2, shm, wave); }
        }
        SEAML(2);
        if (INL(3)) { asm volatile("; PHASE_MARK L3" ::: "memory"); PHB;
            pg8::Gemm g{Y3, ((const bf16*)(ws + OFF_WL) + (size_t)l * W_LAYER_E) + W_IN_E + W_UP_E, Y3_W, Y3_W}; pg8::GridOrder S; S.init(MTOK / 256, DM / 256, G, bid);
            pg8::EpiMerge E{GT, MERGED};
            REPEAT(pb + 3) pg8::gemm_phase<pg8::EpiMerge, pg8::GridOrder>(F.lds + RING_OFF, g, S, E, wave);
        }
        SEAML(3);
        if (INL(4)) { asm volatile("; PHASE_MARK L4" ::: "memory"); PHB;
            pg8::Gemm g{MERGED, ((const bf16*)(ws + OFF_WL) + (size_t)l * W_LAYER_E) + W_IN_E + W_UP_E + W_BR_E, DM, DM}; pg8::GridOrder S; S.init(MTOK / 256, DM / 256, G, bid);
            pg8::EpiResidB<l == 0> E{l == 0 ? (const void*)x_in : (const void*)XS16, XS16, 1.0f};
            REPEAT(l == 0 ? pb + 4 : 31) pg8::gemm_phase<pg8::EpiResidB<l == 0>, pg8::GridOrder>(F.lds + RING_OFF, g, S, E, wave);
        }
        SEAML(4);
        if (l == 0) {
            if (IN(6)) { asm volatile("; PHASE_MARK 6" ::: "memory"); PHB; const float* gf = (const float*)ka->in[11]; REPEAT(6) rms_rows_to_i8<false>(XS16, gf, XNQ, RSX, gw, NGW, lane); }
            SEAM(6);
            if (IN(7)) { asm volatile("; PHASE_MARK 7" ::: "memory"); PHB;
                pg8::Gemm g{(const bf16*)XNQ, (const bf16*)(ws + OFF_WDGU), DM / 2, DM / 2}; pg8::GridOrder S; S.init(MTOK / 256, 2 * DFF / 256, G, bid);
#if DENSE_DOWN_F8
                pg8::EpiSwigluI8 E{(unsigned char*)ACTD, DFF, RSX, CSC};
                REPEAT(7) pg8::gemm_phase<pg8::EpiSwigluI8, pg8::GridOrder, false, true, true, true>(F.lds + RING_OFF, g, S, E, wave);
#else
                pg8::EpiSwigluI8B E{ACTD, DFF, RSX, CSC};
                REPEAT(7) pg8::gemm_phase<pg8::EpiSwigluI8B, pg8::GridOrder, false, true, true, true>(F.lds + RING_OFF, g, S, E, wave);
#endif
            }
            SEAM(7);
            if (IN(8)) { asm volatile("; PHASE_MARK 8" ::: "memory"); PHB;
#if DENSE_DOWN_F8
                pg8::Gemm g{(const bf16*)ACTD, (const bf16*)(ws + OFF_WDDN), DFF / 2, DFF / 2}; pg8::GridOrder S; S.init(MTOK / 256, DM / 256, G, bid);
                pg8::EpiResidB<false> E{(const void*)XS16, XS16, 1.0f / (A8S_ACT * W8S_DN)};
                pg8::gemm_phase<pg8::EpiResidB<false>, pg8::GridOrder, true, true, true, false, false, false>(F.lds + RING_OFF, g, S, E, wave);
#else
                pg8::Gemm g{ACTD, (const bf16*)(ws + OFF_WDDN), DFF, DFF}; pg8::GridOrder S; S.init(MTOK / 256, DM / 256, G, bid);
                pg8::EpiResidB<false> E{(const void*)XS16, XS16, 1.0f};
                pg8::gemm_phase<pg8::EpiResidB<false>, pg8::GridOrder>(F.lds + RING_OFF, g, S, E, wave);
#endif
            }
            SEAM(8);
            if (IN(9)) { asm volatile("; PHASE_MARK 9" ::: "memory"); PHB; const float* gm = (const float*)ka->in[2] + DM; REPEAT(9) rms_rows_to_i8<false>(XS16, gm, XNQ, RSIN, gw, NGW, lane); }
            SEAM(9);
        } else {
            if (IN(15)) { asm volatile("; PHASE_MARK 15" ::: "memory"); PHB;
                const float* gf = (const float*)ka->in[11] + DM;
                LAS int* cnt = (LAS int*)(F.lds + RING_OFF + 32768);
                const float* wr = (const float*)ka->in[14];
                f32x4 w0[4][4], w1[4][4], gg[4];
#pragma unroll
                for (int j = 0; j < 4; ++j) { gg[j] = ((const f32x4*)gf + lane)[64 * j];
#pragma unroll
                    for (int q = 0; q < 4; ++q) { const f32x4* wp = (const f32x4*)(wr + (size_t)(256 * j + 4 * lane + q) * 8); w0[j][q] = wp[0]; w1[j][q] = wp[1]; } }
                const bool b0_ = (lane & 1) != 0, b1_ = (lane & 2) != 0, b2_ = (lane & 4) != 0;
                REPEAT(15) for (int c = bid; c < 256; c += G) {
                    if (tid < 64) cnt[tid] = 0;
                    LDS_WAIT(); __syncthreads();
                    const int t0 = c * 128 + wave * 16;
                    auto row_do = [&](int t, f32x4 (&v)[4]) __attribute__((always_inline)) {
                        float s = 0.f;
#pragma unroll
                        for (int j = 0; j < 4; ++j) s += (v[j].x * v[j].x + v[j].y * v[j].y) + (v[j].z * v[j].z + v[j].w * v[j].w);
                        const float r = rsqrtf(wave_sum(s) * (1.f / DM) + RMS_EPS);
                        float lg[8];
#pragma unroll
                        for (int e = 0; e < 8; ++e) lg[e] = 0.f;
                        float mx = 0.f;
#pragma unroll
                        for (int j = 0; j < 4; ++j) { const f32x4 hv = {v[j].x * r * gg[j].x, v[j].y * r * gg[j].y, v[j].z * r * gg[j].z, v[j].w * r * gg[j].w}; v[j] = hv;
                            mx = fmaxf(fmaxf(mx, fmaxf(fabsf(hv.x), fabsf(hv.y))), fmaxf(fabsf(hv.z), fabsf(hv.w)));
#pragma unroll
                            for (int q = 0; q < 4; ++q) { const f32x4 a0 = w0[j][q], a1 = w1[j][q]; const float hh = hv[q];
                                lg[0] += hh * a0.x; lg[1] += hh * a0.y; lg[2] += hh * a0.z; lg[3] += hh * a0.w; lg[4] += hh * a1.x; lg[5] += hh * a1.y; lg[6] += hh * a1.z; lg[7] += hh * a1.w; } }
#pragma unroll
                        for (int o = 1; o < 64; o <<= 1) mx = fmaxf(mx, __shfl_xor(mx, o));
                        { const float sc = mx > 0.f ? 127.0f / mx : 0.f; unsigned* o4 = (unsigned*)(XN8 + (size_t)t * DM) + lane;
#pragma unroll
                          for (int j = 0; j < 4; ++j) o4[64 * j] = pk4_i8(v[j].x * sc, v[j].y * sc, v[j].z * sc, v[j].w * sc);
                          if (lane == 0) RSX[t] = mx * (1.0f / 127.0f); }
                        float y4[4], y2[2], y1;
#pragma unroll
                        for (int k = 0; k < 4; ++k) { const float keep = b0_ ? lg[4 + k] : lg[k], send = b0_ ? lg[k] : lg[4 + k]; y4[k] = keep + __shfl_xor(send, 1); }
#pragma unroll
                        for (int k = 0; k < 2; ++k) { const float keep = b1_ ? y4[2 + k] : y4[k], send = b1_ ? y4[k] : y4[2 + k]; y2[k] = keep + __shfl_xor(send, 2); }
                        { const float keep = b2_ ? y2[1] : y2[0], send = b2_ ? y2[0] : y2[1]; y1 = keep + __shfl_xor(send, 4); }
                        y1 += __shfl_xor(y1, 8); y1 += __shfl_xor(y1, 16); y1 += __shfl_xor(y1, 32);
#pragma unroll
                        for (int e = 0; e < 8; ++e) lg[e] = __uint_as_float(__builtin_amdgcn_readlane(__float_as_uint(y1), ((e >> 2) & 1) | (((e >> 1) & 1) << 1) | ((e & 1) << 2)));
                        int e0 = 0; float b0 = lg[0];
#pragma unroll
                        for (int e = 1; e < 8; ++e) if (lg[e] > b0) { b0 = lg[e]; e0 = e; }
                        int e1 = 0; float b1 = -INFINITY;
#pragma unroll
                        for (int e = 0; e < 8; ++e) if (e != e0 && lg[e] > b1) { b1 = lg[e]; e1 = e; }
                        if (lane == 0) { const float w1v = 1.0f / (1.0f + __expf(b0 - b1)); const float w0v = 1.0f - w1v;
                            volatile LAS int* cw = cnt + wave * 8; const int i0 = cw[e0]; cw[e0] = i0 + 1; const int i1 = cw[e1]; cw[e1] = i1 + 1;
                            *(i32x4*)(TOKI + (size_t)t * 4) = (i32x4){e0, e1, i0, i1}; *(f32x2*)(TOKW + (size_t)t * 2) = (f32x2){w0v, w1v}; }
                    };
                    f32x4 na[4], nb[4]; ld_row16(XS16 + (size_t)t0 * DM, lane, na); ld_row16(XS16 + (size_t)(t0 + 1) * DM, lane, nb);
                    for (int i = 0; i < 16; i += 2) { const int t = t0 + i;
                        f32x4 va[4], vb[4];
#pragma unroll
                        for (int j = 0; j < 4; ++j) { va[j] = na[j]; vb[j] = nb[j]; }
                        if (i + 2 < 16) { ld_row16(XS16 + (size_t)(t + 2) * DM, lane, na); ld_row16(XS16 + (size_t)(t + 3) * DM, lane, nb); }
                        row_do(t, va); row_do(t + 1, vb);
                    }
                    LDS_WAIT(); __syncthreads();
                    if (tid < 8) { int* wp = (int*)(ws + OFF_WPRE) + c * 64 + tid; int run = 0;
#pragma unroll
                        for (int w = 0; w < 8; ++w) { wp[w * 8] = run; run += cnt[w * 8 + tid]; }
                        CNT[c * 8 + tid] = run; }
                    __syncthreads();
                }
            }
            SEAM(15);
            if (IN(16)) { asm volatile("; PHASE_MARK 16" ::: "memory"); PHB;
                LAS int* PRE = (LAS int*)(F.lds + RING_OFF);
                LAS int* TOT = PRE + 2048;
                { const int e = wave; int cv[4]; int run = 0;
#pragma unroll
                    for (int k = 0; k < 4; ++k) { cv[k] = CNT[(lane * 4 + k) * 8 + e]; run += cv[k]; }
                    int inc = run;
#pragma unroll
                    for (int o = 1; o < 64; o <<= 1) { const int t = __shfl_up(inc, o); if (lane >= o) inc += t; }
                    int ex = inc - run;
#pragma unroll
                    for (int k = 0; k < 4; ++k) { PRE[e * 256 + lane * 4 + k] = ex; ex += cv[k]; }
                    if (lane == 63) TOT[e] = inc; }
                LDS_WAIT(); __syncthreads();
                if (tid == 0) { int st = 0;
                    for (int e = 0; e < 8; ++e) { TOT[8 + e] = st; const int nb = (TOT[e] + 255) >> 8;
                        if (bid == 0) for (int k = 0; k < nb; ++k) MTAB[(st >> 8) + k] = e;
                        st += nb << 8; }
                    if (bid == 0) MTAB[264] = st >> 8; }
                LDS_WAIT(); __syncthreads();
                REPEAT(16) for (int c = bid; c < 256; c += G)
                    for (int i = 0; i < 16; ++i) { const int t = c * 128 + wave * 16 + i; const i32x4 ti = *(const i32x4*)(TOKI + (size_t)t * 4);
                        const int* wpre = (const int*)(ws + OFF_WPRE) + (c * 8 + wave) * 8;
                        const int r0 = TOT[8 + ti.x] + PRE[ti.x * 256 + c] + wpre[ti.x] + ti.z, r1 = TOT[8 + ti.y] + PRE[ti.y * 256 + c] + wpre[ti.y] + ti.w;
                        if (lane == 0) { *(i32x2*)(TOKR + (size_t)t * 2) = (i32x2){r0, r1}; const float rsv = RSX[t]; RSG[r0] = rsv; RSG[r1] = rsv; }
                        const v4u a = *((const v4u*)(XN8 + (size_t)t * DM) + lane);
                        *((v4u*)(XG + (size_t)r0 * DM) + lane) = a; *((v4u*)(XG + (size_t)r1 * DM) + lane) = a; }
            }
            SEAM(16);
            if (IN(17)) { asm volatile("; PHASE_MARK 17" ::: "memory"); PHB;
                const __attribute__((address_space(4))) int* mtab = (const __attribute__((address_space(4))) int*)(ws + OFF_MTAB); const int nblk = mtab[264];
                pg8::Gemm g{(const bf16*)XG, (const bf16*)(ws + OFF_WEGU), DM / 2, DM / 2}; pg8::MoeOrder S; S.init(nblk, 2 * EFF / 256, G, bid); S.tab = mtab;
                pg8::EpiSwigluI8 E{ACTM, EFF, RSG, (const float*)(ws + OFF_CSE)};
                REPEAT(17) pg8::gemm_phase<pg8::EpiSwigluI8, pg8::MoeOrder, false, true, true, true>(F.lds + RING_OFF, g, S, E, wave);
#ifdef PROBE_NULL_EPI
                { pg8::EpiNull EN; pg8::gemm_phase<pg8::EpiNull, pg8::MoeOrder, true>(F.lds + RING_OFF, g, S, EN, wave); }
#endif
            }
            SEAM(17);
            if (IN(18)) { asm volatile("; PHASE_MARK 18" ::: "memory"); PHB;
                const __attribute__((address_space(4))) int* mtab = (const __attribute__((address_space(4))) int*)(ws + OFF_MTAB); const int nblk = mtab[264];
                pg8::Gemm g{(const bf16*)ACTM, (const bf16*)(ws + OFF_WEDN), EFF / 2, EFF / 2}; pg8::MoeDownOrder S; S.init(nblk, G, bid); S.tab = mtab;
                pg8::EpiBf8K E{YE, (float*)(ws + OFF_XG), 1.0f / (A8S_ACT * W8S_DN)};
                REPEAT(18) pg8::gemm_phase<pg8::EpiBf8K, pg8::MoeDownOrder, true, true, true, false, true, false>(F.lds + RING_OFF, g, S, E, wave);
            }
            SEAM(18);
            if (IN(19)) { asm volatile("; PHASE_MARK 19" ::: "memory"); PHB;
                {
                    const __attribute__((address_space(4))) int* mtab = (const __attribute__((address_space(4))) int*)(ws + OFF_MTAB); const int ntail = (mtab[264] - 256) * 256;
                    const float* PART = (const float*)(ws + OFF_XG);
                    for (int r = gw; r < ntail; r += NGW) { const float* pp = PART + (size_t)(((r >> 8) * 7) * 256 + (r & 255)) * DM; f32x4 pv[7][4];
#pragma unroll
                        for (int k = 0; k < 7; ++k)
#pragma unroll
                            for (int j = 0; j < 4; ++j) pv[k][j] = ((const f32x4*)(pp + (size_t)k * 256 * DM) + lane)[64 * j];
#pragma unroll
                        for (int j = 0; j < 4; ++j) { f32x4 a = pv[0][j];
#pragma unroll
                            for (int k = 1; k < 7; ++k) a += pv[k][j];
                            ((v2u*)(YE + (size_t)(65536 + r) * DM) + lane)[64 * j] = (v2u){pg8::cvt_pk_bf16(a.x, a.y), pg8::cvt_pk_bf16(a.z, a.w)}; } }
                    xcd_barrier(bar, F.wave); }
                const f32x4* gr = (const f32x4*)ka->in[17] + lane;
                {   f32x4 gg[4];
#pragma unroll
                    for (int j = 0; j < 4; ++j) gg[j] = gr[64 * j];
                    v2u cx[4], c0[4], c1[4], nx[4], n0[4], n1[4]; i32x2 rrn = {0, 0}; f32x2 wwc = {0.f, 0.f}, wwn = {0.f, 0.f};
                    auto rows = [&](int t, i32x2 rr, v2u (&ax)[4], v2u (&a0)[4], v2u (&a1)[4]) __attribute__((always_inline)) {
                        const v2u* px = (const v2u*)(XS16 + (size_t)t * DM) + lane; const v2u* p0 = (const v2u*)(YE + (size_t)rr.x * DM) + lane; const v2u* p1 = (const v2u*)(YE + (size_t)rr.y * DM) + lane;
#pragma unroll
                        for (int j = 0; j < 4; ++j) { ax[j] = px[64 * j]; a0[j] = p0[64 * j]; a1[j] = p1[64 * j]; } };
                    int t = gw;
                    if (t < MTOK) { const i32x2 rr = *(const i32x2*)(TOKR + (size_t)t * 2); wwc = *(const f32x2*)(TOKW + (size_t)t * 2); rows(t, rr, cx, c0, c1); }
                    if (t + NGW < MTOK) { rrn = *(const i32x2*)(TOKR + (size_t)(t + NGW) * 2); wwn = *(const f32x2*)(TOKW + (size_t)(t + NGW) * 2); }
                    for (; t < MTOK; t += NGW) {
                        i32x2 rrnn = {0, 0}; f32x2 wwnn = {0.f, 0.f};
                        if (t + NGW < MTOK) rows(t + NGW, rrn, nx, n0, n1);
                        if (t + 2 * NGW < MTOK) { rrnn = *(const i32x2*)(TOKR + (size_t)(t + 2 * NGW) * 2); wwnn = *(const f32x2*)(TOKW + (size_t)(t + 2 * NGW) * 2); }
                        f32x4* xr = (f32x4*)(xs + (size_t)t * DM) + lane; f32x4 v[4]; float s = 0.f; const f32x2 ww = wwc;
#pragma unroll
                        for (int j = 0; j < 4; ++j) { const v2u x = cx[j], a = c0[j], b2 = c1[j];
                            v[j].x = bfl(x.x) + ww.x * bfl(a.x) + ww.y * bfl(b2.x); v[j].y = bfh(x.x) + ww.x * bfh(a.x) + ww.y * bfh(b2.x); v[j].z = bfl(x.y) + ww.x * bfl(a.y) + ww.y * bfl(b2.y); v[j].w = bfh(x.y) + ww.x * bfh(a.y) + ww.y * bfh(b2.y);
                            s += (v[j].x * v[j].x + v[j].y * v[j].y) + (v[j].z * v[j].z + v[j].w * v[j].w); }
                        const float r = rsqrtf(wave_sum(s) * (1.f / DM) + RMS_EPS);
#pragma unroll
                        for (int j = 0; j < 4; ++j) xr[64 * j] = (f32x4){v[j].x * r * gg[j].x, v[j].y * r * gg[j].y, v[j].z * r * gg[j].z, v[j].w * r * gg[j].w};
#pragma unroll
                        for (int j = 0; j < 4; ++j) { cx[j] = nx[j]; c0[j] = n0[j]; c1[j] = n1[j]; }
                        wwc = wwn; rrn = rrnn; wwn = wwnn; } }
            }
        }
    }
    {
        constexpr int l = 1;
        const int pb = 1 + 9 * l;
        if (INL(0)) { asm volatile("; PHASE_MARK L0" ::: "memory"); PHB;
            pg8::Gemm g{(const bf16*)XNQ, (const bf16*)(ws + OFF_WL) + (size_t)l * W_LAYER_E, DM / 2, DM / 2}; pg8::GridOrder S; S.init(MTOK / 256, IN_N / 256, G, bid);
            pg8::EpiIn E{ws, (const float*)ka->in[8] + l * 8, CSIN + l * IN_N};
            REPEAT(pb + 0) pg8::gemm_phase<pg8::EpiIn, pg8::GridOrder, false, true, true, true>(F.lds + RING_OFF, g, S, E, wave);
#ifdef PROBE_NULL_EPI_IN
            { pg8::EpiNull EN; pg8::gemm_phase<pg8::EpiNull, pg8::GridOrder, false, true, true, true>(F.lds + RING_OFF, g, S, EN, wave); }
#endif
        }
        SEAML(0);
        if (INL(1)) { asm volatile("; PHASE_MARK L1" ::: "memory"); PHB;
            for (int it = F.vcu; it < 64; it += G) {
                const int b = it >> 3, h = it & 7; LAS float* part = (LAS float*)(F.lds + RING_OFF);
                float v[8]; float run = 0.f;
#pragma unroll
                for (int k = 0; k < 8; ++k) { run += LOGF[((size_t)b * SEQ + tid * 8 + k) * 8 + h]; v[k] = run; }
                float inc = run;
#pragma unroll
                for (int o = 1; o < 64; o <<= 1) { const float t = __shfl_up(inc, o); if (lane >= o) inc += t; }
                if (lane == 63) part[wave] = inc;
                LDS_WAIT(); __syncthreads();
                float base = inc - run;
                for (int w = 0; w < wave; ++w) base += part[w];
                float* dst = CUM + ((size_t)b * 8 + h) * SEQ + tid * 8;
                *(f32x4*)dst = (f32x4){v[0] + base, v[1] + base, v[2] + base, v[3] + base}; *(f32x4*)(dst + 4) = (f32x4){v[4] + base, v[5] + base, v[6] + base, v[7] + base};
                __syncthreads();
                float kn = 0.f;
                for (int k = 0; k < 8; ++k) { const v4u* kp = (const v4u*)(FK + ((size_t)b * SEQ + tid * 8 + k) * BR_W + h * 64); float sq = 0.f;
#pragma unroll
                    for (int c = 0; c < 8; ++c) { const v4u w = kp[c];
#pragma unroll
                        for (int e = 0; e < 4; ++e) { const float lo = bfl(w[e]), hi2 = bfh(w[e]); sq += lo * lo + hi2 * hi2; } }
                    kn = fmaxf(kn, sq); }
#pragma unroll
                for (int o = 1; o < 64; o <<= 1) kn = fmaxf(kn, __shfl_xor(kn, o));
                if (lane == 0) part[8 + wave] = kn;
                LDS_WAIT(); __syncthreads();
                if (tid == 0) { float m = 0.f; for (int w = 0; w < 8; ++w) m = fmaxf(m, part[8 + w]); KNM[it] = sqrtf(m); }
                __syncthreads();
            }
            for (int it = F.vcu - 64; it < 128; it += G) { if (it < 0) continue;
                const bf16* src = MK + (size_t)it * 256 * BR_W + tid; float s = 0.f;
#pragma unroll 8
                for (int r = 0; r < 256; ++r) s += __uint_as_float((unsigned)src[(size_t)r * BR_W] << 16);
                KMEAN[(size_t)it * 512 + tid] = s * (1.0f / 256.0f); }
            VM_WAIT(); __syncthreads();
            pg8::Gemm g{LAT, ((const bf16*)(ws + OFF_WL) + (size_t)l * W_LAYER_E) + W_IN_E, LAT_W, 256}; pg8::MidOrder S; S.init(MTOK / 256, UP_N / 256, G, bid);
            pg8::EpiUp E{ws};
            REPEAT(pb + 1) pg8::gemm_phase<pg8::EpiUp, pg8::MidOrder>(F.lds + RING_OFF, g, S, E, wave);
        }
        SEAML(1);
        if (INL(2)) { asm volatile("; PHASE_MARK L2" ::: "memory"); PHB;
            att::Args A0{(const att::bf16*)QM, (const att::bf16*)KVM, (const att::bf16*)KR, (const att::bf16*)KVM + 64, (att::bf16*)Y3, nullptr, nullptr, QM_W, KVM_W, KVM_W, Y3_W, 96, 128};
            att::Args A1{(const att::bf16*)FQ, (const att::bf16*)FK, nullptr, (const att::bf16*)FV, (att::bf16*)Y3 + 512, CUM, KNM, BR_W, BR_W, BR_W, Y3_W, 64, 64};
            att::Args A2{(const att::bf16*)MQ, (const att::bf16*)MK, nullptr, (const att::bf16*)MV, (att::bf16*)Y3 + 1024, nullptr, KMEAN, BR_W, BR_W, BR_W, Y3_W, 64, 64};
            char* shm = (char*)lds + RING_OFF;
            for (int rep_ = 0; rep_ < (((REP_ATT >> 0) & 1u) ? 2 : 1); ++rep_)
            for (int v = F.vcu; v < 512; v += G) { const int bh = v >> 3, s = v & 7;
                att::attn_unit<0>(bh >> 3, bh & 7, 15 - s, A0, shm, wave); att::attn_unit<0>(bh >> 3, bh & 7, s, A0, shm, wave); }
            for (int rep_ = 0; rep_ < (((REP_ATT >> 1) & 1u) ? 2 : 1); ++rep_)
            for (int v = F.vcu; v < 512; v += G) { const int bh = v >> 3, s = v & 7;
                att::attn_unit<1>(bh >> 3, bh & 7, 15 - s, A1, shm, wave); att::attn_unit<1>(bh >> 3, bh & 7, s, A1, shm, wave); }
            for (int rep_ = 0; rep_ < (((REP_ATT >> 2) & 1u) ? 2 : 1); ++rep_)
            for (int v = F.vcu; v < 512; v += G) { const int bh = v >> 3, s = v & 7;
                att::attn_unit<2>(bh >> 3, bh & 7, 15 - s, A2, shm, wave); att::attn_unit<2>(bh >> 3, bh & 7, s, A2, shm, wave); }
        }
        SEAML(2);
        if (INL(3)) { asm volatile("; PHASE_MARK L3" ::: "memory"); PHB;
            pg8::Gemm g{Y3, ((const bf16*)(ws + OFF_WL) + (size_t)l * W_LAYER_E) + W_IN_E + W_UP_E, Y3_W, Y3_W}; pg8::GridOrder S; S.init(MTOK / 256, DM / 256, G, bid);
            pg8::EpiMerge E{GT, MERGED};
            REPEAT(pb + 3) pg8::gemm_phase<pg8::EpiMerge, pg8::GridOrder>(F.lds + RING_OFF, g, S, E, wave);
        }
        SEAML(3);
        if (INL(4)) { asm volatile("; PHASE_MARK L4" ::: "memory"); PHB;
            pg8::Gemm g{MERGED, ((const bf16*)(ws + OFF_WL) + (size_t)l * W_LAYER_E) + W_IN_E + W_UP_E + W_BR_E, DM, DM}; pg8::GridOrder S; S.init(MTOK / 256, DM / 256, G, bid);
            pg8::EpiResidB<l == 0> E{l == 0 ? (const void*)x_in : (const void*)XS16, XS16, 1.0f};
            REPEAT(l == 0 ? pb + 4 : 31) pg8::gemm_phase<pg8::EpiResidB<l == 0>, pg8::GridOrder>(F.lds + RING_OFF, g, S, E, wave);
        }
        SEAML(4);
        if (l == 0) {
            if (IN(6)) { asm volatile("; PHASE_MARK 6" ::: "memory"); PHB; const float* gf = (const float*)ka->in[11]; REPEAT(6) rms_rows_to_i8<false>(XS16, gf, XNQ, RSX, gw, NGW, lane); }
            SEAM(6);
            if (IN(7)) { asm volatile("; PHASE_MARK 7" ::: "memory"); PHB;
                pg8::Gemm g{(const bf16*)XNQ, (const bf16*)(ws + OFF_WDGU), DM / 2, DM / 2}; pg8::GridOrder S; S.init(MTOK / 256, 2 * DFF / 256, G, bid);
#if DENSE_DOWN_F8
                pg8::EpiSwigluI8 E{(unsigned char*)ACTD, DFF, RSX, CSC};
                REPEAT(7) pg8::gemm_phase<pg8::EpiSwigluI8, pg8::GridOrder, false, true, true, true>(F.lds + RING_OFF, g, S, E, wave);
#else
                pg8::EpiSwigluI8B E{ACTD, DFF, RSX, CSC};
                REPEAT(7) pg8::gemm_phase<pg8::EpiSwigluI8B, pg8::GridOrder, false, true, true, true>(F.lds + RING_OFF, g, S, E, wave);
#endif
            }
            SEAM(7);
            if (IN(8)) { asm volatile("; PHASE_MARK 8" ::: "memory"); PHB;
#if DENSE_DOWN_F8
                pg8::Gemm g{(const bf16*)ACTD, (const bf16*)(ws + OFF_WDDN), DFF / 2, DFF / 2}; pg8::GridOrder S; S.init(MTOK / 256, DM / 256, G, bid);
                pg8::EpiResidB<false> E{(const void*)XS16, XS16, 1.0f / (A8S_ACT * W8S_DN)};
                pg8::gemm_phase<pg8::EpiResidB<false>, pg8::GridOrder, true, true, true, false, false, false>(F.lds + RING_OFF, g, S, E, wave);
#else
                pg8::Gemm g{ACTD, (const bf16*)(ws + OFF_WDDN), DFF, DFF}; pg8::GridOrder S; S.init(MTOK / 256, DM / 256, G, bid);
                pg8::EpiResidB<false> E{(const void*)XS16, XS16, 1.0f};
                pg8::gemm_phase<pg8::EpiResidB<false>, pg8::GridOrder>(F.lds + RING_OFF, g, S, E, wave);
#endif
            }
            SEAM(8);
            if (IN(9)) { asm volatile("; PHASE_MARK 9" ::: "memory"); PHB; const float* gm = (const float*)ka->in[2] + DM; REPEAT(9) rms_rows_to_i8<false>(XS16, gm, XNQ, RSIN, gw, NGW, lane); }
            SEAM(9);
        } else {
            if (IN(15)) { asm volatile("; PHASE_MARK 15" ::: "memory"); PHB;
                const float* gf = (const float*)ka->in[11] + DM;
                LAS int* cnt = (LAS int*)(F.lds + RING_OFF + 32768);
                const float* wr = (const float*)ka->in[14];
                f32x4 w0[4][4], w1[4][4], gg[4];
#pragma unroll
                for (int j = 0; j < 4; ++j) { gg[j] = ((const f32x4*)gf + lane)[64 * j];
#pragma unroll
                    for (int q = 0; q < 4; ++q) { const f32x4* wp = (const f32x4*)(wr + (size_t)(256 * j + 4 * lane + q) * 8); w0[j][q] = wp[0]; w1[j][q] = wp[1]; } }
                const bool b0_ = (lane & 1) != 0, b1_ = (lane & 2) != 0, b2_ = (lane & 4) != 0;
                REPEAT(15) for (int c = bid; c < 256; c += G) {
                    if (tid < 64) cnt[tid] = 0;
                    LDS_WAIT(); __syncthreads();
                    const int t0 = c * 128 + wave * 16;
                    auto row_do = [&](int t, f32x4 (&v)[4]) __attribute__((always_inline)) {
                        float s = 0.f;
#pragma unroll
                        for (int j = 0; j < 4; ++j) s += (v[j].x * v[j].x + v[j].y * v[j].y) + (v[j].z * v[j].z + v[j].w * v[j].w);
                        const float r = rsqrtf(wave_sum(s) * (1.f / DM) + RMS_EPS);
                        float lg[8];
#pragma unroll
                        for (int e = 0; e < 8; ++e) lg[e] = 0.f;
                        float mx = 0.f;
#pragma unroll
                        for (int j = 0; j < 4; ++j) { const f32x4 hv = {v[j].x * r * gg[j].x, v[j].y * r * gg[j].y, v[j].z * r * gg[j].z, v[j].w * r * gg[j].w}; v[j] = hv;
                            mx = fmaxf(fmaxf(mx, fmaxf(fabsf(hv.x), fabsf(hv.y))), fmaxf(fabsf(hv.z), fabsf(hv.w)));
#pragma unroll
                            for (int q = 0; q < 4; ++q) { const f32x4 a0 = w0[j][q], a1 = w1[j][q]; const float hh = hv[q];
                                lg[0] += hh * a0.x; lg[1] += hh * a0.y; lg[2] += hh * a0.z; lg[3] += hh * a0.w; lg[4] += hh * a1.x; lg[5] += hh * a1.y; lg[6] += hh * a1.z; lg[7] += hh * a1.w; } }
#pragma unroll
                        for (int o = 1; o < 64; o <<= 1) mx = fmaxf(mx, __shfl_xor(mx, o));
                        { const float sc = mx > 0.f ? 127.0f / mx : 0.f; unsigned* o4 = (unsigned*)(XN8 + (size_t)t * DM) + lane;
#pragma unroll
                          for (int j = 0; j < 4; ++j) o4[64 * j] = pk4_i8(v[j].x * sc, v[j].y * sc, v[j].z * sc, v[j].w * sc);
                          if (lane == 0) RSX[t] = mx * (1.0f / 127.0f); }
                        float y4[4], y2[2], y1;
#pragma unroll
                        for (int k = 0; k < 4; ++k) { const float keep = b0_ ? lg[4 + k] : lg[k], send = b0_ ? lg[k] : lg[4 + k]; y4[k] = keep + __shfl_xor(send, 1); }
#pragma unroll
                        for (int k = 0; k < 2; ++k) { const float keep = b1_ ? y4[2 + k] : y4[k], send = b1_ ? y4[k] : y4[2 + k]; y2[k] = keep + __shfl_xor(send, 2); }
                        { const float keep = b2_ ? y2[1] : y2[0], send = b2_ ? y2[0] : y2[1]; y1 = keep + __shfl_xor(send, 4); }
                        y1 += __shfl_xor(y1, 8); y1 += __shfl_xor(y1, 16); y1 += __shfl_xor(y1, 32);
#pragma unroll
                        for (int e = 0; e < 8; ++e) lg[e] = __uint_as_float(__builtin_amdgcn_readlane(__float_as_uint(y1), ((e >> 2) & 1) | (((e >> 1) & 1) << 1) | ((e & 1) << 2)));
                        int e0 = 0; float b0 = lg[0];
#pragma unroll
                        for (int e = 1; e < 8; ++e) if (lg[e] > b0) { b0 = lg[e]; e0 = e; }
                        int e1 = 0; float b1 = -INFINITY;
#pragma unroll
                        for (int e = 0; e < 8; ++e) if (e != e0 && lg[e] > b1) { b1 = lg[e]; e1 = e; }
                        if (lane == 0) { const float w1v = 1.0f / (1.0f + __expf(b0 - b1)); const float w0v = 1.0f - w1v;
                            volatile LAS int* cw = cnt + wave * 8; const int i0 = cw[e0]; cw[e0] = i0 + 1; const int i1 = cw[e1]; cw[e1] = i1 + 1;
                            *(i32x4*)(TOKI + (size_t)t * 4) = (i32x4){e0, e1, i0, i1}; *(f32x2*)(TOKW + (size_t)t * 2) = (f32x2){w0v, w1v}; }
                    };
                    f32x4 na[4], nb[4]; ld_row16(XS16 + (size_t)t0 * DM, lane, na); ld_row16(XS16 + (size_t)(t0 + 1) * DM, lane, nb);
                    for (int i = 0; i < 16; i += 2) { const int t = t0 + i;
                        f32x4 va[4], vb[4];
#pragma unroll
                        for (int j = 0; j < 4; ++j) { va[j] = na[j]; vb[j] = nb[j]; }
                        if (i + 2 < 16) { ld_row16(XS16 + (size_t)(t + 2) * DM, lane, na); ld_row16(XS16 + (size_t)(t + 3) * DM, lane, nb); }
                        row_do(t, va); row_do(t + 1, vb);
                    }
                    LDS_WAIT(); __syncthreads();
                    if (tid < 8) { int* wp = (int*)(ws + OFF_WPRE) + c * 64 + tid; int run = 0;
#pragma unroll
                        for (int w = 0; w < 8; ++w) { wp[w * 8] = run; run += cnt[w * 8 + tid]; }
                        CNT[c * 8 + tid] = run; }
                    __syncthreads();
                }
            }
            SEAM(15);
            if (IN(16)) { asm volatile("; PHASE_MARK 16" ::: "memory"); PHB;
                LAS int* PRE = (LAS int*)(F.lds + RING_OFF);
                LAS int* TOT = PRE + 2048;
                { const int e = wave; int cv[4]; int run = 0;
#pragma unroll
                    for (int k = 0; k < 4; ++k) { cv[k] = CNT[(lane * 4 + k) * 8 + e]; run += cv[k]; }
                    int inc = run;
#pragma unroll
                    for (int o = 1; o < 64; o <<= 1) { const int t = __shfl_up(inc, o); if (lane >= o) inc += t; }
                    int ex = inc - run;
#pragma unroll
                    for (int k = 0; k < 4; ++k) { PRE[e * 256 + lane * 4 + k] = ex; ex += cv[k]; }
                    if (lane == 63) TOT[e] = inc; }
                LDS_WAIT(); __syncthreads();
                if (tid == 0) { int st = 0;
                    for (int e = 0; e < 8; ++e) { TOT[8 + e] = st; const int nb = (TOT[e] + 255) >> 8;
                        if (bid == 0) for (int k = 0; k < nb; ++k) MTAB[(st >> 8) + k] = e;
                        st += nb << 8; }
                    if (bid == 0) MTAB[264] = st >> 8; }
                LDS_WAIT(); __syncthreads();
                REPEAT(16) for (int c = bid; c < 256; c += G)
                    for (int i = 0; i < 16; ++i) { const int t = c * 128 + wave * 16 + i; const i32x4 ti = *(const i32x4*)(TOKI + (size_t)t * 4);
                        const int* wpre = (const int*)(ws + OFF_WPRE) + (c * 8 + wave) * 8;
                        const int r0 = TOT[8 + ti.x] + PRE[ti.x * 256 + c] + wpre[ti.x] + ti.z, r1 = TOT[8 + ti.y] + PRE[ti.y * 256 + c] + wpre[ti.y] + ti.w;
                        if (lane == 0) { *(i32x2*)(TOKR + (size_t)t * 2) = (i32x2){r0, r1}; const float rsv = RSX[t]; RSG[r0] = rsv; RSG[r1] = rsv; }
                        const v4u a = *((const v4u*)(XN8 + (size_t)t * DM) + lane);
                        *((v4u*)(XG + (size_t)r0 * DM) + lane) = a; *((v4u*)(XG + (size_t)r1 * DM) + lane) = a; }
            }
            SEAM(16);
            if (IN(17)) { asm volatile("; PHASE_MARK 17" ::: "memory"); PHB;
                const __attribute__((address_space(4))) int* mtab = (const __attribute__((address_space(4))) int*)(ws + OFF_MTAB); const int nblk = mtab[264];
                pg8::Gemm g{(const bf16*)XG, (const bf16*)(ws + OFF_WEGU), DM / 2, DM / 2}; pg8::MoeOrder S; S.init(nblk, 2 * EFF / 256, G, bid); S.tab = mtab;
                pg8::EpiSwigluI8 E{ACTM, EFF, RSG, (const float*)(ws + OFF_CSE)};
                REPEAT(17) pg8::gemm_phase<pg8::EpiSwigluI8, pg8::MoeOrder, false, true, true, true>(F.lds + RING_OFF, g, S, E, wave);
#ifdef PROBE_NULL_EPI
                { pg8::EpiNull EN; pg8::gemm_phase<pg8::EpiNull, pg8::MoeOrder, true>(F.lds + RING_OFF, g, S, EN, wave); }
#endif
            }
            SEAM(17);
            if (IN(18)) { asm volatile("; PHASE_MARK 18" ::: "memory"); PHB;
                const __attribute__((address_space(4))) int* mtab = (const __attribute__((address_space(4))) int*)(ws + OFF_MTAB); const int nblk = mtab[264];
                pg8::Gemm g{(const bf16*)ACTM, (const bf16*)(ws + OFF_WEDN), EFF / 2, EFF / 2}; pg8::MoeDownOrder S; S.init(nblk, G, bid); S.tab = mtab;
                pg8::EpiBf8K E{YE, (float*)(ws + OFF_XG), 1.0f / (A8S_ACT * W8S_DN)};
                REPEAT(18) pg8::gemm_phase<pg8::EpiBf8K, pg8::MoeDownOrder, true, true, true, false, true, false>(F.lds + RING_OFF, g, S, E, wave);
            }
            SEAM(18);
            if (IN(19)) { asm volatile("; PHASE_MARK 19" ::: "memory"); PHB;
                {
                    const __attribute__((address_space(4))) int* mtab = (const __attribute__((address_space(4))) int*)(ws + OFF_MTAB); const int ntail = (mtab[264] - 256) * 256;
                    const float* PART = (const float*)(ws + OFF_XG);
                    for (int r = gw; r < ntail; r += NGW) { const float* pp = PART + (size_t)(((r >> 8) * 7) * 256 + (r & 255)) * DM; f32x4 pv[7][4];
#pragma unroll
                        for (int k = 0; k < 7; ++k)
#pragma unroll
                            for (int j = 0; j < 4; ++j) pv[k][j] = ((const f32x4*)(pp + (size_t)k * 256 * DM) + lane)[64 * j];
#pragma unroll
                        for (int j = 0; j < 4; ++j) { f32x4 a = pv[0][j];
#pragma unroll
                            for (int k = 1; k < 7; ++k) a += pv[k][j];
                            ((v2u*)(YE + (size_t)(65536 + r) * DM) + lane)[64 * j] = (v2u){pg8::cvt_pk_bf16(a.x, a.y), pg8::cvt_pk_bf16(a.z, a.w)}; } }
                    xcd_barrier(bar, F.wave); }
                const f32x4* gr = (const f32x4*)ka->in[17] + lane;
                {   f32x4 gg[4];
#pragma unroll
                    for (int j = 0; j < 4; ++j) gg[j] = gr[64 * j];
                    v2u cx[4], c0[4], c1[4], nx[4], n0[4], n1[4]; i32x2 rrn = {0, 0}; f32x2 wwc = {0.f, 0.f}, wwn = {0.f, 0.f};
                    auto rows = [&](int t, i32x2 rr, v2u (&ax)[4], v2u (&a0)[4], v2u (&a1)[4]) __attribute__((always_inline)) {
                        const v2u* px = (const v2u*)(XS16 + (size_t)t * DM) + lane; const v2u* p0 = (const v2u*)(YE + (size_t)rr.x * DM) + lane; const v2u* p1 = (const v2u*)(YE + (size_t)rr.y * DM) + lane;
#pragma unroll
                        for (int j = 0; j < 4; ++j) { ax[j] = px[64 * j]; a0[j] = p0[64 * j]; a1[j] = p1[64 * j]; } };
                    int t = gw;
                    if (t < MTOK) { const i32x2 rr = *(const i32x2*)(TOKR + (size_t)t * 2); wwc = *(const f32x2*)(TOKW + (size_t)t * 2); rows(t, rr, cx, c0, c1); }
                    if (t + NGW < MTOK) { rrn = *(const i32x2*)(TOKR + (size_t)(t + NGW) * 2); wwn = *(const f32x2*)(TOKW + (size_t)(t + NGW) * 2); }
                    for (; t < MTOK; t += NGW) {
                        i32x2 rrnn = {0, 0}; f32x2 wwnn = {0.f, 0.f};
                        if (t + NGW < MTOK) rows(t + NGW, rrn, nx, n0, n1);
                        if (t + 2 * NGW < MTOK) { rrnn = *(const i32x2*)(TOKR + (size_t)(t + 2 * NGW) * 2); wwnn = *(const f32x2*)(TOKW + (size_t)(t + 2 * NGW) * 2); }
                        f32x4* xr = (f32x4*)(xs + (size_t)t * DM) + lane; f32x4 v[4]; float s = 0.f; const f32x2 ww = wwc;
#pragma unroll
                        for (int j = 0; j < 4; ++j) { const v2u x = cx[j], a = c0[j], b2 = c1[j];
                            v[j].x = bfl(x.x) + ww.x * bfl(a.x) + ww.y * bfl(b2.x); v[j].y = bfh(x.x) + ww.x * bfh(a.x) + ww.y * bfh(b2.x); v[j].z = bfl(x.y) + ww.x * bfl(a.y) + ww.y * bfl(b2.y); v[j].w = bfh(x.y) + ww.x * bfh(a.y) + ww.y * bfh(b2.y);
                            s += (v[j].x * v[j].x + v[j].y * v[j].y) + (v[j].z * v[j].z + v[j].w * v[j].w); }
                        const float r = rsqrtf(wave_sum(s) * (1.f / DM) + RMS_EPS);
#pragma unroll
                        for (int j = 0; j < 4; ++j) xr[64 * j] = (f32x4){v[j].x * r * gg[j].x, v[j].y * r * gg[j].y, v[j].z * r * gg[j].z, v[j].w * r * gg[j].w};
#pragma unroll
                        for (int j = 0; j < 4; ++j) { cx[j] = nx[j]; c0[j] = n0[j]; c1[j] = n1[j]; }
                        wwc = wwn; rrn = rrnn; wwn = wwnn; } }
            }
        }
    }
#undef IN
#undef SEAM
#undef INL
#undef SEAML
}

#undef SSQ
#undef LOGF
#undef CUM
#undef KMEAN
#undef KNM
#undef R64C
#undef R64S
#undef R32C
#undef R32S
#undef TOKI
#undef TOKW
#undef TOKR
#undef CNT
#undef MTAB
#undef XN8
#undef RSX
#undef RSG
#undef XS16
#undef XNQ
#undef CSC
#undef CSIN
#undef RSIN
#undef XN
#undef QM
#undef LAT
#undef KR
#undef FQ
#undef FK
#undef FV
#undef MQ
#undef MK
#undef MV
#undef GT
#undef KVM
#undef MERGED
#undef Y3
#undef ACTD
#undef ACTM
#undef XG
#undef YE
extern "C" void kernel_launch(void* const* d_in, const int* in_sizes, int n_in, void* d_out, int out_size, void* d_ws, size_t ws_size, hipStream_t stream) {
    static int grid = 0;
    if (grid == 0) {
        if (n_in != 18 || in_sizes[0] != MTOK * DM || out_size != MTOK * DM || ws_size < WS_NEED) { fprintf(stderr, "kernel_launch: shape / workspace mismatch (n_in %d, ws %zu, need %zu); nothing launched\n", n_in, ws_size, (size_t)WS_NEED); grid = -1; return; }
        int dev = 0, cus = 0, per_cu = 0;
        if (hipGetDevice(&dev) != hipSuccess || hipDeviceGetAttribute(&cus, hipDeviceAttributeMultiprocessorCount, dev) != hipSuccess) { grid = -1; return; }
        if (hipFuncSetAttribute((const void*)mega_fwd, hipFuncAttributeMaxDynamicSharedMemorySize, LDS_BYTES) != hipSuccess) { fprintf(stderr, "kernel_launch: hipFuncSetAttribute failed\n"); grid = -1; return; }
        if (hipOccupancyMaxActiveBlocksPerMultiprocessor(&per_cu, (const void*)mega_fwd, NWAVES * 64, LDS_BYTES) != hipSuccess || per_cu < 1) fprintf(stderr, "kernel_launch: occupancy query reports %d\n", per_cu);
        (void)hipGetLastError();
        grid = cus;
    }
    if (grid < 0) return;
    if (hipMemsetAsync((char*)d_ws + WS_CTL, 0, CTL_ZERO_BYTES, stream) != hipSuccess) return;
    KArgs a; memset(&a, 0, sizeof(a));
    for (int i = 0; i < 18; ++i) a.in[i] = d_in[i];
    a.out = (float*)d_out; a.ws = (unsigned char*)d_ws;
#if MK_N_LAUNCHES == 1
    a.ph_lo = 0; a.ph_hi = NPHASE;
    hipLaunchKernelGGL(mega_fwd, dim3(grid), dim3(NWAVES * 64), LDS_BYTES, stream, a);
#else
    for (int p = 0; p < NPHASE; ++p) { a.ph_lo = p; a.ph_hi = p + 1; hipLaunchKernelGGL(mega_fwd, dim3(grid), dim3(NWAVES * 64), LDS_BYTES, stream, a); }
#endif
}
```

```cpp
#include <hip/hip_runtime.h>
#include <hip/hip_bf16.h>
#include <cstdio>
#include <cstdint>
#include <cstring>

#define LAS __attribute__((address_space(3)))
#define GAS __attribute__((address_space(1)))

namespace pg8 {
typedef unsigned short bf16_t;
typedef short bf16x8 __attribute__((ext_vector_type(8)));
typedef float f32x4 __attribute__((ext_vector_type(4)));
typedef float f32x2 __attribute__((ext_vector_type(2)));
typedef unsigned u32x4 __attribute__((ext_vector_type(4)));
typedef unsigned u32x2 __attribute__((ext_vector_type(2)));
typedef int i32x4 __attribute__((ext_vector_type(4)));
typedef int i32x8 __attribute__((ext_vector_type(8)));
constexpr int BM = 256, BK = 64, HALF = 128, HTB = HALF * BK * 2  , STAGE_BYTES = 8 * HTB, NXCD = 8, WGM = 8;

__host__ __device__ __forceinline__ int lds_byte(int r, int c) { const int st = (r >> 4) * 2 + (c >> 5), rr = r & 15, cc = c & 31, ob = rr * 64 + cc * 2; return st * 1024 + (ob ^ (((ob >> 9) & 1) << 5)); }
__host__ __device__ __forceinline__ void stage_rc(int b, int& R, int& C) { const int st = b / 1024, sb = b % 1024, swz = sb ^ (((sb >> 9) & 1) << 5); R = (st >> 1) * 16 + swz / 64; C = (st & 1) * 32 + (swz % 64) / 2; }
__host__ __device__ __forceinline__ int perm32(int rho) { const int n = rho >> 4, i = rho & 15; return 8 * (i >> 2) + 4 * n + (i & 3); }

struct Unit { int pm, pn, bt; unsigned aoff; int nt; unsigned boff; int ks; };
struct Gemm { const bf16_t* A; const bf16_t* Bt; int lda, K; };

struct GridOrder {
    int nM, nN, nwg, G, c;
    __device__ void init(int nM_, int nN_, int G_, int c_) { nM = nM_; nN = nN_; nwg = nM * nN; G = G_; c = c_; }
    __device__ __forceinline__ bool next_mn(int i, int& pm, int& pn) const {
        const int L = i * G + c; if (L >= nwg) return false;
        int wgid = L; { const int q = nwg / NXCD, r = nwg % NXCD, xcd = wgid % NXCD, off = wgid / NXCD; wgid = (xcd < r ? xcd * (q + 1) : r * (q + 1) + (xcd - r) * q) + off; }
        const int nig = WGM * nN, gid = wgid / nig, fm = gid * WGM, gsz = (nM - fm) < WGM ? (nM - fm) : WGM;
        pm = fm + ((wgid % nig) % gsz); pn = (wgid % nig) / gsz; return true;
    }
    __device__ __forceinline__ bool next(int i, Unit& u) const { if (!next_mn(i, u.pm, u.pn)) return false; u.bt = u.pn; u.aoff = 0u; return true; }
};
struct MidOrder : GridOrder {
    __device__ __forceinline__ bool next(int i, Unit& u) const { if (!next_mn(i, u.pm, u.pn)) return false; u.bt = u.pn; u.aoff = (u.pn >= 3) ? 512u : 0u; return true; }
};
struct MoeOrder : GridOrder {
    const __attribute__((address_space(4))) int* tab;
    __device__ __forceinline__ bool next(int i, Unit& u) const { if (!next_mn(i, u.pm, u.pn)) return false;
        const int e = tab[u.pm]; u.bt = e * nN + u.pn; u.aoff = 0u; return true; }
};

struct MoeDownOrder {
    GridOrder main; int nblk, G, c; const __attribute__((address_space(4))) int* tab;
    __device__ void init(int nblk_, int G_, int c_) { nblk = nblk_; G = G_; c = c_; main.init(256, 4, G_, c_); }
    __device__ __forceinline__ bool next(int i, Unit& u) const {
        const int L = i * G + c; const int j = L - 1024;
        if (j >= (nblk - 256) * 28) return false;
        int pm, pn; main.next_mn(L < 1024 ? i : 0, pm, pn);
        const int q = j / 28, r = j - q * 28, pn2 = r / 7, ks2 = r - pn2 * 7; const bool tail = j >= 0;
        pm = tail ? 256 + q : pm; pn = tail ? pn2 : pn;
        const unsigned off = tail ? (unsigned)ks2 * 512u : 0u;
        u.pm = pm; u.pn = pn; u.bt = tab[pm] * 4 + pn; u.aoff = off; u.boff = off; u.nt = tail ? 4 : 28; u.ks = tail ? ks2 : -1; return true; }
};

__device__ __forceinline__ unsigned cvt_pk_bf16(float lo, float hi) { unsigned r; asm volatile("v_cvt_pk_bf16_f32 %0, %1, %2" : "=v"(r) : "v"(lo), "v"(hi)); return r; }
__device__ __forceinline__ u32x4 pack8(const f32x4 v0, const f32x4 v1) { u32x4 w; w.x = cvt_pk_bf16(v0[0], v0[1]); w.y = cvt_pk_bf16(v0[2], v0[3]); w.z = cvt_pk_bf16(v1[0], v1[1]); w.w = cvt_pk_bf16(v1[2], v1[3]); return w; }
__device__ __forceinline__ u32x2 pack4(const f32x4 v0) { u32x2 w; w.x = cvt_pk_bf16(v0[0], v0[1]); w.y = cvt_pk_bf16(v0[2], v0[3]); return w; }
__device__ __forceinline__ float clamp8(float v) { return fminf(fmaxf(v, -448.0f), 448.0f); }
__device__ __forceinline__ unsigned pk4_f8(float a, float b, float c, float d) { int v = 0; v = __builtin_amdgcn_cvt_pk_fp8_f32(clamp8(a), clamp8(b), v, false); v = __builtin_amdgcn_cvt_pk_fp8_f32(clamp8(c), clamp8(d), v, true); return (unsigned)v; }
__device__ __forceinline__ float bf_lo(unsigned w) { return __uint_as_float(w << 16); }
__device__ __forceinline__ float bf_hi(unsigned w) { return __uint_as_float(w & 0xffff0000u); }
__device__ __forceinline__ float fast_sigmoid(float x) { return __builtin_amdgcn_rcpf(1.0f + __builtin_amdgcn_exp2f(-1.4426950408889634f * x)); }

typedef f32x4 Acc[2][2][4][2];
__device__ __forceinline__ int lane_id_opaque() { int l; asm volatile("v_mbcnt_lo_u32_b32 %0, -1, 0\n\tv_mbcnt_hi_u32_b32 %0, -1, %0" : "=v"(l)); return l; }

template <class Epi, class Sched, bool F8 = false, bool ALIGN_EPI = true, bool SP2 = true, bool I8 = false, bool VARK = false, bool PEEL = true>
__device__ __forceinline__ void gemm_phase(LAS unsigned char* lds, const Gemm g, const Sched& S, const Epi& E, int wid) {
    const int lane = lane_id_opaque();
    const int tid = wid * 64 + lane, wr = wid >> 2, wc = wid & 3, fr = lane & 15, fq = lane >> 4;
    const int K = g.K, nt = K / BK, lda = g.lda;
    unsigned voffA, voffB;
    { int R, C; stage_rc(tid * 16, R, C); voffA = (unsigned)(R * lda + C) * 2u; voffB = (unsigned)(R * K + C) * 2u; }
    const size_t rstepA = (size_t)64 * lda * 2, rstepB = (size_t)64 * K * 2;
    const size_t kstep = (size_t)(BK * 2);
    const size_t hstepA = (size_t)HALF * lda * 2, hstepB = (size_t)HALF * K * 2;
    const size_t tstepA = 2 * hstepA, tstepB = 2 * hstepB;
    const unsigned ldsw = (unsigned)wid * 1024u;
    const int aoff = lds_byte(wr * 64 + fr, fq * 8), boff = lds_byte(wc * 32 + fr, fq * 8);
#define PG8_SA(b, h) (((b) * 2 + (h)) * HTB)
#define PG8_SB(b, h) ((4 + (b) * 2 + (h)) * HTB)
#define PG8_STAGE(bufoff, gbase, X) do { _Pragma("unroll") for (int _i = 0; _i < 2; ++_i) \
        __builtin_amdgcn_global_load_lds((const unsigned*)((const char*)(gbase) + _i * rstep##X + voff##X), (LAS unsigned*)(lds + (bufoff) + ldsw + _i * 8192), 16, 0, 0); } while (0)
#define PG8_LDA(dst, b, h) do { _Pragma("unroll") for (int m = 0; m < 4; ++m) _Pragma("unroll") for (int k = 0; k < 2; ++k) dst[m][k] = *(const LAS bf16x8*)(lds + PG8_SA(b, h) + aoff + m * 2048 + k * 1024); } while (0)
#define PG8_LDB(dst, b, h) do { _Pragma("unroll") for (int n = 0; n < 2; ++n) _Pragma("unroll") for (int k = 0; k < 2; ++k) dst[n][k] = *(const LAS bf16x8*)(lds + PG8_SB(b, h) + boff + n * 2048 + k * 1024); } while (0)
#define PG8_CAT8(x) __builtin_shufflevector(__builtin_bit_cast(i32x4, x[0]), __builtin_bit_cast(i32x4, x[1]), 0, 1, 2, 3, 4, 5, 6, 7)
#define PG8_MMA(ai, bj, At, Bt) do { __builtin_amdgcn_s_setprio(1); _Pragma("unroll") for (int m = 0; m < 4; ++m) _Pragma("unroll") for (int n = 0; n < 2; ++n) { \
        if constexpr (F8) acc[ai][bj][m][n] = __builtin_amdgcn_mfma_scale_f32_16x16x128_f8f6f4(PG8_CAT8(Bt[n]), PG8_CAT8(At[m]), acc[ai][bj][m][n], 0, 0, 0, 0x7F7F7F7F, 0, 0x7F7F7F7F); \
        else if constexpr (I8) { _Pragma("unroll") for (int k = 0; k < 2; ++k) acc[ai][bj][m][n] = __builtin_bit_cast(f32x4, __builtin_amdgcn_mfma_i32_16x16x64_i8(__builtin_bit_cast(i32x4, Bt[n][k]), __builtin_bit_cast(i32x4, At[m][k]), __builtin_bit_cast(i32x4, acc[ai][bj][m][n]), 0, 0, 0)); } \
        else { _Pragma("unroll") for (int k = 0; k < 2; ++k) acc[ai][bj][m][n] = __builtin_amdgcn_mfma_f32_16x16x32_bf16(Bt[n][k], At[m][k], acc[ai][bj][m][n], 0, 0, 0); } } __builtin_amdgcn_s_setprio(0); } while (0)
#define PG8_WAIT_V(n) asm volatile("s_waitcnt vmcnt(" #n ")" ::: "memory")
#define PG8_WAIT_VE asm volatile("s_waitcnt vmcnt(%0)" :: "n"(8 + Epi::NVM) : "memory")
#define PG8_WAIT_L(n) asm volatile("s_waitcnt lgkmcnt(" #n ")" ::: "memory")
#define PG8_BAR __builtin_amdgcn_s_barrier()
#define PG8_SCHED __builtin_amdgcn_sched_barrier(0)
    Unit cur, nxt; int ui = 0;
    if (!S.next(0, cur)) return;
    Acc acc;
#pragma unroll
    for (int a = 0; a < 2; ++a)
#pragma unroll
        for (int b = 0; b < 2; ++b)
#pragma unroll
            for (int m = 0; m < 4; ++m)
#pragma unroll
                for (int n = 0; n < 2; ++n) acc[a][b][m][n] = (f32x4){0.f, 0.f, 0.f, 0.f};
    bf16x8 At[4][2], B0[2][2], B1[2][2];
    const char* cA = (const char*)g.A + (size_t)cur.pm * tstepA + cur.aoff; const char* cB = (const char*)g.Bt + (size_t)cur.bt * tstepB + (VARK ? cur.boff : 0u);
    {
        PG8_STAGE(PG8_SB(0, 0), cB, B); PG8_STAGE(PG8_SB(0, 1), cB + hstepB, B); PG8_STAGE(PG8_SA(0, 0), cA, A); PG8_STAGE(PG8_SA(0, 1), cA + hstepA, A);
        if (wr == 1) PG8_BAR;
        PG8_WAIT_V(2); PG8_BAR;
        PG8_STAGE(PG8_SB(1, 0), cB + kstep, B); PG8_STAGE(PG8_SA(1, 0), cA + kstep, A); PG8_STAGE(PG8_SB(1, 1), cB + hstepB + kstep, B);
        PG8_WAIT_V(6); PG8_BAR;
    }
    for (;;) {
        const bool has_next = S.next(ui + 1, nxt);
        const char* nA = has_next ? (const char*)g.A + (size_t)nxt.pm * tstepA + nxt.aoff : cA; const char* nB = has_next ? (const char*)g.Bt + (size_t)nxt.bt * tstepB + (VARK ? nxt.boff : 0u) : cB;
        const int ntc = VARK ? cur.nt : nt;
        if constexpr (Epi::LDSSCALE) { const int l_ = lane_id_opaque(); const float* src = (wid < 4 ? E.cs_src(cur) : E.rs_src(cur) - 256) + wid * 64 + l_;
            __builtin_amdgcn_global_load_lds((const unsigned*)src, (LAS unsigned*)(lds + 8 * HTB + 4096 + (ui & 1) * 2048 + wid * 256), 4, 0, 0); }
#define PG8_TRIP(WF) do { \
            const bool last = (t == ntc - 2); \
            const char* a1 = cA + (size_t)(t + 1) * kstep; \
            const char* a2 = last ? nA : cA + (size_t)(t + 2) * kstep; const char* b2 = last ? nB : cB + (size_t)(t + 2) * kstep; \
            const char* a3 = a2 + kstep; const char* b3 = b2 + kstep; \
            if constexpr (Epi::MIDK) { if (t == Epi::MID0 || t == Epi::MID1) { const int l_ = lane_id_opaque(); E.mid(acc, cur, t, wr, wc, l_ & 15, l_ >> 4); } } \
            PG8_LDB(B0, 0, 0); PG8_LDB(B1, 0, 1); PG8_SCHED; PG8_LDA(At, 0, 0); PG8_STAGE(PG8_SA(1, 1), a1 + hstepA, A); \
            WF; PG8_WAIT_L(0); PG8_BAR; PG8_MMA(0, 0, At, B0); PG8_MMA(0, 1, At, B1); PG8_BAR; PG8_SCHED; \
            PG8_LDA(At, 0, 1); PG8_STAGE(PG8_SB(0, 0), b2, B); PG8_STAGE(PG8_SB(0, 1), b2 + hstepB, B); PG8_STAGE(PG8_SA(0, 0), a2, A); \
            WF; PG8_WAIT_L(0); PG8_BAR; PG8_MMA(1, 0, At, B0); PG8_MMA(1, 1, At, B1); PG8_BAR; PG8_SCHED; \
            PG8_LDB(B0, 1, 0); PG8_LDB(B1, 1, 1); PG8_SCHED; PG8_LDA(At, 1, 0); PG8_STAGE(PG8_SA(0, 1), a2 + hstepA, A); \
            WF; PG8_WAIT_L(0); PG8_BAR; PG8_MMA(0, 0, At, B0); PG8_MMA(0, 1, At, B1); PG8_BAR; PG8_SCHED; \
            PG8_LDA(At, 1, 1); PG8_STAGE(PG8_SB(1, 0), b3, B); PG8_STAGE(PG8_SB(1, 1), b3 + hstepB, B); PG8_STAGE(PG8_SA(1, 0), a3, A); \
            PG8_WAIT_V(8); PG8_WAIT_L(0); PG8_BAR; PG8_MMA(1, 0, At, B0); PG8_MMA(1, 1, At, B1); PG8_BAR; PG8_SCHED; } while (0)
        int t = 0;
        if constexpr (PEEL) { if (ui > 0) { PG8_TRIP(PG8_WAIT_VE); t = 2; } }
#pragma unroll 1
        for (; t < ntc; t += 2) PG8_TRIP(PG8_WAIT_V(8));
#undef PG8_TRIP
        if constexpr (ALIGN_EPI) { if (wr == 0) PG8_BAR; }
        { const int l_ = lane_id_opaque();
          if constexpr (Epi::LDSSCALE) E.run(acc, cur, wr, wc, l_ & 15, l_ >> 4, (const LAS float*)(lds + 8 * HTB + 4096 + (ui & 1) * 2048));
          else E(acc, cur, wr, wc, l_ & 15, l_ >> 4); }
        if (!has_next) break;
#pragma unroll
        for (int a = 0; a < 2; ++a)
#pragma unroll
            for (int b = 0; b < 2; ++b)
#pragma unroll
                for (int m = 0; m < 4; ++m)
#pragma unroll
                    for (int n = 0; n < 2; ++n) acc[a][b][m][n] = (f32x4){0.f, 0.f, 0.f, 0.f};
        cur = nxt; cA = nA; cB = nB; ++ui;
        if constexpr (ALIGN_EPI) { if (wr == 1) PG8_BAR; }
    }
    PG8_WAIT_V(0);
    if constexpr (!ALIGN_EPI) { if (wr == 0) PG8_BAR; }
    PG8_BAR;
#undef PG8_SA
#undef PG8_SB
#undef PG8_STAGE
#undef PG8_LDA
#undef PG8_LDB
#undef PG8_MMA
#undef PG8_CAT8
#undef PG8_WAIT_V
#undef PG8_WAIT_VE
#undef PG8_WAIT_L
#undef PG8_BAR
#undef PG8_SCHED
}
}
constexpr int BATCH = 8, SEQ = 4096, DM = 1024, MTOK = BATCH * SEQ;
constexpr int IN_COLS = 6568, IN_N = 6656;
constexpr int LAT_W = 512;
constexpr int QM_W = 768, KVM_W = 1024, UP_N = QM_W + KVM_W;
constexpr int BR_W = 512, Y3_W = 1536, GT_W = 3072;
constexpr int DFF = 2816, EFF = 3584, NEXP = 8;
constexpr int MOE_ROWS = (MTOK * 2 / 256 + NEXP) * 256;
constexpr int MOE_BLKS = MOE_ROWS / 256;
constexpr float RMS_EPS = 1e-6f;
constexpr float LOG2E = 1.4426950408889634f;
constexpr float C2_64 = 0.125f * LOG2E;
constexpr float C2_96 = 0.10206207261596577f * LOG2E;

typedef unsigned short bf16;
constexpr size_t MiB = 1u << 20;
constexpr size_t WS_CTL = 0, CTL_ZERO_BYTES = 1 * MiB;
#ifndef DENSE_DOWN_F8
#define DENSE_DOWN_F8 1
#endif
constexpr size_t WS_SMALL = 1 * MiB;
constexpr size_t OFF_SSQ = WS_SMALL;
constexpr size_t OFF_LOGF = OFF_SSQ + (size_t)MTOK * 8 * 4;
constexpr size_t OFF_CUM = OFF_LOGF + (size_t)MTOK * 8 * 4;
constexpr size_t OFF_KMEAN = OFF_CUM + (size_t)MTOK * 8 * 4;
constexpr size_t OFF_R64C = OFF_KMEAN + (size_t)BATCH * 16 * 512 * 4;
constexpr size_t OFF_R64S = OFF_R64C + (size_t)MTOK * 32 * 4;
constexpr size_t OFF_R32C = OFF_R64S + (size_t)MTOK * 32 * 4;
constexpr size_t OFF_R32S = OFF_R32C + (size_t)MTOK * 16 * 4;
constexpr size_t OFF_TOKI = OFF_R32S + (size_t)MTOK * 16 * 4;
constexpr size_t OFF_TOKW = OFF_TOKI + (size_t)MTOK * 16;
constexpr size_t OFF_TOKR = OFF_TOKW + (size_t)MTOK * 8;
constexpr size_t OFF_CNT = OFF_TOKR + (size_t)MTOK * 8;
constexpr size_t OFF_MTAB = OFF_CNT + 256 * 8 * 4;
constexpr size_t OFF_KNM = OFF_MTAB + 512 * 4;
constexpr size_t OFF_RSX = OFF_KNM + 256;
constexpr size_t OFF_RSG = OFF_RSX + (size_t)MTOK * 4;
constexpr size_t OFF_CSC = OFF_RSG + (size_t)MOE_ROWS * 4;
constexpr size_t OFF_CSIN = OFF_CSC + (size_t)2 * DFF * 4;
constexpr size_t OFF_RSIN = OFF_CSIN + (size_t)2 * IN_N * 4;
constexpr size_t OFF_CSE = OFF_RSIN + (size_t)MTOK * 4;
constexpr size_t OFF_WPRE = OFF_CSE + (size_t)8 * 2 * EFF * 4;
constexpr size_t OFF_SMALL_END = OFF_WPRE + (size_t)256 * 8 * 8 * 4;
constexpr size_t WS_W = 20 * MiB;
constexpr size_t W_IN_E = (size_t)IN_N * DM, W_UP_E = (size_t)UP_N * 256, W_BR_E = (size_t)DM * Y3_W, W_OUT_E = (size_t)DM * DM;
constexpr size_t W_LAYER_E = W_IN_E + W_UP_E + W_BR_E + W_OUT_E;
constexpr size_t OFF_WL = WS_W;
constexpr size_t OFF_WDGU = OFF_WL + 2 * W_LAYER_E * 2;
constexpr size_t OFF_WDDN = OFF_WDGU + (size_t)2 * DFF * DM * 2;
constexpr size_t OFF_WEGU = OFF_WDDN + (size_t)DM * DFF * 2;
constexpr size_t OFF_WEDN = OFF_WEGU + (size_t)NEXP * 2 * EFF * DM;
constexpr size_t OFF_W_END = OFF_WEDN + (size_t)NEXP * DM * EFF;
constexpr float W8S_GU = 1024.0f, W8S_DN = 2048.0f, A8S_ACT = 8.0f, A8_ROWMAX = 384.0f;
constexpr size_t WS_ACT = ((OFF_W_END + MiB - 1) / MiB) * MiB;
constexpr size_t OFF_XN = WS_ACT;
constexpr size_t OFF_QM = OFF_XN;
constexpr size_t OFF_LAT = OFF_XN + (size_t)MTOK * DM * 2;
constexpr size_t OFF_KR = OFF_LAT + (size_t)MTOK * LAT_W * 2;
constexpr size_t OFF_FQ = OFF_KR + (size_t)MTOK * 32 * 2;
constexpr size_t OFF_FK = OFF_FQ + (size_t)MTOK * BR_W * 2, OFF_FV = OFF_FK + (size_t)MTOK * BR_W * 2;
constexpr size_t OFF_MQ = OFF_FV + (size_t)MTOK * BR_W * 2, OFF_MK = OFF_MQ + (size_t)MTOK * BR_W * 2, OFF_MV = OFF_MK + (size_t)MTOK * BR_W * 2;
constexpr size_t OFF_GT = OFF_MV + (size_t)MTOK * BR_W * 2;
constexpr size_t OFF_KVM = OFF_GT + (size_t)MTOK * GT_W * 2;
constexpr size_t OFF_MERGED = OFF_KVM;
constexpr size_t OFF_Y3 = OFF_KVM + (size_t)MTOK * KVM_W * 2;
constexpr size_t OFF_XN8 = OFF_Y3;
constexpr size_t OFF_XS = OFF_Y3 + (size_t)MTOK * Y3_W * 2;
constexpr size_t OFF_ACT_END = OFF_XS + (size_t)MTOK * DM * 2;
constexpr size_t OFF_ACTD = OFF_LAT;
constexpr size_t OFF_XG = OFF_LAT;
constexpr size_t OFF_ACTM = OFF_XG + (size_t)MOE_ROWS * DM;
constexpr size_t OFF_YE = OFF_ACTM + (size_t)MOE_ROWS * EFF;
constexpr size_t OFF_MOE_END = OFF_YE + (size_t)MOE_ROWS * DM * 2;
constexpr size_t WS_NEED = OFF_ACT_END;
static_assert(OFF_SMALL_END <= WS_W, "small tables");
static_assert(OFF_ACTD + (size_t)MTOK * DFF * 2 <= OFF_KVM, "dense hidden overlay must not reach MERGED");
static_assert(OFF_MOE_END <= OFF_XN8, "MoE buffers must not reach XN8 (the gather reads it)");
constexpr int CW_BAR = 4096;

namespace pg8 {
struct EpiIn {
    static constexpr bool LDSSCALE = true; static constexpr bool MIDK = false; static constexpr int MID0 = -1, MID1 = -1; static constexpr int NVM = 16;
    unsigned char* ws; const float* bfg; const float* CS;
    __device__ __forceinline__ const float* cs_src(const Unit& u) const { return CS + u.pn * BM; }
    __device__ __forceinline__ const float* rs_src(const Unit& u) const { return (const float*)(ws + OFF_RSIN) + u.pm * BM; }
    __device__ __forceinline__ void run(Acc& acc, const Unit& u, int wr, int wc, int fr, int fq, const LAS float* sl) const {
        unsigned char* w = ws; asm volatile("" : "+s"(w));
        { f32x4 cs[2][2];
#pragma unroll
            for (int bj = 0; bj < 2; ++bj)
#pragma unroll
                for (int n = 0; n < 2; ++n) cs[bj][n] = *(const LAS f32x4*)(sl + bj * HALF + wc * 32 + 16 * n + 4 * fq);
#pragma unroll
            for (int ai = 0; ai < 2; ++ai)
#pragma unroll
                for (int m = 0; m < 4; ++m) { const float rs = sl[256 + wr * 64 + fr + ai * HALF + m * 16];
#pragma unroll
                    for (int bj = 0; bj < 2; ++bj)
#pragma unroll
                        for (int n = 0; n < 2; ++n) { const i32x4 iv = __builtin_bit_cast(i32x4, acc[ai][bj][m][n]);
                            acc[ai][bj][m][n] = (f32x4){(float)iv[0], (float)iv[1], (float)iv[2], (float)iv[3]} * (cs[bj][n] * rs); } } }
        bf16_t* LAT = (bf16_t*)(w + OFF_LAT); bf16_t* KR = (bf16_t*)(w + OFF_KR); bf16_t* FQ = (bf16_t*)(w + OFF_FQ); bf16_t* GT = (bf16_t*)(w + OFF_GT);
        float* LOGF = (float*)(w + OFF_LOGF); float* SSQ = (float*)(w + OFF_SSQ);
        const float* R64C = (const float*)(w + OFF_R64C); const float* R64S = (const float*)(w + OFF_R64S); const float* R32C = (const float*)(w + OFF_R32C); const float* R32S = (const float*)(w + OFF_R32S);
        const int pn = u.pn; const int row0 = u.pm * BM + wr * 64 + fr;
        if (pn == 0) {
#pragma unroll
            for (int ai = 0; ai < 2; ++ai)
#pragma unroll
                for (int m = 0; m < 4; ++m) { const int row = row0 + ai * HALF + m * 16; float s = 0.f;
#pragma unroll
                    for (int bj = 0; bj < 2; ++bj) { const f32x4 v0 = acc[ai][bj][m][0], v1 = acc[ai][bj][m][1];
                        s += (v0[0] * v0[0] + v0[1] * v0[1]) + (v0[2] * v0[2] + v0[3] * v0[3]) + (v1[0] * v1[0] + v1[1] * v1[1]) + (v1[2] * v1[2] + v1[3] * v1[3]);
                        *(u32x4*)(LAT + (size_t)row * LAT_W + bj * HALF + wc * 32 + 8 * fq) = pack8(v0, v1); }
                    s += __shfl_xor(s, 16); s += __shfl_xor(s, 32);
                    if (fq == 0) SSQ[(size_t)row * 8 + wc] = s; asm volatile("" ::: "memory"); }
        } else if (pn == 1) {
#pragma unroll
            for (int ai = 0; ai < 2; ++ai)
#pragma unroll
                for (int m = 0; m < 4; ++m) { const int row = row0 + ai * HALF + m * 16;
                    { const f32x4 v0 = acc[ai][0][m][0], v1 = acc[ai][0][m][1];
                      float s = (v0[0] * v0[0] + v0[1] * v0[1]) + (v0[2] * v0[2] + v0[3] * v0[3]) + (v1[0] * v1[0] + v1[1] * v1[1]) + (v1[2] * v1[2] + v1[3] * v1[3]);
                      *(u32x4*)(LAT + (size_t)row * LAT_W + 256 + wc * 32 + 8 * fq) = pack8(v0, v1);
                      s += __shfl_xor(s, 16); s += __shfl_xor(s, 32);
                      if (fq == 0) SSQ[(size_t)row * 8 + 4 + wc] = s; }
                    *(u32x4*)(LAT + (size_t)row * LAT_W + 384 + wc * 32 + 8 * fq) = (u32x4){0u, 0u, 0u, 0u};
                    if (wc == 0) {
                        const f32x4 x1 = acc[ai][1][m][0], x2 = acc[ai][1][m][1];
                        const f32x4 c = *(const f32x4*)(R32C + (size_t)row * 16 + 4 * fq), s = *(const f32x4*)(R32S + (size_t)row * 16 + 4 * fq);
                        *(u32x2*)(KR + (size_t)row * 32 + 4 * fq) = pack4(x1 * c - x2 * s);
                        *(u32x2*)(KR + (size_t)row * 32 + 16 + 4 * fq) = pack4(x2 * c + x1 * s);
                    } else if (wc == 1 && fq < 2) {
                        const f32x4 z = acc[ai][1][m][0] + *(const f32x4*)(bfg + 4 * fq); f32x4 o;
#pragma unroll
                        for (int j = 0; j < 4; ++j) o[j] = fminf(z[j], 0.f) - log1pf(__expf(-fabsf(z[j])));
                        *(f32x4*)(LOGF + (size_t)row * 8 + 4 * fq) = o; }
                    asm volatile("" ::: "memory"); }
        } else if (pn >= 8 && pn < 12) {
            bf16_t* dst = FQ + (size_t)(3 + ((pn - 8) >> 1)) * ((size_t)MTOK * BR_W); const float sc = (pn < 10) ? C2_64 : 1.0f; const int colt = ((pn - 8) & 1) * 256;
            const int i0 = 16 * (wc & 1) + 4 * fq;
#pragma unroll
            for (int ai = 0; ai < 2; ++ai)
#pragma unroll
                for (int m = 0; m < 4; ++m) { const int row = row0 + ai * HALF + m * 16;
                    const f32x4 c = *(const f32x4*)(R64C + (size_t)row * 32 + i0) * sc, s = *(const f32x4*)(R64S + (size_t)row * 32 + i0) * sc;
#pragma unroll
                    for (int bj = 0; bj < 2; ++bj) { const f32x4 x1 = acc[ai][bj][m][0], x2 = acc[ai][bj][m][1];
                        bf16_t* p = dst + (size_t)row * BR_W + colt + (2 * bj + (wc >> 1)) * 64 + i0;
                        *(u32x2*)p = pack4(x1 * c - x2 * s); *(u32x2*)(p + 32) = pack4(x2 * c + x1 * s); } asm volatile("" ::: "memory"); }
        } else {
            bf16_t* dst; int pitch, colt; float sc = 1.0f; const bool sig = pn >= 14;
            if (!sig) { const int bi = (pn - 2) >> 1; dst = FQ + (size_t)bi * ((size_t)MTOK * BR_W); pitch = BR_W; colt = (pn & 1) * 256; if (pn < 4) sc = C2_64; }
            else { dst = GT; pitch = GT_W; colt = (pn - 14) * 256; }
#pragma unroll
            for (int ai = 0; ai < 2; ++ai)
#pragma unroll
                for (int m = 0; m < 4; ++m) { const int row = row0 + ai * HALF + m * 16;
#pragma unroll
                    for (int bj = 0; bj < 2; ++bj) { f32x4 v0 = acc[ai][bj][m][0], v1 = acc[ai][bj][m][1];
                        if (sig) {
#pragma unroll
                            for (int j = 0; j < 4; ++j) { v0[j] = fmaxf(fast_sigmoid(v0[j]), 1e-7f); v1[j] = fmaxf(fast_sigmoid(v1[j]), 1e-7f); }
                        } else { v0 = v0 * sc; v1 = v1 * sc; }
                        __builtin_nontemporal_store(pack8(v0, v1), (u32x4*)(dst + (size_t)row * pitch + colt + bj * HALF + wc * 32 + 8 * fq)); } }
        }
    }
};

struct EpiUp {
    static constexpr bool LDSSCALE = false; static constexpr bool MIDK = false; static constexpr int MID0 = -1, MID1 = -1; static constexpr int NVM = 16;
    unsigned char* ws;
    __device__ __forceinline__ void operator()(const Acc& acc, const Unit& u, int wr, int wc, int fr, int fq) const {
        unsigned char* w = ws; asm volatile("" : "+s"(w));
        bf16_t* QM = (bf16_t*)(w + OFF_QM); bf16_t* KVM = (bf16_t*)(w + OFF_KVM); const float* SSQ = (const float*)(w + OFF_SSQ); const float* R32C = (const float*)(w + OFF_R32C); const float* R32S = (const float*)(w + OFF_R32S);
        const int pn = u.pn; const int row0 = u.pm * BM + wr * 64 + fr; const bool isq = pn < 3;
#pragma unroll
        for (int ai = 0; ai < 2; ++ai)
#pragma unroll
            for (int m = 0; m < 4; ++m) { const int row = row0 + ai * HALF + m * 16;
                const f32x4 ss = *(const f32x4*)(SSQ + (size_t)row * 8 + (isq ? 0 : 4));
                const float tot = (ss[0] + ss[1]) + (ss[2] + ss[3]);
                const float r = isq ? rsqrtf(tot * (1.0f / 256.0f) + RMS_EPS) * C2_96 : rsqrtf(tot * (1.0f / 128.0f) + RMS_EPS);
#pragma unroll
                for (int bj = 0; bj < 2; ++bj) { const f32x4 v0 = acc[ai][bj][m][0] * r, v1 = acc[ai][bj][m][1] * r;
                    if (isq) { const int g = 8 * pn + 4 * bj + wc;
                        if (g % 3 == 2) { const f32x4 c = *(const f32x4*)(R32C + (size_t)row * 16 + 4 * fq), s = *(const f32x4*)(R32S + (size_t)row * 16 + 4 * fq);
                            bf16_t* p = QM + (size_t)row * QM_W + g * 32 + 4 * fq;
                            *(u32x2*)p = pack4(v0 * c - v1 * s); *(u32x2*)(p + 16) = pack4(v1 * c + v0 * s);
                        } else __builtin_nontemporal_store(pack8(v0, v1), (u32x4*)(QM + (size_t)row * QM_W + g * 32 + 8 * fq));
                    } else __builtin_nontemporal_store(pack8(v0, v1), (u32x4*)(KVM + (size_t)row * KVM_W + (pn - 3) * 256 + bj * HALF + wc * 32 + 8 * fq)); } asm volatile("" ::: "memory"); }
    }
};

struct EpiMerge {
    static constexpr bool LDSSCALE = false; static constexpr bool MIDK = true; static constexpr int MID0 = 8, MID1 = 16; static constexpr int NVM = 16;
    const bf16_t* GT; bf16_t* OUT;
    __device__ __forceinline__ void mid(Acc& acc, const Unit& u, int t, int wr, int wc, int fr, int fq) const {
        const int nb = (t == MID0) ? 0 : 1; const bf16_t* gbase = GT + (size_t)(u.pm * BM + wr * 64 + fr) * GT_W + nb * DM + u.pn * BM + wc * 32 + 8 * fq;
#pragma unroll
        for (int ai = 0; ai < 2; ++ai) { u32x4 ga[4][2], gb[4][2];
#pragma unroll
            for (int m = 0; m < 4; ++m)
#pragma unroll
                for (int bj = 0; bj < 2; ++bj) { const bf16_t* gp = gbase + (size_t)(ai * HALF + m * 16) * GT_W + bj * HALF; ga[m][bj] = *(const u32x4*)gp; gb[m][bj] = *(const u32x4*)(gp + DM); }
#pragma unroll
            for (int m = 0; m < 4; ++m) {
#pragma unroll
                for (int bj = 0; bj < 2; ++bj)
#pragma unroll
                    for (int j = 0; j < 4; ++j) { const unsigned wa = ga[m][bj][j], wb = gb[m][bj][j]; const int n = j >> 1, e = (j & 1) * 2;
                        acc[ai][bj][m][n][e] *= bf_lo(wa) * __builtin_amdgcn_rcpf(bf_lo(wb)); acc[ai][bj][m][n][e + 1] *= bf_hi(wa) * __builtin_amdgcn_rcpf(bf_hi(wb)); }
                asm volatile("" : "+v"(acc[ai][0][m][0]), "+v"(acc[ai][0][m][1]), "+v"(acc[ai][1][m][0]), "+v"(acc[ai][1][m][1])); }
            asm volatile("" ::: "memory"); }
    }
    __device__ __forceinline__ void operator()(const Acc& acc, const Unit& u, int wr, int wc, int fr, int fq) const {
        const int row0 = u.pm * BM + wr * 64 + fr; const int col0 = u.pn * BM + wc * 32 + 8 * fq;
#pragma unroll
        for (int ai = 0; ai < 2; ++ai) { u32x4 g[4][2];
#pragma unroll
            for (int m = 0; m < 4; ++m)
#pragma unroll
                for (int bj = 0; bj < 2; ++bj) g[m][bj] = *(const u32x4*)(GT + (size_t)(row0 + ai * HALF + m * 16) * GT_W + 2 * DM + col0 + bj * HALF);
#pragma unroll
            for (int m = 0; m < 4; ++m) { const int row = row0 + ai * HALF + m * 16;
#pragma unroll
                for (int bj = 0; bj < 2; ++bj) { const u32x4 gg = g[m][bj]; f32x4 v0 = acc[ai][bj][m][0], v1 = acc[ai][bj][m][1];
                    v0[0] *= bf_lo(gg[0]); v0[1] *= bf_hi(gg[0]); v0[2] *= bf_lo(gg[1]); v0[3] *= bf_hi(gg[1]); v1[0] *= bf_lo(gg[2]); v1[1] *= bf_hi(gg[2]); v1[2] *= bf_lo(gg[3]); v1[3] *= bf_hi(gg[3]);
                    *(u32x4*)(OUT + (size_t)row * DM + col0 + bj * HALF) = pack8(v0, v1); } }
            asm volatile("" ::: "memory"); }
    }
};

struct EpiResid {
    static constexpr bool LDSSCALE = false; static constexpr bool MIDK = false; static constexpr int MID0 = -1, MID1 = -1; static constexpr int NVM = 0;
    const float* base; float* out;
    __device__ __forceinline__ void operator()(const Acc& acc, const Unit& u, int wr, int wc, int fr, int fq) const {
        const int row0 = u.pm * BM + wr * 64 + fr; const int col0 = u.pn * BM + wc * 32 + 4 * fq;
#pragma unroll
        for (int ai = 0; ai < 2; ++ai)
#pragma unroll
            for (int m = 0; m < 4; ++m) { const size_t off = (size_t)(row0 + ai * HALF + m * 16) * DM + col0;
#pragma unroll
                for (int bj = 0; bj < 2; ++bj)
#pragma unroll
                    for (int n = 0; n < 2; ++n) { const f32x4 b = *(const f32x4*)(base + off + bj * HALF + n * 16); *(f32x4*)(out + off + bj * HALF + n * 16) = b + acc[ai][bj][m][n]; } asm volatile("" ::: "memory"); }
    }
};

template <bool BASE32> struct EpiResidB {
    static constexpr bool LDSSCALE = false; static constexpr bool MIDK = false; static constexpr int MID0 = -1, MID1 = -1; static constexpr int NVM = 16;
    const void* base; bf16_t* out; float sc;
    __device__ __forceinline__ void operator()(const Acc& acc, const Unit& u, int wr, int wc, int fr, int fq) const {
        const size_t off0 = (size_t)(u.pm * BM + wr * 64 + fr) * DM + u.pn * BM + wc * 32 + 8 * fq;
        if constexpr (BASE32) {
#pragma unroll
            for (int ai = 0; ai < 2; ++ai) { f32x4 b[4][2][2];
#pragma unroll
                for (int m = 0; m < 4; ++m)
#pragma unroll
                    for (int bj = 0; bj < 2; ++bj) { const float* bp = (const float*)base + off0 + (size_t)(ai * HALF + m * 16) * DM + bj * HALF; b[m][bj][0] = *(const f32x4*)bp; b[m][bj][1] = *(const f32x4*)(bp + 4); }
#pragma unroll
                for (int m = 0; m < 4; ++m)
#pragma unroll
                    for (int bj = 0; bj < 2; ++bj) *(u32x4*)(out + off0 + (size_t)(ai * HALF + m * 16) * DM + bj * HALF) = pack8(b[m][bj][0] + acc[ai][bj][m][0] * sc, b[m][bj][1] + acc[ai][bj][m][1] * sc);
                asm volatile("" ::: "memory"); }
        } else {
            u32x4 w[2][4][2];
#pragma unroll
            for (int ai = 0; ai < 2; ++ai)
#pragma unroll
                for (int m = 0; m < 4; ++m)
#pragma unroll
                    for (int bj = 0; bj < 2; ++bj) w[ai][m][bj] = *(const u32x4*)((const bf16_t*)base + off0 + (size_t)(ai * HALF + m * 16) * DM + bj * HALF);
            asm volatile("" ::: "memory");
#pragma unroll
            for (int ai = 0; ai < 2; ++ai)
#pragma unroll
                for (int m = 0; m < 4; ++m) {
#pragma unroll
                    for (int bj = 0; bj < 2; ++bj) { const u32x4 ww = w[ai][m][bj]; const f32x4 b0 = {bf_lo(ww.x), bf_hi(ww.x), bf_lo(ww.y), bf_hi(ww.y)}, b1 = {bf_lo(ww.z), bf_hi(ww.z), bf_lo(ww.w), bf_hi(ww.w)};
                        *(u32x4*)(out + off0 + (size_t)(ai * HALF + m * 16) * DM + bj * HALF) = pack8(b0 + acc[ai][bj][m][0] * sc, b1 + acc[ai][bj][m][1] * sc); }
                    asm volatile("" ::: "memory"); }
        }
    }
};
struct EpiSwiglu {
    static constexpr bool LDSSCALE = false; static constexpr bool MIDK = false; static constexpr int MID0 = -1, MID1 = -1; static constexpr int NVM = 0;
    bf16_t* ACT; int pitch;
    __device__ __forceinline__ void operator()(const Acc& acc, const Unit& u, int wr, int wc, int fr, int fq) const {
        const int row0 = u.pm * BM + wr * 64 + fr; const int col = u.pn * HALF + wc * 32 + 8 * fq;
#pragma unroll
        for (int ai = 0; ai < 2; ++ai)
#pragma unroll
            for (int m = 0; m < 4; ++m) { f32x4 o[2];
#pragma unroll
                for (int n = 0; n < 2; ++n)
#pragma unroll
                    for (int j = 0; j < 4; ++j) { const float gv = acc[ai][0][m][n][j], uv = acc[ai][1][m][n][j]; o[n][j] = gv * fast_sigmoid(gv) * uv; }
                *(u32x4*)(ACT + (size_t)(row0 + ai * HALF + m * 16) * pitch + col) = pack8(o[0], o[1]); }
    }
};

struct EpiSwigluB8 {
    static constexpr bool LDSSCALE = false; static constexpr bool MIDK = false; static constexpr int MID0 = -1, MID1 = -1; static constexpr int NVM = 0;
    unsigned char* ACT; int pitch;
    __device__ __forceinline__ void operator()(const Acc& acc, const Unit& u, int wr, int wc, int fr, int fq) const {
        const int row0 = u.pm * BM + wr * 64 + fr; const int col = u.pn * HALF + wc * 32 + 8 * fq;
#pragma unroll
        for (int ai = 0; ai < 2; ++ai)
#pragma unroll
            for (int m = 0; m < 4; ++m) { float o[8];
#pragma unroll
                for (int n = 0; n < 2; ++n)
#pragma unroll
                    for (int j = 0; j < 4; ++j) { const float gv = acc[ai][0][m][n][j], uv = acc[ai][1][m][n][j]; o[4 * n + j] = gv * fast_sigmoid(gv) * uv * A8S_ACT; }
                u32x2 w; w.x = pk4_f8(o[0], o[1], o[2], o[3]); w.y = pk4_f8(o[4], o[5], o[6], o[7]);
                *(u32x2*)(ACT + (size_t)(row0 + ai * HALF + m * 16) * pitch + col) = w; }
    }
};
struct SwigluI8Core {
    __device__ static __forceinline__ f32x2 pair(int g0, int g1, int u0, int u1, f32x2 cg, f32x2 cu, float a, float irs2) {
        const f32x2 t = (f32x2){(float)g0, (float)g1} * cg, w = (f32x2){(float)u0, (float)u1} * cu, ar = t * (f32x2){a, a};
        const f32x2 e = {__builtin_amdgcn_exp2f(ar.x), __builtin_amdgcn_exp2f(ar.y)};
        const f32x2 d = e * (f32x2){irs2, irs2} + (f32x2){irs2, irs2};
        const f32x2 r = {__builtin_amdgcn_rcpf(d.x), __builtin_amdgcn_rcpf(d.y)};
        return (t * w) * r; }
};
struct EpiSwigluI8 {
    static constexpr bool LDSSCALE = true; static constexpr bool MIDK = false; static constexpr int MID0 = -1, MID1 = -1; static constexpr int NVM = 8;
    unsigned char* ACT; int pitch; const float* RS; const float* CS;
    __device__ __forceinline__ const float* cs_src(const Unit& u) const { return CS + u.bt * BM; }
    __device__ __forceinline__ const float* rs_src(const Unit& u) const { return RS + u.pm * BM; }
    __device__ __forceinline__ void run(const Acc& acc, const Unit& u, int wr, int wc, int fr, int fq, const LAS float* sl) const {
        const int row0 = u.pm * BM + wr * 64 + fr; const int col = u.pn * HALF + wc * 32 + 8 * fq;
        f32x4 cg[2], cu[2]; float rsv[8];
#pragma unroll
        for (int n = 0; n < 2; ++n) { cg[n] = *(const LAS f32x4*)(sl + wc * 32 + 16 * n + 4 * fq); cu[n] = *(const LAS f32x4*)(sl + HALF + wc * 32 + 16 * n + 4 * fq) * A8S_ACT; }
#pragma unroll
        for (int i = 0; i < 8; ++i) rsv[i] = sl[256 + wr * 64 + fr + (i >> 2) * HALF + (i & 3) * 16];
#pragma unroll
        for (int ai = 0; ai < 2; ++ai)
#pragma unroll
            for (int m = 0; m < 4; ++m) { const int row = row0 + ai * HALF + m * 16; const float rs = rsv[ai * 4 + m]; const float a = rs * -1.4426950408889634f, irs2 = __builtin_amdgcn_rcpf(rs * rs); u32x2 w;
#pragma unroll
                for (int n = 0; n < 2; ++n) { const i32x4 ig = __builtin_bit_cast(i32x4, acc[ai][0][m][n]), iu = __builtin_bit_cast(i32x4, acc[ai][1][m][n]);
                    const f32x2 o0 = SwigluI8Core::pair(ig[0], ig[1], iu[0], iu[1], (f32x2){cg[n][0], cg[n][1]}, (f32x2){cu[n][0], cu[n][1]}, a, irs2);
                    const f32x2 o1 = SwigluI8Core::pair(ig[2], ig[3], iu[2], iu[3], (f32x2){cg[n][2], cg[n][3]}, (f32x2){cu[n][2], cu[n][3]}, a, irs2);
                    w[n] = pk4_f8(o0.x, o0.y, o1.x, o1.y); }
                *(u32x2*)(ACT + (size_t)row * pitch + col) = w; asm volatile("" ::: "memory"); }
    }
};
struct EpiSwigluI8B {
    static constexpr bool LDSSCALE = true; static constexpr bool MIDK = false; static constexpr int MID0 = -1, MID1 = -1; static constexpr int NVM = 8;
    bf16_t* ACT; int pitch; const float* RS; const float* CS;
    __device__ __forceinline__ const float* cs_src(const Unit& u) const { return CS + u.bt * BM; }
    __device__ __forceinline__ const float* rs_src(const Unit& u) const { return RS + u.pm * BM; }
    __device__ __forceinline__ void run(const Acc& acc, const Unit& u, int wr, int wc, int fr, int fq, const LAS float* sl) const {
        const int row0 = u.pm * BM + wr * 64 + fr; const int col = u.pn * HALF + wc * 32 + 8 * fq;
        f32x4 cg[2], cu[2]; float rsv[8];
#pragma unroll
        for (int n = 0; n < 2; ++n) { cg[n] = *(const LAS f32x4*)(sl + wc * 32 + 16 * n + 4 * fq); cu[n] = *(const LAS f32x4*)(sl + HALF + wc * 32 + 16 * n + 4 * fq); }
#pragma unroll
        for (int i = 0; i < 8; ++i) rsv[i] = sl[256 + wr * 64 + fr + (i >> 2) * HALF + (i & 3) * 16];
#pragma unroll
        for (int ai = 0; ai < 2; ++ai)
#pragma unroll
            for (int m = 0; m < 4; ++m) { const int row = row0 + ai * HALF + m * 16; const float rs = rsv[ai * 4 + m]; const float a = rs * -1.4426950408889634f, irs2 = __builtin_amdgcn_rcpf(rs * rs); f32x4 o[2];
#pragma unroll
                for (int n = 0; n < 2; ++n) { const i32x4 ig = __builtin_bit_cast(i32x4, acc[ai][0][m][n]), iu = __builtin_bit_cast(i32x4, acc[ai][1][m][n]);
                    const f32x2 o0 = SwigluI8Core::pair(ig[0], ig[1], iu[0], iu[1], (f32x2){cg[n][0], cg[n][1]}, (f32x2){cu[n][0], cu[n][1]}, a, irs2);
                    const f32x2 o1 = SwigluI8Core::pair(ig[2], ig[3], iu[2], iu[3], (f32x2){cg[n][2], cg[n][3]}, (f32x2){cu[n][2], cu[n][3]}, a, irs2);
                    o[n] = (f32x4){o0.x, o0.y, o1.x, o1.y}; }
                *(u32x4*)(ACT + (size_t)row * pitch + col) = pack8(o[0], o[1]); asm volatile("" ::: "memory"); }
    }
};
struct EpiSwiglu8 {
    static constexpr bool LDSSCALE = false; static constexpr bool MIDK = false; static constexpr int MID0 = -1, MID1 = -1; static constexpr int NVM = 0;
    unsigned char* ACT; int pitch; const float* RS;
    __device__ __forceinline__ void operator()(const Acc& acc, const Unit& u, int wr, int wc, int fr, int fq) const {
        const int row0 = u.pm * BM + wr * 64 + fr; const int col = u.pn * HALF + wc * 32 + 8 * fq;
        float rsv[8];
#pragma unroll
        for (int i = 0; i < 8; ++i) rsv[i] = RS[row0 + (i >> 2) * HALF + (i & 3) * 16];
#pragma unroll
        for (int ai = 0; ai < 2; ++ai)
#pragma unroll
            for (int m = 0; m < 4; ++m) { const int row = row0 + ai * HALF + m * 16; const float rs = rsv[ai * 4 + m] * (1.0f / W8S_GU); float o[8];
#pragma unroll
                for (int n = 0; n < 2; ++n)
#pragma unroll
                    for (int j = 0; j < 4; ++j) { const float gv = acc[ai][0][m][n][j] * rs, uv = acc[ai][1][m][n][j] * rs; o[4 * n + j] = gv * fast_sigmoid(gv) * uv * A8S_ACT; }
                u32x2 w; w.x = pk4_f8(o[0], o[1], o[2], o[3]); w.y = pk4_f8(o[4], o[5], o[6], o[7]);
                *(u32x2*)(ACT + (size_t)row * pitch + col) = w; asm volatile("" ::: "memory"); }
    }
};
struct EpiNull {
    static constexpr bool LDSSCALE = false; static constexpr bool MIDK = false; static constexpr int MID0 = -1, MID1 = -1; static constexpr int NVM = 0;
    __device__ __forceinline__ void operator()(const Acc& acc, const Unit& u, int wr, int wc, int fr, int fq) const {
#pragma unroll
        for (int a = 0; a < 2; ++a)
#pragma unroll
            for (int b = 0; b < 2; ++b)
#pragma unroll
                for (int m = 0; m < 4; ++m)
#pragma unroll
                    for (int n = 0; n < 2; ++n) asm volatile("" :: "v"(acc[a][b][m][n]));
    }
};
struct EpiResid8 {
    static constexpr bool LDSSCALE = false; static constexpr bool MIDK = false; static constexpr int MID0 = -1, MID1 = -1; static constexpr int NVM = 0;
    const float* base; float* out; float sc;
    __device__ __forceinline__ void operator()(const Acc& acc, const Unit& u, int wr, int wc, int fr, int fq) const {
        const int row0 = u.pm * BM + wr * 64 + fr; const int col0 = u.pn * BM + wc * 32 + 4 * fq;
#pragma unroll
        for (int ai = 0; ai < 2; ++ai)
#pragma unroll
            for (int m = 0; m < 4; ++m) { const size_t off = (size_t)(row0 + ai * HALF + m * 16) * DM + col0;
#pragma unroll
                for (int bj = 0; bj < 2; ++bj)
#pragma unroll
                    for (int n = 0; n < 2; ++n) { const f32x4 b = *(const f32x4*)(base + off + bj * HALF + n * 16); *(f32x4*)(out + off + bj * HALF + n * 16) = b + acc[ai][bj][m][n] * sc; } asm volatile("" ::: "memory"); }
    }
};
struct EpiBf8 {
    static constexpr bool LDSSCALE = false; static constexpr bool MIDK = false; static constexpr int MID0 = -1, MID1 = -1; static constexpr int NVM = 16;
    bf16_t* OUT; int pitch; float sc;
    __device__ __forceinline__ void operator()(const Acc& acc, const Unit& u, int wr, int wc, int fr, int fq) const {
        const int row0 = u.pm * BM + wr * 64 + fr;
#pragma unroll
        for (int ai = 0; ai < 2; ++ai)
#pragma unroll
            for (int m = 0; m < 4; ++m)
#pragma unroll
                for (int bj = 0; bj < 2; ++bj) *(u32x4*)(OUT + (size_t)(row0 + ai * HALF + m * 16) * pitch + u.pn * BM + bj * HALF + wc * 32 + 8 * fq) = pack8(acc[ai][bj][m][0] * sc, acc[ai][bj][m][1] * sc);
    }
};
struct EpiBf8K {
    static constexpr bool LDSSCALE = false; static constexpr bool MIDK = false; static constexpr int MID0 = -1, MID1 = -1; static constexpr int NVM = 16;
    bf16_t* OUT; float* PART; float sc;
    __device__ __forceinline__ void operator()(const Acc& acc, const Unit& u, int wr, int wc, int fr, int fq) const {
        const int r0 = wr * 64 + fr; const int col = u.pn * BM + wc * 32 + 8 * fq;
        if (u.ks < 0) {
#pragma unroll
            for (int ai = 0; ai < 2; ++ai)
#pragma unroll
                for (int m = 0; m < 4; ++m)
#pragma unroll
                    for (int bj = 0; bj < 2; ++bj) *(u32x4*)(OUT + (size_t)(u.pm * BM + r0 + ai * HALF + m * 16) * DM + col + bj * HALF) = pack8(acc[ai][bj][m][0] * sc, acc[ai][bj][m][1] * sc);
        } else { float* pb = PART + (size_t)(((u.pm - 256) * 7 + u.ks) * 256 + r0) * DM + col;
#pragma unroll
            for (int ai = 0; ai < 2; ++ai)
#pragma unroll
                for (int m = 0; m < 4; ++m)
#pragma unroll
                    for (int bj = 0; bj < 2; ++bj) { float* q = pb + (size_t)(ai * HALF + m * 16) * DM + bj * HALF; *(f32x4*)q = acc[ai][bj][m][0] * sc; *(f32x4*)(q + 4) = acc[ai][bj][m][1] * sc; } }
    }
};
}
namespace att {
using bf16 = __hip_bfloat16;
using bf16x8 = __attribute__((ext_vector_type(8))) short;
using s16x4 = __attribute__((ext_vector_type(4))) short;
using f32x16 = __attribute__((ext_vector_type(16))) float;
using f32x4 = __attribute__((ext_vector_type(4))) float;
using f32x2 = __attribute__((ext_vector_type(2))) float;
using u32x4 = __attribute__((ext_vector_type(4))) unsigned;
typedef LAS const char* lds_cptr;
typedef LAS char* lds_ptr;
constexpr int NW = 8, QBLK = 32, QB = QBLK * NW, KVBLK = 64, NQB = SEQ / QB, NSLOT = 3;
constexpr int KSLOT = 12288, VSLOT = 8192;
constexpr int LDS_K = 0, LDS_V = NSLOT * KSLOT, LDS_CB = LDS_V + NSLOT * VSLOT, LDS_KM = LDS_CB + SEQ * 4, LDS_WS = LDS_KM + 8192, LDS_OST = LDS_WS + NW * 64 * 4, LDS_BYTES = LDS_OST + NW * 4096;
static_assert(LDS_BYTES <= 131072, "attention LDS");
constexpr float NEGBIG = -1.0e30f;
constexpr float THR = 8.0f;
#define SBAR() __builtin_amdgcn_sched_barrier(0)
__device__ __forceinline__ int crow(int r, int hi) { return (r & 3) + 8 * (r >> 2) + 4 * hi; }
__device__ __forceinline__ void glds16(const void* gsrc, unsigned lds_dst) { unsigned keep;
    asm volatile("s_mov_b32 %0, m0\n\ts_mov_b32 m0, %2\n\ts_nop 0\n\tglobal_load_lds_dwordx4 %1, off\n\ts_mov_b32 m0, %0" : "=&s"(keep) : "v"(gsrc), "s"(lds_dst) : "memory"); }
typedef float f32x2_t __attribute__((ext_vector_type(2))); typedef __bf16 bf16x2_t __attribute__((ext_vector_type(2)));
__device__ __forceinline__ unsigned cvtpk_s(float lo, float hi) { f32x2_t v = {lo, hi}; bf16x2_t b = __builtin_convertvector(v, bf16x2_t); return __builtin_bit_cast(unsigned, b); }
#define WAIT_BAR(N) asm volatile("s_waitcnt vmcnt(" #N ") lgkmcnt(0)\n\ts_barrier" ::: "memory")

struct Args { const bf16* Q; const bf16* K; const bf16* KR; const bf16* V; bf16* O; const float* CUM; const float* KMEAN; int qpitch, kpitch, vpitch, opitch, qhs, khs; };

template <int ND> __device__ __forceinline__ void qkt(f32x16& p0, f32x16& p1, lds_cptr kb, const bf16x8* qr, const f32x16& cin) {
#pragma unroll
    for (int d0 = 0; d0 < ND; ++d0) {
        const bf16x8 b0 = *(const LAS bf16x8*)(kb + d0 * 2048); const bf16x8 b1 = *(const LAS bf16x8*)(kb + d0 * 2048 + 512);
        if (d0 == 0) { p0 = __builtin_amdgcn_mfma_f32_32x32x16_bf16(b0, qr[0], cin, 0, 0, 0); p1 = __builtin_amdgcn_mfma_f32_32x32x16_bf16(b1, qr[0], cin, 0, 0, 0); }
        else { p0 = __builtin_amdgcn_mfma_f32_32x32x16_bf16(b0, qr[d0], p0, 0, 0, 0); p1 = __builtin_amdgcn_mfma_f32_32x32x16_bf16(b1, qr[d0], p1, 0, 0, 0); } }
}
__device__ __forceinline__ float rowmax(const f32x16& p0, const f32x16& p1) {
    float a = fmaxf(fmaxf(p0[0], p0[1]), p1[0]), b = fmaxf(fmaxf(p0[2], p0[3]), p1[1]); a = fmaxf(fmaxf(a, p1[2]), p1[3]);
#pragma unroll
    for (int r = 4; r < 16; r += 4) { a = fmaxf(fmaxf(a, p0[r]), p0[r + 1]); b = fmaxf(fmaxf(b, p0[r + 2]), p0[r + 3]); a = fmaxf(fmaxf(a, p1[r]), p1[r + 1]); b = fmaxf(fmaxf(b, p1[r + 2]), p1[r + 3]); }
    const float m = fmaxf(a, b);
    auto rr = __builtin_amdgcn_permlane32_swap(__float_as_uint(m), __float_as_uint(m), false, false);
    return fmaxf(__uint_as_float(rr[0]), __uint_as_float(rr[1]));
}
struct VFrag { s16x4 lo[2][4], hi[2][4]; };
__device__ __forceinline__ void pv_issue(VFrag& f, int vb) {
#pragma unroll
    for (int d0 = 0; d0 < 2; ++d0)
#pragma unroll
        for (int ks = 0; ks < 4; ++ks) {
            asm volatile("ds_read_b64_tr_b16 %0,%1 offset:%c2" : "=&v"(f.lo[d0][ks]) : "v"(vb), "i"(d0 * 4096 + ks * 1024) : "memory");
            asm volatile("ds_read_b64_tr_b16 %0,%1 offset:%c2" : "=&v"(f.hi[d0][ks]) : "v"(vb), "i"(d0 * 4096 + ks * 1024 + 512) : "memory"); }
}
__device__ __forceinline__ void pv_mma(f32x16& o0, f32x16& o1, f32x16& o2, VFrag& f, bf16x8 pa0, bf16x8 pa1, bf16x8 pa2, bf16x8 pa3) {
    asm volatile("s_waitcnt lgkmcnt(0)" : "+v"(f.lo[0][0]), "+v"(f.lo[0][1]), "+v"(f.lo[0][2]), "+v"(f.lo[0][3]), "+v"(f.hi[0][0]), "+v"(f.hi[0][1]), "+v"(f.hi[0][2]), "+v"(f.hi[0][3]),
                 "+v"(f.lo[1][0]), "+v"(f.lo[1][1]), "+v"(f.lo[1][2]), "+v"(f.lo[1][3]), "+v"(f.hi[1][0]), "+v"(f.hi[1][1]), "+v"(f.hi[1][2]), "+v"(f.hi[1][3]) :: "memory");
#define PK(d, k) (bf16x8){f.lo[d][k][0], f.lo[d][k][1], f.lo[d][k][2], f.lo[d][k][3], f.hi[d][k][0], f.hi[d][k][1], f.hi[d][k][2], f.hi[d][k][3]}
    o0 = __builtin_amdgcn_mfma_f32_32x32x16_bf16(pa0, PK(0, 0), o0, 0, 0, 0); o1 = __builtin_amdgcn_mfma_f32_32x32x16_bf16(pa0, PK(1, 0), o1, 0, 0, 0);
    o0 = __builtin_amdgcn_mfma_f32_32x32x16_bf16(pa1, PK(0, 1), o0, 0, 0, 0); o1 = __builtin_amdgcn_mfma_f32_32x32x16_bf16(pa1, PK(1, 1), o1, 0, 0, 0);
    o0 = __builtin_amdgcn_mfma_f32_32x32x16_bf16(pa2, PK(0, 2), o0, 0, 0, 0); o1 = __builtin_amdgcn_mfma_f32_32x32x16_bf16(pa2, PK(1, 2), o1, 0, 0, 0);
    o0 = __builtin_amdgcn_mfma_f32_32x32x16_bf16(pa3, PK(0, 3), o0, 0, 0, 0); o1 = __builtin_amdgcn_mfma_f32_32x32x16_bf16(pa3, PK(1, 3), o1, 0, 0, 0);
#undef PK
    const bf16x8 ones = {0x3F80, 0x3F80, 0x3F80, 0x3F80, 0x3F80, 0x3F80, 0x3F80, 0x3F80};
    o2 = __builtin_amdgcn_mfma_f32_32x32x16_bf16(pa0, ones, o2, 0, 0, 0);
    o2 = __builtin_amdgcn_mfma_f32_32x32x16_bf16(pa1, ones, o2, 0, 0, 0);
    o2 = __builtin_amdgcn_mfma_f32_32x32x16_bf16(pa2, ones, o2, 0, 0, 0);
    o2 = __builtin_amdgcn_mfma_f32_32x32x16_bf16(pa3, ones, o2, 0, 0, 0);
}

template <int VAR, bool FIRST, bool BAND>
__device__ __forceinline__ void tile_step(f32x16& o0, f32x16& o1, f32x16& o2, float& mhat, const bf16x8* qr, lds_cptr kb, int vb, LAS float* wsf, lds_cptr cbp, bool take, int jb, int qrel, int hi, int r32) {
    constexpr int ND = (VAR == 0) ? 6 : 4;
    f32x16 cin; { const float c0 = (VAR == 2 && !BAND && !take) ? NEGBIG : -mhat;
#pragma unroll
        for (int r = 0; r < 16; ++r) cin[r] = c0; }
    f32x16 p0, p1; qkt<ND>(p0, p1, kb, qr, cin);
    if (VAR == 1) {
#pragma unroll
        for (int j = 0; j < 4; ++j) { const f32x4 b0 = *(const LAS f32x4*)(cbp + j * 32), b1 = *(const LAS f32x4*)(cbp + 128 + j * 32);
#pragma unroll
            for (int e = 0; e < 4; ++e) { p0[4 * j + e] += b0[e]; p1[4 * j + e] += b1[e]; } } }
    VFrag vf; pv_issue(vf, vb);
    if (BAND) { const int kb0 = 64 * jb + 4 * hi;
#pragma unroll
        for (int r = 0; r < 16; ++r) { const int kv = kb0 + (r & 3) + 8 * (r >> 2); if (kv > qrel) p0[r] = NEGBIG; if (kv + 32 > qrel) p1[r] = NEGBIG; } }
    const float rm = rowmax(p0, p1);
    if (FIRST) { mhat = rm;
#pragma unroll
        for (int r = 0; r < 16; ++r) { p0[r] -= rm; p1[r] -= rm; }
    } else if (__builtin_amdgcn_ballot_w64(rm > THR) != 0ull) {
        const float dl = fmaxf(rm, 0.f); mhat += dl;
#pragma unroll
        for (int r = 0; r < 16; ++r) { p0[r] -= dl; p1[r] -= dl; }
        const float f = __builtin_amdgcn_exp2f(-dl); if (hi == 0) wsf[r32] = f;
#pragma unroll
        for (int j = 0; j < 4; ++j) { const f32x4 fv = *(const LAS f32x4*)(wsf + 8 * j + 4 * hi);
#pragma unroll
            for (int e = 0; e < 4; ++e) { o0[4 * j + e] *= fv[e]; o1[4 * j + e] *= fv[e]; o2[4 * j + e] *= fv[e]; } }
    }
#pragma unroll
    for (int r = 0; r < 16; ++r) { p0[r] = __builtin_amdgcn_exp2f(p0[r]); p1[r] = __builtin_amdgcn_exp2f(p1[r]); }
    u32x4 pw0, pw1, pw2, pw3;
#define PKW(P, B) cvtpk_s(P[B], P[B + 1])
    pw0 = (u32x4){PKW(p0, 0), PKW(p0, 2), PKW(p0, 4), PKW(p0, 6)}; pw1 = (u32x4){PKW(p0, 8), PKW(p0, 10), PKW(p0, 12), PKW(p0, 14)};
    pw2 = (u32x4){PKW(p1, 0), PKW(p1, 2), PKW(p1, 4), PKW(p1, 6)}; pw3 = (u32x4){PKW(p1, 8), PKW(p1, 10), PKW(p1, 12), PKW(p1, 14)};
#undef PKW
    pv_mma(o0, o1, o2, vf, __builtin_bit_cast(bf16x8, pw0), __builtin_bit_cast(bf16x8, pw1), __builtin_bit_cast(bf16x8, pw2), __builtin_bit_cast(bf16x8, pw3));
}

template <int VAR>
__device__ __forceinline__ void attn_unit(int b, int h, int qb, const Args& A, char* shm, int wid) {
    constexpr int DK = (VAR == 0) ? 96 : 64, ND = DK / 16;
    const int lane = pg8::lane_id_opaque(), tid = wid * 64 + lane, r32 = lane & 31, hi = lane >> 5;
    const long rowbase = (long)b * SEQ; const int q0 = qb * QB;
    const unsigned lds0 = (unsigned)(uintptr_t)shm;
    const lds_cptr shm3 = (lds_cptr)shm;
    LAS float* wsf = (LAS float*)((lds_ptr)shm + LDS_WS) + wid * 64;
    const bf16* Qw = A.Q + (rowbase + q0 + wid * QBLK) * A.qpitch + h * A.qhs;
    const bf16* Kh = A.K + rowbase * A.kpitch + h * A.khs; const bf16* Vh = A.V + rowbase * A.vpitch + h * A.khs;
    const int NT = (q0 + QB) / KVBLK;
    bf16x8 qr[ND];
#pragma unroll
    for (int d0 = 0; d0 < ND; ++d0) qr[d0] = *reinterpret_cast<const bf16x8*>(&Qw[(long)r32 * A.qpitch + d0 * 16 + hi * 8]);
    const bf16* ksrc = Kh + (long)lane * A.kpitch + wid * 8;
    const bf16* ksrc2 = (VAR == 0) ? A.KR + (rowbase + lane) * 32 + (wid & 3) * 8 : nullptr;
    const bf16* vsrc = Vh + (long)(16 * (wid & 3) + (lane >> 2)) * A.vpitch + (wid >> 2) * 32 + (lane & 3) * 8;
    const unsigned kdst = lds0 + LDS_K + wid * 1024, kdst2 = lds0 + LDS_K + (8 + (wid & 3)) * 1024, vdst = lds0 + LDS_V + wid * 1024;
#define DMA_T(t, sl) do { glds16(ksrc + (long)(t) * KVBLK * A.kpitch, (unsigned)__builtin_amdgcn_readfirstlane(kdst + (sl) * KSLOT)); \
        if (VAR == 0) glds16(ksrc2 + (long)(t) * KVBLK * 32, (unsigned)__builtin_amdgcn_readfirstlane(kdst2 + (sl) * KSLOT)); \
        glds16(vsrc + (long)(t) * KVBLK * A.vpitch, (unsigned)__builtin_amdgcn_readfirstlane(vdst + (sl) * VSLOT)); } while (0)
#define TILE_OF(i) (((i) < 4) ? (NT - 4 + (i)) : (NT - 1 - (i)))
    if (VAR == 1) { const float* cu = A.CUM + ((long)b * 8 + h) * SEQ; const float c0 = cu[q0]; const int nk = q0 + QB; LAS float* CB = (LAS float*)((lds_ptr)shm + LDS_CB);
        for (int s = tid; s < nk; s += NW * 64) CB[s] = (c0 - cu[s]) * LOG2E; }
    if (VAR == 2) { const int idx = tid * 2, blk = idx >> 6, d = idx & 63; const f32x2 km = *(const f32x2*)(A.KMEAN + ((long)b * 16 + blk) * 512 + h * 64 + d);
        *(LAS unsigned*)((lds_ptr)shm + LDS_KM + (d >> 3) * 1024 + blk * 16 + (d & 7) * 2) = cvtpk_s(km[0], km[1]); }
    float qn2 = 0.f;
    if (VAR == 1) { float sq = 0.f;
#pragma unroll
        for (int d0 = 0; d0 < ND; ++d0)
#pragma unroll
            for (int e = 0; e < 8; ++e) { const float x = __uint_as_float((unsigned)(unsigned short)qr[d0][e] << 16); sq += x * x; }
        { auto rr = __builtin_amdgcn_permlane32_swap(__float_as_uint(sq), __float_as_uint(sq), false, false); sq = __uint_as_float(rr[0]) + __uint_as_float(rr[1]); }
#pragma unroll
        for (int o = 1; o < 32; o <<= 1) sq = fmaxf(sq, __shfl_xor(sq, o));
        qn2 = sq; if (lane == 0) ((LAS float*)((lds_ptr)shm + LDS_KM))[wid] = sq; }
    asm volatile("s_waitcnt vmcnt(0)" ::: "memory");
    DMA_T(TILE_OF(0), 0); DMA_T(TILE_OF(1), 1);
    float mhat = 0.f; f32x16 o0 = f32x16{}, o1 = f32x16{}, o2 = f32x16{};
    const int qrel = wid * QBLK + r32;
    const lds_cptr kb0 = shm3 + LDS_K + hi * 1024 + r32 * 16;
    const int vb0 = (int)(lds0 + LDS_V) + ((lane >> 4) & 1) * 32 + (lane & 3) * 8 + (4 * hi + ((lane & 15) >> 2)) * 64;
    const lds_cptr cb0 = shm3 + LDS_CB + 16 * hi;
    unsigned selmask = 0u;
    if (VAR == 0) WAIT_BAR(3); else WAIT_BAR(2);
    int NTe = NT;
    if (VAR == 1 && NT > 4) {
        const LAS float* qs = (const LAS float*)((lds_ptr)shm + LDS_KM); float q2 = 0.f;
#pragma unroll
        for (int w = 0; w < 8; ++w) q2 = fmaxf(q2, qs[w]);
        const float thr = -(64.0f + 2.05f * sqrtf(q2) * A.KMEAN[b * 8 + h]);
        const LAS float* CBt = (const LAS float*)((lds_ptr)shm + LDS_CB);
        const bool sk = (lane < NT - 4) && (CBt[64 * lane + 63] < thr);
        NTe = NT - (int)__builtin_popcountll(__builtin_amdgcn_ballot_w64(sk));
    }
    if (2 < NTe) DMA_T(TILE_OF(2), 2);
    if (VAR == 2 && qb > 0) {
        f32x16 pg = f32x16{}; const lds_cptr km = shm3 + LDS_KM + hi * 1024 + r32 * 16;
#pragma unroll
        for (int d0 = 0; d0 < 4; ++d0) pg = __builtin_amdgcn_mfma_f32_32x32x16_bf16(*(const LAS bf16x8*)(km + d0 * 2048), qr[d0], pg, 0, 0, 0);
        float G[16];
#pragma unroll
        for (int r = 0; r < 8; ++r) { auto rr = __builtin_amdgcn_permlane32_swap(__float_as_uint(pg[r]), __float_as_uint(pg[r]), false, false);
            const int blk = (r & 3) + 8 * (r >> 2); G[blk] = (blk < qb) ? __uint_as_float(rr[0]) : -INFINITY; G[blk + 4] = (blk + 4 < qb) ? __uint_as_float(rr[1]) : -INFINITY; }
#pragma unroll
        for (int k = 0; k < 3; ++k) { float best = -INFINITY; int bi = -1;
#pragma unroll
            for (int n = 0; n < 16; ++n) if (G[n] > best) { best = G[n]; bi = n; }
            if (bi >= 0) selmask |= 1u << bi;
#pragma unroll
            for (int n = 0; n < 16; ++n) if (n == bi) G[n] = -INFINITY; }
    }
    tile_step<VAR, true, true>(o0, o1, o2, mhat, qr, kb0, vb0, wsf, cb0 + (NT - 4) * 256, true, 0, qrel, hi, r32);
#pragma unroll 1
    for (int i = 1; i < 4; ++i) {
        if (i + 1 < NTe) { if (VAR == 0) WAIT_BAR(3); else WAIT_BAR(2); } else WAIT_BAR(0);
        if (i + 2 < NTe) DMA_T(TILE_OF(i + 2), (i + 2) % 3);
        if (64 * i <= 32 * wid + 31) tile_step<VAR, false, true>(o0, o1, o2, mhat, qr, kb0 + (i % 3) * KSLOT, vb0 + (i % 3) * VSLOT, wsf, cb0 + (NT - 4 + i) * 256, true, i, qrel, hi, r32);
    }
    if (VAR == 1 && NTe > 4) {
        float mm = mhat;
#pragma unroll
        for (int o = 1; o < 64; o <<= 1) mm = fminf(mm, __shfl_xor(mm, o));
        LAS float* qs = (LAS float*)((lds_ptr)shm + LDS_KM);
        if (lane == 0) qs[16 + wid] = mm;
        asm volatile("s_waitcnt lgkmcnt(0)\n\ts_barrier" ::: "memory");
        float mmin = qs[16], q2 = qs[0];
#pragma unroll
        for (int w = 1; w < 8; ++w) { mmin = fminf(mmin, qs[16 + w]); q2 = fmaxf(q2, qs[w]); }
        const float thr2 = mmin - 56.0f - 1.03f * sqrtf(q2) * A.KMEAN[b * 8 + h];
        const LAS float* CBt = (const LAS float*)((lds_ptr)shm + LDS_CB);
        const bool sk = (lane < NT - 4) && (CBt[64 * lane + 63] < thr2);
        const int nte2 = NT - (int)__builtin_popcountll(__builtin_amdgcn_ballot_w64(sk));
        NTe = nte2 < NTe ? nte2 : NTe;
    }
    int sl = 1;
#pragma unroll 1
    for (int i = 4; i < NTe; ++i) {
        const int t = NT - 1 - i;
        if (i + 1 < NTe) { if (VAR == 0) WAIT_BAR(3); else WAIT_BAR(2); } else WAIT_BAR(0);
        if (i + 2 < NTe) { const int s2 = (sl == 0) ? 2 : sl - 1; DMA_T(TILE_OF(i + 2), s2); }
        const bool take = (VAR == 2) ? (((selmask >> (t >> 2)) & 1u) != 0u) : true;
        tile_step<VAR, false, false>(o0, o1, o2, mhat, qr, kb0 + sl * KSLOT, vb0 + sl * VSLOT, wsf, cb0 + t * 256, take, 0, qrel, hi, r32);
        sl = (sl == 2) ? 0 : sl + 1;
    }
    float rli[16];
#pragma unroll
    for (int r = 0; r < 16; ++r) rli[r] = __builtin_amdgcn_rcpf(o2[r]);
    bf16* Ow = A.O + (rowbase + q0 + wid * QBLK) * A.opitch + h * 64;
    { LAS unsigned short* stg = (LAS unsigned short*)((lds_ptr)shm + LDS_OST) + wid * 2048;
#pragma unroll
        for (int r = 0; r < 16; ++r) { const int orow = crow(r, hi);
            const unsigned pk = cvtpk_s(o0[r] * rli[r], o1[r] * rli[r]); stg[orow * 64 + r32] = (unsigned short)(pk & 0xffffu); stg[orow * 64 + 32 + r32] = (unsigned short)(pk >> 16); }
        asm volatile("s_waitcnt lgkmcnt(0)" ::: "memory");
#pragma unroll
        for (int i = 0; i < 4; ++i) { const int row = i * 8 + (lane >> 3), ch = lane & 7; const u32x4 v = *(const LAS u32x4*)(stg + row * 64 + ch * 8); __builtin_nontemporal_store(v, (u32x4*)(Ow + (long)row * A.opitch + ch * 8)); } }
    asm volatile("s_waitcnt lgkmcnt(0)\n\ts_barrier" ::: "memory");
#undef DMA_T
#undef TILE_OF
}
#undef SBAR
#undef WAIT_BAR
}
constexpr int RING_OFF = 0, RING_BYTES = 131072;
constexpr int LDSCTL_OFF = RING_BYTES, MISC_OFF = LDSCTL_OFF + 320;
constexpr int LDS_BYTES = 147456;
constexpr int NWAVES = 8;

typedef unsigned v4u __attribute__((ext_vector_type(4)));
typedef unsigned v2u __attribute__((ext_vector_type(2)));
typedef float f32x4 __attribute__((ext_vector_type(4)));
typedef float f32x2 __attribute__((ext_vector_type(2)));
typedef int i32x4 __attribute__((ext_vector_type(4)));
typedef int i32x2 __attribute__((ext_vector_type(2)));
typedef GAS unsigned gu32;
#define RLX_AGENT __ATOMIC_RELAXED, __HIP_MEMORY_SCOPE_AGENT
#define LDS_WAIT() asm volatile("s_waitcnt lgkmcnt(0)" ::: "memory")
#define VM_WAIT() asm volatile("s_waitcnt vmcnt(0)" ::: "memory")
__device__ __forceinline__ unsigned f2bf(float f) { unsigned u = __builtin_bit_cast(unsigned, f); return (u + 0x7fffu + ((u >> 16) & 1u)) >> 16; }
__device__ __forceinline__ unsigned pk2(float lo, float hi) { return f2bf(lo) | (f2bf(hi) << 16); }
__device__ __forceinline__ float bfl(unsigned w) { return __uint_as_float(w << 16); }
__device__ __forceinline__ float bfh(unsigned w) { return __uint_as_float(w & 0xffff0000u); }

#define XB_TMO      128
#define XB_XCNT(j)  (256  + 64 * (j))
#define XB_XSUB(j)  (1280 + 64 * (j))
#define XB_XGEN(j)  (2304 + 64 * (j))
#define XB_TOP      3328
#define XB_TOPGEN   3392
#define XCD_BAR_WORDS 3456
#define XB_SPIN_CAP (1u << 18)
__device__ __forceinline__ unsigned xb_ld(unsigned* p)              { return __hip_atomic_load(p, __ATOMIC_RELAXED, __HIP_MEMORY_SCOPE_AGENT); }
__device__ __forceinline__ unsigned xb_add(unsigned* p, unsigned v) { return __hip_atomic_fetch_add(p, v, __ATOMIC_RELAXED, __HIP_MEMORY_SCOPE_AGENT); }
__device__ __forceinline__ unsigned xb_xcc_id() { return (unsigned)__builtin_amdgcn_s_getreg((3 << 11) | 20) & 0xFu; }
#define XB_SPIN(cond, bar) do { unsigned _sp = 0; while (cond) { __builtin_amdgcn_s_sleep(1); \
    if ((++_sp & 255u) == 0u) { if (xb_ld(&(bar)[XB_TMO])) break; if (_sp > XB_SPIN_CAP) { atomicAdd(&(bar)[XB_TMO], 1u); break; } } } } while (0)
struct XcdBarrier { unsigned* bar; unsigned x; volatile LAS unsigned* st; };
__device__ __forceinline__ XcdBarrier xcd_barrier_post(unsigned* bar, volatile LAS unsigned* st) {
    XcdBarrier b; b.bar = bar; b.x = xb_xcc_id(); b.st = st;
    if (threadIdx.x == 0) (void)xb_add(&bar[XB_XCNT(b.x)], 1u);
    return b;
}
__device__ __forceinline__ void xcd_barrier_complete(unsigned* bar, unsigned x, unsigned& nloc, unsigned& nx) {
    const unsigned G = gridDim.x * gridDim.y * gridDim.z;
    unsigned sum, cnt, mine, sp = 0u;
    for (;;) {
        sum = 0u; cnt = 0u; mine = 0u;
#pragma unroll
        for (unsigned j = 0; j < 16; ++j) { const unsigned c = xb_ld(&bar[XB_XCNT(j)]); sum += c; cnt += (c > 0u) ? 1u : 0u; mine = (j == x) ? c : mine; }
        if (sum == G) break;
        __builtin_amdgcn_s_sleep(1);
        if ((++sp & 255u) == 0u) { if (xb_ld(&bar[XB_TMO])) break; if (sp > XB_SPIN_CAP) { atomicAdd(&bar[XB_TMO], 1u); break; } }
    }
    nloc = mine > 0u ? mine : 1u; nx = cnt > 0u ? cnt : 1u;
}
__device__ __forceinline__ void xcd_barrier(const XcdBarrier& b, int wave) {
    asm volatile("s_waitcnt vmcnt(0)" ::: "memory");
    __syncthreads();
    if (wave == 0 && pg8::lane_id_opaque() == 0) {
        unsigned* bar = b.bar; asm volatile("" : "+s"(bar));
        __builtin_amdgcn_s_waitcnt(0);
        unsigned nloc = b.st[0], nx = b.st[1];
        if (nloc == 0u) { xcd_barrier_complete(bar, b.x, nloc, nx); b.st[0] = nloc; b.st[1] = nx; }
        const unsigned old = xb_add(&bar[XB_XSUB(b.x)], 1u);
        const unsigned gen = old / nloc;
        if (old + 1u == (gen + 1u) * nloc) {
            __builtin_amdgcn_fence(__ATOMIC_RELEASE, "agent");
            asm volatile("s_waitcnt vmcnt(0)" ::: "memory");
            const unsigned og = xb_add(&bar[XB_TOP], 1u);
            const unsigned tg = og / nx;
            if (og + 1u == (tg + 1u) * nx) xb_add(&bar[XB_TOPGEN], 1u);
            else XB_SPIN(xb_ld(&bar[XB_TOPGEN]) == tg, bar);
            __builtin_amdgcn_fence(__ATOMIC_ACQUIRE, "agent");
            xb_add(&bar[XB_XGEN(b.x)], 1u);
            asm volatile("s_waitcnt vmcnt(0)" ::: "memory");
        } else {
            XB_SPIN(xb_ld(&bar[XB_XGEN(b.x)]) == gen, bar);
            __builtin_amdgcn_fence(__ATOMIC_ACQUIRE, "agent");
            asm volatile("s_waitcnt vmcnt(0)" ::: "memory");
        }
    }
    __syncthreads();
}

struct Frame {
    LAS unsigned char* lds;
    int tid, lane, wave, vcu, G, bid;
};
__device__ __forceinline__ float wave_sum(float v) {
#pragma unroll
    for (int o = 1; o < 64; o <<= 1) v += __shfl_xor(v, o);
    return v;
}

struct WJob { const float* W; const float* ksc; bf16* Bt; int Ks, Ns, Kd, Nd, kind, p0; float f8s; };
__device__ __forceinline__ int srccol(int kind, int p0, int R) {
    const int P8 = (R & ~31) + pg8::perm32(R & 31);
    switch (kind) {
    case 0: return R;
    case 1: return P8;
    case 2: {
        if (R < 256) return P8;
        if (R < 384) return P8;
        if (R < 416) return R;
        if (R < 424) return 1952 + (R - 416);
        if (R < 512) return -1;
        if (R < 2048) return 416 + (P8 - 512);
        if (R < 3072) { const int idx = R - 2048, head = idx >> 6, hp = idx & 63, s = hp >> 5, n = (hp >> 4) & 1, q4 = hp & 15; return 1960 + head * 64 + 32 * n + 16 * s + q4; }
        if (R < 3584) return 2984 + (P8 - 3072);
        return 3496 + (P8 - 3584); }
    case 3: { const int g = R >> 5; return (g % 3 == 2) ? R : P8; }
    case 4: { const int t = R >> 8, p = R & 255, bj = p >> 7, hp = p & 127; return bj * p0 + t * 128 + (hp & ~31) + pg8::perm32(hp & 31); }
    }
    return -1;
}
__device__ __forceinline__ void wconv_load(const WJob& J, int item, int lane, f32x4 (&v)[8]) {
    const int nkb = J.Kd / 64, rb = item / nkb, kb = item % nkb, k0 = 64 * kb + 8 * (lane >> 3), R = 32 * rb + 4 * (lane & 7);
    const int sc = srccol(J.kind, J.p0, R);
    const bool live = sc >= 0; const float* wp = J.W + (size_t)k0 * J.Ns + (live ? sc : 0);
#pragma unroll
    for (int i = 0; i < 8; ++i) v[i] = (live && k0 + i < J.Ks) ? *(const f32x4*)(wp + (size_t)i * J.Ns) : (f32x4){0.f, 0.f, 0.f, 0.f};
    if (J.ksc) {
#pragma unroll
        for (int i = 0; i < 8; ++i) if (k0 + i < J.Ks) v[i] = v[i] * J.ksc[k0 + i]; }
}
__device__ __forceinline__ void wconv_store(const WJob& J, int item, int lane, const f32x4 (&v)[8]) {
    const int nkb = J.Kd / 64, rb = item / nkb, kb = item % nkb, k0 = 64 * kb + 8 * (lane >> 3), R = 32 * rb + 4 * (lane & 7);
    if (J.f8s > 0.f) { const float f = J.f8s;
#pragma unroll
        for (int j = 0; j < 4; ++j) { v2u o; o.x = pg8::pk4_f8(v[0][j] * f, v[1][j] * f, v[2][j] * f, v[3][j] * f); o.y = pg8::pk4_f8(v[4][j] * f, v[5][j] * f, v[6][j] * f, v[7][j] * f);
            *(v2u*)((unsigned char*)J.Bt + (size_t)(R + j) * J.Kd + k0) = o; }
    } else {
#pragma unroll
        for (int j = 0; j < 4; ++j) { v4u o; o.x = pk2(v[0][j], v[1][j]); o.y = pk2(v[2][j], v[3][j]); o.z = pk2(v[4][j], v[5][j]); o.w = pk2(v[6][j], v[7][j]);
            *(v4u*)(J.Bt + (size_t)(R + j) * J.Kd + k0) = o; } }
}

__device__ __forceinline__ void rms_row_to_bf16(const float* xrow, const float* g, bf16* orow, int lane) {
    const f32x4* xr = (const f32x4*)xrow + lane; const f32x4* gr = (const f32x4*)g + lane;
    f32x4 v[4]; float s = 0.f;
#pragma unroll
    for (int j = 0; j < 4; ++j) { v[j] = xr[64 * j]; s += (v[j].x * v[j].x + v[j].y * v[j].y) + (v[j].z * v[j].z + v[j].w * v[j].w); }
    const float r = rsqrtf(wave_sum(s) * (1.f / DM) + RMS_EPS);
    unsigned long long* o8 = (unsigned long long*)orow + lane;
#pragma unroll
    for (int j = 0; j < 4; ++j) { const f32x4 gg = gr[64 * j]; o8[64 * j] = (unsigned long long)pk2(v[j].x * r * gg.x, v[j].y * r * gg.y) | ((unsigned long long)pk2(v[j].z * r * gg.z, v[j].w * r * gg.w) << 32); }
}

__device__ __forceinline__ void rms_row_to_f8(const float* xrow, const float* g, unsigned char* orow, float* rs, int lane) {
    const f32x4* xr = (const f32x4*)xrow + lane; const f32x4* gr = (const f32x4*)g + lane;
    f32x4 v[4]; float s = 0.f;
#pragma unroll
    for (int j = 0; j < 4; ++j) { v[j] = xr[64 * j]; s += (v[j].x * v[j].x + v[j].y * v[j].y) + (v[j].z * v[j].z + v[j].w * v[j].w); }
    const float r = rsqrtf(wave_sum(s) * (1.f / DM) + RMS_EPS); float mx = 0.f;
#pragma unroll
    for (int j = 0; j < 4; ++j) { const f32x4 gg = gr[64 * j]; v[j] = (f32x4){v[j].x * r * gg.x, v[j].y * r * gg.y, v[j].z * r * gg.z, v[j].w * r * gg.w};
        mx = fmaxf(fmaxf(mx, fmaxf(fabsf(v[j].x), fabsf(v[j].y))), fmaxf(fabsf(v[j].z), fabsf(v[j].w))); }
#pragma unroll
    for (int o = 1; o < 64; o <<= 1) mx = fmaxf(mx, __shfl_xor(mx, o));
    const float sc = mx > 0.f ? A8_ROWMAX / mx : 1.0f;
    unsigned* o4 = (unsigned*)orow + lane;
#pragma unroll
    for (int j = 0; j < 4; ++j) o4[64 * j] = pg8::pk4_f8(v[j].x * sc, v[j].y * sc, v[j].z * sc, v[j].w * sc);
    if (lane == 0) *rs = mx > 0.f ? mx * (1.0f / A8_ROWMAX) : 1.0f;
}

__device__ __forceinline__ void ld_row16(const bf16* row, int lane, f32x4 (&v)[4]) {
    const v2u* xr = (const v2u*)row + lane;
#pragma unroll
    for (int j = 0; j < 4; ++j) { const v2u w = xr[64 * j]; v[j] = (f32x4){bfl(w.x), bfh(w.x), bfl(w.y), bfh(w.y)}; }
}
__device__ __forceinline__ void rms_row16_to_bf16(const bf16* xrow, const float* g, bf16* orow, int lane) {
    const f32x4* gr = (const f32x4*)g + lane; f32x4 v[4]; ld_row16(xrow, lane, v); float s = 0.f;
#pragma unroll
    for (int j = 0; j < 4; ++j) s += (v[j].x * v[j].x + v[j].y * v[j].y) + (v[j].z * v[j].z + v[j].w * v[j].w);
    const float r = rsqrtf(wave_sum(s) * (1.f / DM) + RMS_EPS);
    unsigned long long* o8 = (unsigned long long*)orow + lane;
#pragma unroll
    for (int j = 0; j < 4; ++j) { const f32x4 gg = gr[64 * j]; o8[64 * j] = (unsigned long long)pk2(v[j].x * r * gg.x, v[j].y * r * gg.y) | ((unsigned long long)pk2(v[j].z * r * gg.z, v[j].w * r * gg.w) << 32); }
}

__device__ __forceinline__ unsigned pk4_i8(float a, float b, float c, float d) {
    const int ia = (int)rintf(a), ib = (int)rintf(b), ic = (int)rintf(c), id = (int)rintf(d);
    return (unsigned)(ia & 255) | ((unsigned)(ib & 255) << 8) | ((unsigned)(ic & 255) << 16) | ((unsigned)(id & 255) << 24);
}
__device__ __forceinline__ void rms_row16_to_i8(const bf16* xrow, const float* g, unsigned char* orow, float* rs, int lane) {
    const f32x4* gr = (const f32x4*)g + lane; f32x4 v[4]; ld_row16(xrow, lane, v); float s = 0.f;
#pragma unroll
    for (int j = 0; j < 4; ++j) s += (v[j].x * v[j].x + v[j].y * v[j].y) + (v[j].z * v[j].z + v[j].w * v[j].w);
    const float r = rsqrtf(wave_sum(s) * (1.f / DM) + RMS_EPS); float mx = 0.f;
#pragma unroll
    for (int j = 0; j < 4; ++j) { const f32x4 gg = gr[64 * j]; v[j] = (f32x4){v[j].x * r * gg.x, v[j].y * r * gg.y, v[j].z * r * gg.z, v[j].w * r * gg.w};
        mx = fmaxf(fmaxf(mx, fmaxf(fabsf(v[j].x), fabsf(v[j].y))), fmaxf(fabsf(v[j].z), fabsf(v[j].w))); }
#pragma unroll
    for (int o = 1; o < 64; o <<= 1) mx = fmaxf(mx, __shfl_xor(mx, o));
    const float sc = mx > 0.f ? 127.0f / mx : 0.f;
    unsigned* o4 = (unsigned*)orow + lane;
#pragma unroll
    for (int j = 0; j < 4; ++j) o4[64 * j] = pk4_i8(v[j].x * sc, v[j].y * sc, v[j].z * sc, v[j].w * sc);
    if (lane == 0) *rs = mx * (1.0f / 127.0f);
}
template <bool F32IN>
__device__ __forceinline__ void rms_rows_to_i8(const void* X, const float* g, unsigned char* O, float* RS, int m0, int step, int lane) {
    const f32x4* gr = (const f32x4*)g + lane; f32x4 gg[4];
#pragma unroll
    for (int j = 0; j < 4; ++j) gg[j] = gr[64 * j];
    v2u nw[4]; f32x4 nf[4];
    auto issue = [&](int m) __attribute__((always_inline)) {
        if (F32IN) { const f32x4* xr = (const f32x4*)((const float*)X + (size_t)m * DM) + lane;
#pragma unroll
            for (int j = 0; j < 4; ++j) nf[j] = xr[64 * j]; }
        else { const v2u* xr = (const v2u*)((const bf16*)X + (size_t)m * DM) + lane;
#pragma unroll
            for (int j = 0; j < 4; ++j) nw[j] = xr[64 * j]; } };
    if (m0 < MTOK) issue(m0);
    for (int m = m0; m < MTOK; m += step) { f32x4 v[4];
#pragma unroll
        for (int j = 0; j < 4; ++j) v[j] = F32IN ? nf[j] : (f32x4){bfl(nw[j].x), bfh(nw[j].x), bfl(nw[j].y), bfh(nw[j].y)};
        if (m + step < MTOK) issue(m + step);
        float s = 0.f;
#pragma unroll
        for (int j = 0; j < 4; ++j) s += (v[j].x * v[j].x + v[j].y * v[j].y) + (v[j].z * v[j].z + v[j].w * v[j].w);
        const float r = rsqrtf(wave_sum(s) * (1.f / DM) + RMS_EPS); float mx = 0.f;
#pragma unroll
        for (int j = 0; j < 4; ++j) { v[j] = (f32x4){v[j].x * r * gg[j].x, v[j].y * r * gg[j].y, v[j].z * r * gg[j].z, v[j].w * r * gg[j].w};
            mx = fmaxf(fmaxf(mx, fmaxf(fabsf(v[j].x), fabsf(v[j].y))), fmaxf(fabsf(v[j].z), fabsf(v[j].w))); }
#pragma unroll
        for (int o = 1; o < 64; o <<= 1) mx = fmaxf(mx, __shfl_xor(mx, o));
        const float sc = mx > 0.f ? 127.0f / mx : 0.f;
        unsigned* o4 = (unsigned*)(O + (size_t)m * DM) + lane;
#pragma unroll
        for (int j = 0; j < 4; ++j) o4[64 * j] = pk4_i8(v[j].x * sc, v[j].y * sc, v[j].z * sc, v[j].w * sc);
        if (lane == 0) RS[m] = mx * (1.0f / 127.0f); }
}
__device__ __forceinline__ void wconv_i8_item(const float* W, int Ks, int Ns, int kind, int p0, unsigned char* Bt, float* CS, int item, int lane) {
    const int R = 16 * item + 4 * (lane & 3), ko = lane >> 2; const int sc = srccol(kind, p0, R);
    const float* wp = W + (size_t)(8 * ko) * Ns + (sc >= 0 ? sc : 0);
    f32x4 mx = {0.f, 0.f, 0.f, 0.f};
    for (int kb = 0; kb < Ks / 128; ++kb) {
#pragma unroll
        for (int i = 0; i < 8; ++i) { const f32x4 v = *(const f32x4*)(wp + (size_t)(128 * kb + i) * Ns);
            mx[0] = fmaxf(mx[0], fabsf(v[0])); mx[1] = fmaxf(mx[1], fabsf(v[1])); mx[2] = fmaxf(mx[2], fabsf(v[2])); mx[3] = fmaxf(mx[3], fabsf(v[3])); } }
#pragma unroll
    for (int o = 4; o < 64; o <<= 1)
#pragma unroll
        for (int j = 0; j < 4; ++j) mx[j] = fmaxf(mx[j], __shfl_xor(mx[j], o));
    if (sc < 0) mx = (f32x4){0.f, 0.f, 0.f, 0.f};
    f32x4 qs;
#pragma unroll
    for (int j = 0; j < 4; ++j) qs[j] = mx[j] > 0.f ? 127.0f / mx[j] : 0.f;
    if (ko == 0) *(f32x4*)(CS + R) = mx * (1.0f / 127.0f);
    for (int kb = 0; kb < Ks / 128; ++kb) { f32x4 v[8];
#pragma unroll
        for (int i = 0; i < 8; ++i) v[i] = *(const f32x4*)(wp + (size_t)(128 * kb + i) * Ns);
#pragma unroll
        for (int j = 0; j < 4; ++j) { v2u o; o.x = pk4_i8(v[0][j] * qs[j], v[1][j] * qs[j], v[2][j] * qs[j], v[3][j] * qs[j]); o.y = pk4_i8(v[4][j] * qs[j], v[5][j] * qs[j], v[6][j] * qs[j], v[7][j] * qs[j]);
            *(v2u*)(Bt + (size_t)(R + j) * Ks + 128 * kb + 8 * ko) = o; } }
}

struct I8Job { const float* W; int Ns, kind, p0; unsigned char* Bt; float* CS; int item; };
__device__ __forceinline__ void wconv_i8_load(const I8Job& J, int wave, int lane, f32x4 (&v)[16]) {
    const int nq = lane & 7, ko = lane >> 3; const int sc = srccol(J.kind, J.p0, 32 * J.item + 4 * nq);
    const float* wp = J.W + (size_t)(128 * wave + 8 * ko) * J.Ns + (sc >= 0 ? sc : 0);
#pragma unroll
    for (int i = 0; i < 16; ++i) v[i] = *(const f32x4*)(wp + (size_t)(64 * (i >> 3) + (i & 7)) * J.Ns);
}
__device__ __forceinline__ void wconv_i8_finish(const I8Job& J, int wave, int lane, f32x4 (&v)[16], LAS float* mxs) {
    const int nq = lane & 7, ko = lane >> 3; const int R = 32 * J.item + 4 * nq; const int sc = srccol(J.kind, J.p0, R);
    f32x4 mx = {0.f, 0.f, 0.f, 0.f};
#pragma unroll
    for (int i = 0; i < 16; ++i) { if (sc < 0) v[i] = (f32x4){0.f, 0.f, 0.f, 0.f};
        mx[0] = fmaxf(mx[0], fabsf(v[i][0])); mx[1] = fmaxf(mx[1], fabsf(v[i][1])); mx[2] = fmaxf(mx[2], fabsf(v[i][2])); mx[3] = fmaxf(mx[3], fabsf(v[i][3])); }
#pragma unroll
    for (int o = 8; o < 64; o <<= 1)
#pragma unroll
        for (int j = 0; j < 4; ++j) mx[j] = fmaxf(mx[j], __shfl_xor(mx[j], o));
    if (ko == 0) *(LAS f32x4*)(mxs + wave * 32 + 4 * nq) = mx;
    LDS_WAIT(); __builtin_amdgcn_s_barrier();
#pragma unroll
    for (int w2 = 0; w2 < 8; ++w2) { const f32x4 o = *(const LAS f32x4*)(mxs + w2 * 32 + 4 * nq); mx[0] = fmaxf(mx[0], o[0]); mx[1] = fmaxf(mx[1], o[1]); mx[2] = fmaxf(mx[2], o[2]); mx[3] = fmaxf(mx[3], o[3]); }
    f32x4 qs;
#pragma unroll
    for (int j = 0; j < 4; ++j) qs[j] = mx[j] > 0.f ? 127.0f / mx[j] : 0.f;
    if (wave == 0 && ko == 0) *(f32x4*)(J.CS + R) = mx * (1.0f / 127.0f);
#pragma unroll
    for (int j = 0; j < 4; ++j)
#pragma unroll
        for (int h = 0; h < 2; ++h) { v2u o; o.x = pk4_i8(v[8 * h][j] * qs[j], v[8 * h + 1][j] * qs[j], v[8 * h + 2][j] * qs[j], v[8 * h + 3][j] * qs[j]); o.y = pk4_i8(v[8 * h + 4][j] * qs[j], v[8 * h + 5][j] * qs[j], v[8 * h + 6][j] * qs[j], v[8 * h + 7][j] * qs[j]);
            *(v2u*)(J.Bt + (size_t)(R + j) * 1024 + 128 * wave + 64 * h + 8 * ko) = o; }
}

__device__ __forceinline__ void rms_row_to_i8(const float* xrow, const float* g, unsigned char* orow, float* rs, int lane) {
    const f32x4* xr = (const f32x4*)xrow + lane; const f32x4* gr = (const f32x4*)g + lane; f32x4 v[4]; float s = 0.f;
#pragma unroll
    for (int j = 0; j < 4; ++j) { v[j] = xr[64 * j]; s += (v[j].x * v[j].x + v[j].y * v[j].y) + (v[j].z * v[j].z + v[j].w * v[j].w); }
    const float r = rsqrtf(wave_sum(s) * (1.f / DM) + RMS_EPS); float mx = 0.f;
#pragma unroll
    for (int j = 0; j < 4; ++j) { const f32x4 gg = gr[64 * j]; v[j] = (f32x4){v[j].x * r * gg.x, v[j].y * r * gg.y, v[j].z * r * gg.z, v[j].w * r * gg.w};
        mx = fmaxf(fmaxf(mx, fmaxf(fabsf(v[j].x), fabsf(v[j].y))), fmaxf(fabsf(v[j].z), fabsf(v[j].w))); }
#pragma unroll
    for (int o = 1; o < 64; o <<= 1) mx = fmaxf(mx, __shfl_xor(mx, o));
    const float sc = mx > 0.f ? 127.0f / mx : 0.f;
    unsigned* o4 = (unsigned*)orow + lane;
#pragma unroll
    for (int j = 0; j < 4; ++j) o4[64 * j] = pk4_i8(v[j].x * sc, v[j].y * sc, v[j].z * sc, v[j].w * sc);
    if (lane == 0) *rs = mx * (1.0f / 127.0f);
}
struct KArgs { const void* in[18]; float* out; unsigned char* ws; int ph_lo, ph_hi; };
#ifndef MK_N_LAUNCHES
#define MK_N_LAUNCHES 1
#endif
constexpr int NPHASE = 20;
constexpr int NJOBS = 10 + 2 + 16;

__device__ __forceinline__ void get_job(int j, const __attribute__((address_space(4))) KArgs* ap, WJob& J) {
    unsigned char* ws = ap->ws;
    if (j < 10) { const int l = j / 5, ty = j % 5; bf16* wl = (bf16*)(ws + OFF_WL) + (size_t)l * W_LAYER_E;
        if (ty == 0) { J.W = (const float*)ap->in[3] + (size_t)l * DM * IN_COLS; J.ksc = nullptr; J.Bt = wl; J.Ks = DM; J.Ns = IN_COLS; J.Kd = DM; J.Nd = IN_N; J.kind = 2; J.p0 = 0; J.f8s = 0.f; }
        else if (ty == 1) { J.W = (const float*)ap->in[6] + (size_t)l * 256 * QM_W; J.ksc = (const float*)ap->in[4] + l * 256; J.Bt = wl + W_IN_E; J.Ks = 256; J.Ns = QM_W; J.Kd = 256; J.Nd = QM_W; J.kind = 3; J.p0 = 0; J.f8s = 0.f; }
        else if (ty == 2) { J.W = (const float*)ap->in[7] + (size_t)l * 128 * KVM_W; J.ksc = (const float*)ap->in[5] + l * 128; J.Bt = wl + W_IN_E + (size_t)QM_W * 256; J.Ks = 128; J.Ns = KVM_W; J.Kd = 256; J.Nd = KVM_W; J.kind = 1; J.p0 = 0; J.f8s = 0.f; }
        else if (ty == 3) { J.W = (const float*)ap->in[9] + (size_t)l * Y3_W * DM; J.ksc = nullptr; J.Bt = wl + W_IN_E + W_UP_E; J.Ks = Y3_W; J.Ns = DM; J.Kd = Y3_W; J.Nd = DM; J.kind = 1; J.p0 = 0; J.f8s = 0.f; }
        else { J.W = (const float*)ap->in[10] + (size_t)l * DM * DM; J.ksc = nullptr; J.Bt = wl + W_IN_E + W_UP_E + W_BR_E; J.Ks = DM; J.Ns = DM; J.Kd = DM; J.Nd = DM; J.kind = 1; J.p0 = 0; J.f8s = 0.f; }
    } else if (j == 10) { J.W = (const float*)ap->in[12]; J.ksc = nullptr; J.Bt = (bf16*)(ws + OFF_WDGU); J.Ks = DM; J.Ns = 2 * DFF; J.Kd = DM; J.Nd = 2 * DFF; J.kind = 4; J.p0 = DFF; J.f8s = 0.f; }
    else if (j == 11) { J.W = (const float*)ap->in[13]; J.ksc = nullptr; J.Bt = (bf16*)(ws + OFF_WDDN); J.Ks = DFF; J.Ns = DM; J.Kd = DFF; J.Nd = DM; J.kind = 1; J.p0 = 0; J.f8s = DENSE_DOWN_F8 ? W8S_DN : 0.f; }
    else if (j < 20) { const int e = j - 12; J.W = (const float*)ap->in[15] + (size_t)e * DM * 2 * EFF; J.ksc = nullptr; J.Bt = (bf16*)(ws + OFF_WEGU + (size_t)e * 2 * EFF * DM); J.Ks = DM; J.Ns = 2 * EFF; J.Kd = DM; J.Nd = 2 * EFF; J.kind = 4; J.p0 = EFF; J.f8s = W8S_GU; }
    else { const int e = j - 20; J.W = (const float*)ap->in[16] + (size_t)e * EFF * DM; J.ksc = nullptr; J.Bt = (bf16*)(ws + OFF_WEDN + (size_t)e * DM * EFF); J.Ks = EFF; J.Ns = DM; J.Kd = EFF; J.Nd = DM; J.kind = 1; J.p0 = 0; J.f8s = W8S_DN; }
}
__device__ __forceinline__ int job_items(int j) {
    if (j < 10) { const int ty = j % 5; return ty == 0 ? 0   : ty == 1 ? (QM_W / 32) * 4 : ty == 2 ? (KVM_W / 32) * 4 : ty == 3 ? (DM / 32) * (Y3_W / 64) : (DM / 32) * (DM / 64); }
    if (j == 10) return 0;
    if (j == 11) return (DM / 32) * (DFF / 64);
    if (j < 20) return 0;
    return (DM / 32) * (EFF / 64);
}

#define SSQ ((float*)(ws + OFF_SSQ))
#define LOGF ((float*)(ws + OFF_LOGF))
#define CUM ((float*)(ws + OFF_CUM))
#define KMEAN ((float*)(ws + OFF_KMEAN))
#define KNM ((float*)(ws + OFF_KNM))
#define R64C ((float*)(ws + OFF_R64C))
#define R64S ((float*)(ws + OFF_R64S))
#define R32C ((float*)(ws + OFF_R32C))
#define R32S ((float*)(ws + OFF_R32S))
#define TOKI ((int*)(ws + OFF_TOKI))
#define TOKW ((float*)(ws + OFF_TOKW))
#define TOKR ((int*)(ws + OFF_TOKR))
#define CNT ((int*)(ws + OFF_CNT))
#define MTAB ((int*)(ws + OFF_MTAB))
#define XN8 ((unsigned char*)(ws + OFF_XN8))
#define RSX ((float*)(ws + OFF_RSX))
#define RSG ((float*)(ws + OFF_RSG))
#define XS16 ((bf16*)(ws + OFF_XS))
#define XNQ ((unsigned char*)(ws + OFF_XN))
#define CSC ((float*)(ws + OFF_CSC))
#define CSIN ((float*)(ws + OFF_CSIN))
#define RSIN ((float*)(ws + OFF_RSIN))
#define XN ((bf16*)(ws + OFF_XN))
#define QM ((bf16*)(ws + OFF_QM))
#define LAT ((bf16*)(ws + OFF_LAT))
#define KR ((bf16*)(ws + OFF_KR))
#define FQ ((bf16*)(ws + OFF_FQ))
#define FK ((bf16*)(ws + OFF_FK))
#define FV ((bf16*)(ws + OFF_FV))
#define MQ ((bf16*)(ws + OFF_MQ))
#define MK ((bf16*)(ws + OFF_MK))
#define MV ((bf16*)(ws + OFF_MV))
#define GT ((bf16*)(ws + OFF_GT))
#define KVM ((bf16*)(ws + OFF_KVM))
#define MERGED ((bf16*)(ws + OFF_MERGED))
#define Y3 ((bf16*)(ws + OFF_Y3))
#define ACTD ((bf16*)(ws + OFF_ACTD))
#define ACTM ((unsigned char*)(ws + OFF_ACTM))
#define XG ((unsigned char*)(ws + OFF_XG))
#define YE ((bf16*)(ws + OFF_YE))
__global__ void __launch_bounds__(NWAVES * 64, 2) mega_fwd(KArgs args) {
    extern __shared__ __attribute__((aligned(16))) unsigned char lds[];
    Frame F;
    F.lds = (LAS unsigned char*)lds;
    volatile LAS unsigned* MISC = (volatile LAS unsigned*)(F.lds + MISC_OFF);
    F.tid = threadIdx.x; F.lane = F.tid & 63; F.wave = __builtin_amdgcn_readfirstlane(F.tid >> 6);
    F.G = gridDim.x; F.bid = blockIdx.x; { const int bx = blockIdx.x; F.vcu = (F.G % 8 == 0) ? (bx % 8) * (F.G / 8) + bx / 8 : bx; }
    unsigned char* ws0 = args.ws;
    gu32* ctl = (gu32*)(ws0 + WS_CTL);
    for (int u = F.tid; u < (LDS_BYTES - LDSCTL_OFF) / 4; u += NWAVES * 64) ((LAS unsigned*)(F.lds + LDSCTL_OFF))[u] = 0u;
    __syncthreads();
    XcdBarrier bar = xcd_barrier_post((unsigned*)(ctl + CW_BAR), MISC + 8);
    const int lo = args.ph_lo, hi = args.ph_hi;
#ifndef PH_MASK
#define PH_MASK 0xFFFFFFu
#endif
#ifndef REP_MASK
#define REP_MASK 0u
#endif
#ifndef REP_ATT
#define REP_ATT 0u
#endif
#define REPEAT(k) for (int rep_ = 0; rep_ < ((((unsigned)REP_MASK >> (k)) & 1u) ? 2 : 1); ++rep_)
#define IN(k) (lo <= (k) && (k) < hi && ((PH_MASK >> (k)) & 1u))
#define SEAM(k) do { if (IN(k) && IN((k) + 1)) xcd_barrier(bar, F.wave); } while (0)
#define INL(j) (lo <= pb + (j) && pb + (j) < hi && ((PH_MASK >> (1 + (j))) & 1u))
#define SEAML(j) do { if (lo <= pb + (j) && pb + (j) + 1 < hi) xcd_barrier(bar, F.wave); } while (0)
#define PHB const int wave = F.wave; const int lane = pg8::lane_id_opaque(); const int tid = wave * 64 + lane; const int gw = F.vcu * NWAVES + wave; (void)lane; (void)gw; (void)tid; \
    const __attribute__((address_space(4))) KArgs* ka = (const __attribute__((address_space(4))) KArgs*)__builtin_amdgcn_kernarg_segment_ptr(); asm volatile("" : "+s"(ka)); unsigned char* ws = ka->ws; float* xs = ka->out; const float* x_in = (const float*)ka->in[0]; \
    int G = F.G, bid = F.bid, NGW; asm volatile("" : "+s"(G), "+s"(bid)); NGW = G * NWAVES; (void)xs; (void)x_in; (void)NGW; (void)bid
    if (IN(0)) { asm volatile("; PHASE_MARK 0" ::: "memory"); PHB;
        REPEAT(0) {
        {
            WJob Jc, Jn; int itc = 0, itn = 0; f32x4 vc[8], vn[8];
            auto decode = [&](int git, WJob& J, int& it) -> bool { int jb = 0;
                for (int j = 0; j < NJOBS; ++j) { const int ni = job_items(j); if (git < jb + ni) { get_job(j, ka, J); it = git - jb; return true; } jb += ni; }
                return false; };
            int git = gw; bool have = decode(git, Jc, itc);
            if (have) wconv_load(Jc, itc, lane, vc);
            while (have) {
                const bool hn = decode(git + NGW, Jn, itn);
                if (hn) wconv_load(Jn, itn, lane, vn);
                wconv_store(Jc, itc, lane, vc);
                Jc = Jn; itc = itn; have = hn; git += NGW;
#pragma unroll
                for (int i = 0; i < 8; ++i) vc[i] = vn[i];
            } }
        { LAS float* mxs = (LAS float*)(F.lds + RING_OFF); int par = 0;
          constexpr int NI_IN = 2 * (IN_N / 32), NI_DG = 2 * DFF / 32, NI_EG = 2 * EFF / 32, NI_ALL = NI_IN + NI_DG + 8 * NI_EG;
          auto getj = [&](int it, I8Job& J) __attribute__((always_inline)) {
              if (it < NI_IN) { const int l2 = it / (IN_N / 32); J.W = (const float*)ka->in[3] + (size_t)l2 * DM * IN_COLS; J.Ns = IN_COLS; J.kind = 2; J.p0 = 0; J.Bt = (unsigned char*)((bf16*)(ws + OFF_WL) + (size_t)l2 * W_LAYER_E); J.CS = CSIN + l2 * IN_N; J.item = it - l2 * (IN_N / 32); }
              else if (it < NI_IN + NI_DG) { J.W = (const float*)ka->in[12]; J.Ns = 2 * DFF; J.kind = 4; J.p0 = DFF; J.Bt = (unsigned char*)(ws + OFF_WDGU); J.CS = CSC; J.item = it - NI_IN; }
              else { const int i2 = it - NI_IN - NI_DG, e = i2 / NI_EG; J.W = (const float*)ka->in[15] + (size_t)e * DM * 2 * EFF; J.Ns = 2 * EFF; J.kind = 4; J.p0 = EFF; J.Bt = (unsigned char*)(ws + OFF_WEGU + (size_t)e * 2 * EFF * DM); J.CS = (float*)(ws + OFF_CSE) + e * 2 * EFF; J.item = i2 - e * NI_EG; } };
          I8Job Jc, Jn; f32x4 vc[16], vn[16]; int it = bid; bool have = it < NI_ALL;
          if (have) { getj(it, Jc); wconv_i8_load(Jc, wave, lane, vc); }
          while (have) { const bool hn = it + G < NI_ALL;
              if (hn) { getj(it + G, Jn); wconv_i8_load(Jn, wave, lane, vn); }
              wconv_i8_finish(Jc, wave, lane, vc, mxs + par * 256);
              Jc = Jn; have = hn; it += G; par ^= 1;
#pragma unroll
              for (int i = 0; i < 16; ++i) vc[i] = vn[i]; }
          LDS_WAIT(); __syncthreads(); }
        const int* pos = (const int*)ka->in[1];
        for (int i = bid * (NWAVES * 64) + tid; i < MTOK * 32; i += G * NWAVES * 64) { const int tok = i >> 5, f = i & 31;
            const float p = (float)pos[tok];
            { const float inv = expf(-9.210340371976184f * (float)f * (2.0f / 64.0f)); const float ang = p * inv; const float n = rintf(ang * 0.15915494309189535f);
              float r = fmaf(-n, 6.28318548202514648f, ang); r = fmaf(-n, -1.7484555e-7f, r); R64C[i] = __cosf(r); R64S[i] = __sinf(r); }
            if (f < 16) { const float inv = expf(-9.210340371976184f * (float)f * (2.0f / 32.0f)); const float ang = p * inv; const float n = rintf(ang * 0.15915494309189535f);
              float r = fmaf(-n, 6.28318548202514648f, ang); r = fmaf(-n, -1.7484555e-7f, r); R32C[tok * 16 + f] = __cosf(r); R32S[tok * 16 + f] = __sinf(r); } }
        rms_rows_to_i8<true>(x_in, (const float*)ka->in[2], XNQ, RSIN, gw, NGW, lane);
        }
    }
    SEAM(0);

    {
        constexpr int l = 0;
        const int pb = 1 + 9 * l;
        if (INL(0)) { asm volatile("; PHASE_MARK L0" ::: "memory"); PHB;
            pg8::Gemm g{(const bf16*)XNQ, (const bf16*)(ws + OFF_WL) + (size_t)l * W_LAYER_E, DM / 2, DM / 2}; pg8::GridOrder S; S.init(MTOK / 256, IN_N / 256, G, bid);
            pg8::EpiIn E{ws, (const float*)ka->in[8] + l * 8, CSIN + l * IN_N};
            REPEAT(pb + 0) pg8::gemm_phase<pg8::EpiIn, pg8::GridOrder, false, true, true, true>(F.lds + RING_OFF, g, S, E, wave);
#ifdef PROBE_NULL_EPI_IN
            { pg8::EpiNull EN; pg8::gemm_phase<pg8::EpiNull, pg8::GridOrder, false, true, true, true>(F.lds + RING_OFF, g, S, EN, wave); }
#endif
        }
        SEAML(0);
        if (INL(1)) { asm volatile("; PHASE_MARK L1" ::: "memory"); PHB;
            const int sw0 = (G >= 256) ? bid - 192 : F.vcu, sw1 = (G >= 256) ? bid - 128 : F.vcu - 64;
            for (int it = sw0; it < 64; it += G) { if (it < 0) continue;
                const int b = it >> 3, h = it & 7; LAS float* part = (LAS float*)(F.lds + RING_OFF);
                float v[8]; float run = 0.f;
#pragma unroll
                for (int k = 0; k < 8; ++k) { run += LOGF[((size_t)b * SEQ + tid * 8 + k) * 8 + h]; v[k] = run; }
                float inc = run;
#pragma unroll
                for (int o = 1; o < 64; o <<= 1) { const float t = __shfl_up(inc, o); if (lane >= o) inc += t; }
                if (lane == 63) part[wave] = inc;
                LDS_WAIT(); __syncthreads();
                float base = inc - run;
                for (int w = 0; w < wave; ++w) base += part[w];
                float* dst = CUM + ((size_t)b * 8 + h) * SEQ + tid * 8;
                *(f32x4*)dst = (f32x4){v[0] + base, v[1] + base, v[2] + base, v[3] + base}; *(f32x4*)(dst + 4) = (f32x4){v[4] + base, v[5] + base, v[6] + base, v[7] + base};
                __syncthreads();
                float kn = 0.f;
                { const v4u* kp = (const v4u*)(FK + ((size_t)b * SEQ + (tid >> 3)) * BR_W + h * 64) + (tid & 7);
#pragma unroll 8
                  for (int p = 0; p < SEQ / 64; ++p) { const v4u w = kp[(size_t)p * 64 * (BR_W / 8)]; float sq = 0.f;
#pragma unroll
                      for (int e = 0; e < 4; ++e) { const float lo = bfl(w[e]), hi2 = bfh(w[e]); sq += lo * lo + hi2 * hi2; }
                      sq += __shfl_xor(sq, 1); sq += __shfl_xor(sq, 2); sq += __shfl_xor(sq, 4);
                      kn = fmaxf(kn, sq); } }
#pragma unroll
                for (int o = 1; o < 64; o <<= 1) kn = fmaxf(kn, __shfl_xor(kn, o));
                if (lane == 0) part[8 + wave] = kn;
                LDS_WAIT(); __syncthreads();
                if (tid == 0) { float m = 0.f; for (int w = 0; w < 8; ++w) m = fmaxf(m, part[8 + w]); KNM[it] = sqrtf(m); }
                __syncthreads();
            }
            for (int it = sw1; it < 128; it += G) { if (it < 0) continue;
                const v4u* src = (const v4u*)(MK + ((size_t)it * 256 + wave * 32) * BR_W) + lane; float a8[8];
#pragma unroll
                for (int e = 0; e < 8; ++e) a8[e] = 0.f;
#pragma unroll 8
                for (int r = 0; r < 32; ++r) { const v4u w = src[(size_t)r * (BR_W / 8)];
#pragma unroll
                    for (int e = 0; e < 4; ++e) { a8[2 * e] += bfl(w[e]); a8[2 * e + 1] += bfh(w[e]); } }
                LAS float* red = (LAS float*)(F.lds + RING_OFF + 4096);
                *(LAS f32x4*)(red + wave * 512 + 8 * lane) = (f32x4){a8[0], a8[1], a8[2], a8[3]}; *(LAS f32x4*)(red + wave * 512 + 8 * lane + 4) = (f32x4){a8[4], a8[5], a8[6], a8[7]};
                LDS_WAIT(); __syncthreads();
                float s = 0.f;
#pragma unroll
                for (int w = 0; w < 8; ++w) s += red[w * 512 + tid];
                KMEAN[(size_t)it * 512 + tid] = s * (1.0f / 256.0f);
                __syncthreads(); }
            VM_WAIT(); __syncthreads();
            pg8::Gemm g{LAT, ((const bf16*)(ws + OFF_WL) + (size_t)l * W_LAYER_E) + W_IN_E, LAT_W, 256}; pg8::MidOrder S; S.init(MTOK / 256, UP_N / 256, G, bid);
            pg8::EpiUp E{ws};
            REPEAT(pb + 1) pg8::gemm_phase<pg8::EpiUp, pg8::MidOrder>(F.lds + RING_OFF, g, S, E, wave);
        }
        SEAML(1);
        if (INL(2)) { asm volatile("; PHASE_MARK L2" ::: "memory"); PHB;
            att::Args A0{(const att::bf16*)QM, (const att::bf16*)KVM, (const att::bf16*)KR, (const att::bf16*)KVM + 64, (att::bf16*)Y3, nullptr, nullptr, QM_W, KVM_W, KVM_W, Y3_W, 96, 128};
            att::Args A1{(const att::bf16*)FQ, (const att::bf16*)FK, nullptr, (const att::bf16*)FV, (att::bf16*)Y3 + 512, CUM, KNM, BR_W, BR_W, BR_W, Y3_W, 64, 64};
            att::Args A2{(const att::bf16*)MQ, (const att::bf16*)MK, nullptr, (const att::bf16*)MV, (att::bf16*)Y3 + 1024, nullptr, KMEAN, BR_W, BR_W, BR_W, Y3_W, 64, 64};
            char* shm = (char*)lds + RING_OFF;
            for (int rep_ = 0; rep_ < (((REP_ATT >> 0) & 1u) ? 2 : 1); ++rep_)
            for (int v = F.vcu; v < 512; v += G) { const int bh = v >> 3, s = v & 7;
                att::attn_unit<0>(bh >> 3, bh & 7, 15 - s, A0, shm, wave); att::attn_unit<0>(bh >> 3, bh & 7, s, A0, shm, wave); }
            for (int rep_ = 0; rep_ < (((REP_ATT >> 1) & 1u) ? 2 : 1); ++rep_)
            for (int v = F.vcu; v < 512; v += G) { const int bh = v >> 3, s = v & 7;
                att::attn_unit<1>(bh >> 3, bh & 7, 15 - s, A1, shm, wave); att::attn_unit<1>(bh >> 3, bh & 7, s, A1, shm, wave); }
            for (int rep_ = 0; rep_ < (((REP_ATT >> 2) & 1u) ? 2 : 1); ++rep_)
            for (int v = F.vcu; v < 512; v += G) { const int bh = v >> 3, s = v & 7;
                att::attn_unit<2>(bh >> 3, bh & 7, 15 - s, A2, shm, wave); att::attn_unit<2>(bh >> 3, bh & 7, s, A2, shm, wave); }
        }
        SEAML(2);
        if (INL(3)) { asm volatile("; PHASE_MARK L3" ::: "memory"); PHB;
            pg8::Gemm g{Y3, ((const bf16*)(ws + OFF_WL) + (size_t)l * W_LAYER_E) + W_IN_E + W_UP_E, Y3_W, Y3_W}; pg8::GridOrder S; S.init(MTOK / 256, DM / 256, G, bid);
            pg8::EpiMerge E{GT, MERGED};
            REPEAT(pb + 3) pg8::gemm_phase<pg8::EpiMerge, pg8::GridOrder>(F.lds + RING_OFF, g, S, E, wave);
        }
        SEAML(3);
        if (INL(4)) { asm volatile("; PHASE_MARK L4" ::: "memory"); PHB;
            pg8::Gemm g{MERGED, ((const bf16*)(ws + OFF_WL) + (size_t)l * W_LAYER_E) + W_IN_E + W_UP_E + W_BR_E, DM, DM}; pg8::GridOrder S; S.init(MTOK / 256, DM / 256, G, bid);
            pg8::EpiResidB<l == 0> E{l == 0 ? (const void*)x_in : (const void*)XS16, XS16, 1.0f};
            REPEAT(l == 0 ? pb + 4 : 31) pg8::gemm_phase<pg8::EpiResidB<l == 0>, pg8::GridOrder>(F.lds + RING_OFF, g, S, E, wave);
        }
        SEAML(4);
        if (l == 0) {
            if (IN(6)) { asm volatile("; PHASE_MARK 6" ::: "memory"); PHB; const float* gf = (const float*)ka->in[11]; REPEAT(6) rms_rows_to_i8<false>(XS16, gf, XNQ, RSX, gw, NGW, lane); }
            SEAM(6);
            if (IN(7)) { asm volatile("; PHASE_MARK 7" ::: "memory"); PHB;
                pg8::Gemm g{(const bf16*)XNQ, (const bf16*)(ws + OFF_WDGU), DM / 2, DM / 2}; pg8::GridOrder S; S.init(MTOK / 256, 2 * DFF / 256, G, bid);
#if DENSE_DOWN_F8
                pg8::EpiSwigluI8 E{(unsigned char*)ACTD, DFF, RSX, CSC};
                REPEAT(7) pg8::gemm_phase<pg8::EpiSwigluI8, pg8::GridOrder, false, true, true, true>(F.lds + RING_OFF, g, S, E, wave);
#else
                pg8::EpiSwigluI8B E{ACTD, DFF, RSX, CSC};
                REPEAT(7) pg8::gemm_phase<pg8::EpiSwigluI8B, pg8::GridOrder, false, true, true, true>(F.lds + RING_OFF, g, S, E, wave);
#endif
            }
            SEAM(7);
            if (IN(8)) { asm volatile("; PHASE_MARK 8" ::: "memory"); PHB;
#if DENSE_DOWN_F8
                pg8::Gemm g{(const bf16*)ACTD, (const bf16*)(ws + OFF_WDDN), DFF / 2, DFF / 2}; pg8::GridOrder S; S.init(MTOK / 256, DM / 256, G, bid);
                pg8::EpiResidB<false> E{(const void*)XS16, XS16, 1.0f / (A8S_ACT * W8S_DN)};
                pg8::gemm_phase<pg8::EpiResidB<false>, pg8::GridOrder, true, true, true, false, false, false>(F.lds + RING_OFF, g, S, E, wave);
#else
                pg8::Gemm g{ACTD, (const bf16*)(ws + OFF_WDDN), DFF, DFF}; pg8::GridOrder S; S.init(MTOK / 256, DM / 256, G, bid);
                pg8::EpiResidB<false> E{(const void*)XS16, XS16, 1.0f};
                pg8::gemm_phase<pg8::EpiResidB<false>, pg8::GridOrder>(F.lds + RING_OFF, g, S, E, wave);
#endif
            }
            SEAM(8);
            if (IN(9)) { asm volatile("; PHASE_MARK 9" ::: "memory"); PHB; const float* gm = (const float*)ka->in[2] + DM; REPEAT(9) rms_rows_to_i8<false>(XS16, gm, XNQ, RSIN, gw, NGW, lane); }
            SEAM(9);
        } else {
            if (IN(15)) { asm volatile("; PHASE_MARK 15" ::: "memory"); PHB;
                const float* gf = (const float*)ka->in[11] + DM;
                LAS int* cnt = (LAS int*)(F.lds + RING_OFF + 32768);
                const float* wr = (const float*)ka->in[14];
                f32x4 w0[4][4], w1[4][4], gg[4];
#pragma unroll
                for (int j = 0; j < 4; ++j) { gg[j] = ((const f32x4*)gf + lane)[64 * j];
#pragma unroll
                    for (int q = 0; q < 4; ++q) { const f32x4* wp = (const f32x4*)(wr + (size_t)(256 * j + 4 * lane + q) * 8); w0[j][q] = wp[0]; w1[j][q] = wp[1]; } }
                const bool b0_ = (lane & 1) != 0, b1_ = (lane & 2) != 0, b2_ = (lane & 4) != 0;
                REPEAT(15) for (int c = bid; c < 256; c += G) {
                    if (tid < 64) cnt[tid] = 0;
                    LDS_WAIT(); __syncthreads();
                    const int t0 = c * 128 + wave * 16;
                    auto row_do = [&](int t, f32x4 (&v)[4]) __attribute__((always_inline)) {
                        float s = 0.f;
#pragma unroll
                        for (int j = 0; j < 4; ++j) s += (v[j].x * v[j].x + v[j].y * v[j].y) + (v[j].z * v[j].z + v[j].w * v[j].w);
                        const float r = rsqrtf(wave_sum(s) * (1.f / DM) + RMS_EPS);
                        float lg[8];
#pragma unroll
                        for (int e = 0; e < 8; ++e) lg[e] = 0.f;
                        float mx = 0.f;
#pragma unroll
                        for (int j = 0; j < 4; ++j) { const f32x4 hv = {v[j].x * r * gg[j].x, v[j].y * r * gg[j].y, v[j].z * r * gg[j].z, v[j].w * r * gg[j].w}; v[j] = hv;
                            mx = fmaxf(fmaxf(mx, fmaxf(fabsf(hv.x), fabsf(hv.y))), fmaxf(fabsf(hv.z), fabsf(hv.w)));
#pragma unroll
                            for (int q = 0; q < 4; ++q) { const f32x4 a0 = w0[j][q], a1 = w1[j][q]; const float hh = hv[q];
                                lg[0] += hh * a0.x; lg[1] += hh * a0.y; lg[2] += hh * a0.z; lg[3] += hh * a0.w; lg[4] += hh * a1.x; lg[5] += hh * a1.y; lg[6] += hh * a1.z; lg[7] += hh * a1.w; } }
#pragma unroll
                        for (int o = 1; o < 64; o <<= 1) mx = fmaxf(mx, __shfl_xor(mx, o));
                        { const float sc = mx > 0.f ? 127.0f / mx : 0.f; unsigned* o4 = (unsigned*)(XN8 + (size_t)t * DM) + lane;
#pragma unroll
                          for (int j = 0; j < 4; ++j) o4[64 * j] = pk4_i8(v[j].x * sc, v[j].y * sc, v[j].z * sc, v[j].w * sc);
                          if (lane == 0) RSX[t] = mx * (1.0f / 127.0f); }
                        float y4[4], y2[2], y1;
#pragma unroll
                        for (int k = 0; k < 4; ++k) { const float keep = b0_ ? lg[4 + k] : lg[k], send = b0_ ? lg[k] : lg[4 + k]; y4[k] = keep + __shfl_xor(send, 1); }
#pragma unroll
                        for (int k = 0; k < 2; ++k) { const float keep = b1_ ? y4[2 + k] : y4[k], send = b1_ ? y4[k] : y4[2 + k]; y2[k] = keep + __shfl_xor(send, 2); }
                        { const float keep = b2_ ? y2[1] : y2[0], send = b2_ ? y2[0] : y2[1]; y1 = keep + __shfl_xor(send, 4); }
                        y1 += __shfl_xor(y1, 8); y1 += __shfl_xor(y1, 16); y1 += __shfl_xor(y1, 32);
#pragma unroll
                        for (int e = 0; e < 8; ++e) lg[e] = __uint_as_float(__builtin_amdgcn_readlane(__float_as_uint(y1), ((e >> 2) & 1) | (((e >> 1) & 1) << 1) | ((e & 1) << 2)));
                        int e0 = 0; float b0 = lg[0];
#pragma unroll
                        for (int e = 1; e < 8; ++e) if (lg[e] > b0) { b0 = lg[e]; e0 = e; }
                        int e1 = 0; float b1 = -INFINITY;
#pragma unroll
                        for (int e = 0; e < 8; ++e) if (e != e0 && lg[e] > b1) { b1 = lg[e]; e1 = e; }
                        if (lane == 0) { const float w1v = 1.0f / (1.0f + __expf(b0 - b1)); const float w0v = 1.0f - w1v;
                            volatile LAS int* cw = cnt + wave * 8; const int i0 = cw[e0]; cw[e0] = i0 + 1; const int i1 = cw[e1]; cw[e1] = i1 + 1;
                            *(i32x4*)(TOKI + (size_t)t * 4) = (i32x4){e0, e1, i0, i1}; *(f32x2*)(TOKW + (size_t)t * 2) = (f32x2){w0v, w1v}; }
                    };
                    f32x4 na[4], nb[4]; ld_row16(XS16 + (size_t)t0 * DM, lane, na); ld_row16(XS16 + (size_t)(t0 + 1) * DM, lane, nb);
                    for (int i = 0; i < 16; i += 2) { const int t = t0 + i;
                        f32x4 va[4], vb[4];
#pragma unroll
                        for (int j = 0; j < 4; ++j) { va[j] = na[j]; vb[j] = nb[j]; }
                        if (i + 2 < 16) { ld_row16(XS16 + (size_t)(t + 2) * DM, lane, na); ld_row16(XS16 + (size_t)(t + 3) * DM, lane, nb); }
                        row_do(t, va); row_do(t + 1, vb);
                    }
                    LDS_WAIT(); __syncthreads();
                    if (tid < 8) { int* wp = (int*)(ws + OFF_WPRE) + c * 64 + tid; int run = 0;
#pragma unroll
                        for (int w = 0; w < 8; ++w) { wp[w * 8] = run; run += cnt[w * 8 + tid]; }
                        CNT[c * 8 + tid] = run; }
                    __syncthreads();
                }
            }
            SEAM(15);
            if (IN(16)) { asm volatile("; PHASE_MARK 16" ::: "memory"); PHB;
                LAS int* PRE = (LAS int*)(F.lds + RING_OFF);
                LAS int* TOT = PRE + 2048;
                { const int e = wave; int cv[4]; int run = 0;
#pragma unroll
                    for (int k = 0; k < 4; ++k) { cv[k] = CNT[(lane * 4 + k) * 8 + e]; run += cv[k]; }
                    int inc = run;
#pragma unroll
                    for (int o = 1; o < 64; o <<= 1) { const int t = __shfl_up(inc, o); if (lane >= o) inc += t; }
                    int ex = inc - run;
#pragma unroll
                    for (int k = 0; k < 4; ++k) { PRE[e * 256 + lane * 4 + k] = ex; ex += cv[k]; }
                    if (lane == 63) TOT[e] = inc; }
                LDS_WAIT(); __syncthreads();
                if (tid == 0) { int st = 0;
                    for (int e = 0; e < 8; ++e) { TOT[8 + e] = st; const int nb = (TOT[e] + 255) >> 8;
                        if (bid == 0) for (int k = 0; k < nb; ++k) MTAB[(st >> 8) + k] = e;
                        st += nb << 8; }
                    if (bid == 0) MTAB[264] = st >> 8; }
                LDS_WAIT(); __syncthreads();
                REPEAT(16) for (int c = bid; c < 256; c += G)
                    for (int i = 0; i < 16; ++i) { const int t = c * 128 + wave * 16 + i; const i32x4 ti = *(const i32x4*)(TOKI + (size_t)t * 4);
                        const int* wpre = (const int*)(ws + OFF_WPRE) + (c * 8 + wave) * 8;
                        const int r0 = TOT[8 + ti.x] + PRE[ti.x * 256 + c] + wpre[ti.x] + ti.z, r1 = TOT[8 + ti.y] + PRE[ti.y * 256 + c] + wpre[ti.y] + ti.w;
                        if (lane == 0) { *(i32x2*)(TOKR + (size_t)t * 2) = (i32x2){r0, r1}; const float rsv = RSX[t]; RSG[r0] = rsv; RSG[r1] = rsv; }
                        const v4u a = *((const v4u*)(XN8 + (size_t)t * DM) + lane);
                        *((v4u*)(XG + (size_t)r0 * DM) + lane) = a; *((v4u*)(XG + (size_t)r1 * DM) + lane) = a; }
            }
            SEAM(16);
            if (IN(17)) { asm volatile("; PHASE_MARK 17" ::: "memory"); PHB;
                const __attribute__((address_space(4))) int* mtab = (const __attribute__((address_space(4))) int*)(ws + OFF_MTAB); const int nblk = mtab[264];
                pg8::Gemm g{(const bf16*)XG, (const bf16*)(ws + OFF_WEGU), DM / 2, DM / 2}; pg8::MoeOrder S; S.init(nblk, 2 * EFF / 256, G, bid); S.tab = mtab;
                pg8::EpiSwigluI8 E{ACTM, EFF, RSG, (const float*)(ws + OFF_CSE)};
                REPEAT(17) pg8::gemm_phase<pg8::EpiSwigluI8, pg8::MoeOrder, false, true, true, true>(F.lds + RING_OFF, g, S, E, wave);
#ifdef PROBE_NULL_EPI
                { pg8::EpiNull EN; pg8::gemm_phase<pg8::EpiNull, pg8::MoeOrder, true>(F.lds + RING_OFF, g, S, EN, wave); }
#endif
            }
            SEAM(17);
            if (IN(18)) { asm volatile("; PHASE_MARK 18" ::: "memory"); PHB;
                const __attribute__((address_space(4))) int* mtab = (const __attribute__((address_space(4))) int*)(ws + OFF_MTAB); const int nblk = mtab[264];
                pg8::Gemm g{(const bf16*)ACTM, (const bf16*)(ws + OFF_WEDN), EFF / 2, EFF / 2}; pg8::MoeDownOrder S; S.init(nblk, G, bid); S.tab = mtab;
                pg8::EpiBf8K E{YE, (float*)(ws + OFF_XG), 1.0f / (A8S_ACT * W8S_DN)};
                REPEAT(18) pg8::gemm_phase<pg8::EpiBf8K, pg8::MoeDownOrder, true, true, true, false, true, false>(F.lds + RING_OFF, g, S, E, wave);
            }
            SEAM(18);
            if (IN(19)) { asm volatile("; PHASE_MARK 19" ::: "memory"); PHB;
                {
                    const __attribute__((address_space(4))) int* mtab = (const __attribute__((address_space(4))) int*)(ws + OFF_MTAB); const int ntail = (mtab[264] - 256) * 256;
                    const float* PART = (const float*)(ws + OFF_XG);
                    for (int r = gw; r < ntail; r += NGW) { const float* pp = PART + (size_t)(((r >> 8) * 7) * 256 + (r & 255)) * DM; f32x4 pv[7][4];
#pragma unroll
                        for (int k = 0; k < 7; ++k)
#pragma unroll
                            for (int j = 0; j < 4; ++j) pv[k][j] = ((const f32x4*)(pp + (size_t)k * 256 * DM) + lane)[64 * j];
#pragma unroll
                        for (int j = 0; j < 4; ++j) { f32x4 a = pv[0][j];
#pragma unroll
                            for (int k = 1; k < 7; ++k) a += pv[k][j];
                            ((v2u*)(YE + (size_t)(65536 + r) * DM) + lane)[64 * j] = (v2u){pg8::cvt_pk_bf16(a.x, a.y), pg8::cvt_pk_bf16(a.z, a.w)}; } }
                    xcd_barrier(bar, F.wave); }
                const f32x4* gr = (const f32x4*)ka->in[17] + lane;
                {   f32x4 gg[4];
#pragma unroll
                    for (int j = 0; j < 4; ++j) gg[j] = gr[64 * j];
                    v2u cx[4], c0[4], c1[4], nx[4], n0[4], n1[4]; i32x2 rrn = {0, 0}; f32x2 wwc = {0.f, 0.f}, wwn = {0.f, 0.f};
                    auto rows = [&](int t, i32x2 rr, v2u (&ax)[4], v2u (&a0)[4], v2u (&a1)[4]) __attribute__((always_inline)) {
                        const v2u* px = (const v2u*)(XS16 + (size_t)t * DM) + lane; const v2u* p0 = (const v2u*)(YE + (size_t)rr.x * DM) + lane; const v2u* p1 = (const v2u*)(YE + (size_t)rr.y * DM) + lane;
#pragma unroll
                        for (int j = 0; j < 4; ++j) { ax[j] = px[64 * j]; a0[j] = p0[64 * j]; a1[j] = p1[64 * j]; } };
                    int t = gw;
                    if (t < MTOK) { const i32x2 rr = *(const i32x2*)(TOKR + (size_t)t * 2); wwc = *(const f32x2*)(TOKW + (size_t)t * 2); rows(t, rr, cx, c0, c1); }
                    if (t + NGW < MTOK) { rrn = *(const i32x2*)(TOKR + (size_t)(t + NGW) * 2); wwn = *(const f32x2*)(TOKW + (size_t)(t + NGW) * 2); }
                    for (; t < MTOK; t += NGW) {
                        i32x2 rrnn = {0, 0}; f32x2 wwnn = {0.f, 0.f};
                        if (t + NGW < MTOK) rows(t + NGW, rrn, nx, n0, n1);
                        if (t + 2 * NGW < MTOK) { rrnn = *(const i32x2*)(TOKR + (size_t)(t + 2 * NGW) * 2); wwnn = *(const f32x2*)(TOKW + (size_t)(t + 2 * NGW) * 2); }
                        f32x4* xr = (f32x4*)(xs + (size_t)t * DM) + lane; f32x4 v[4]; float s = 0.f; const f32x2 ww = wwc;
#pragma unroll
                        for (int j = 0; j < 4; ++j) { const v2u x = cx[j], a = c0[j], b2 = c1[j];
                            v[j].x = bfl(x.x) + ww.x * bfl(a.x) + ww.y * bfl(b2.x); v[j].y = bfh(x.x) + ww.x * bfh(a.x) + ww.y * bfh(b2.x); v[j].z = bfl(x.y) + ww.x * bfl(a.y) + ww.y * bfl(b2.y); v[j].w = bfh(x.y) + ww.x * bfh(a.y) + ww.y * bfh(b2.y);
                            s += (v[j].x * v[j].x + v[j].y * v[j].y) + (v[j].z * v[j].z + v[j].w * v[j].w); }
                        const float r = rsqrtf(wave_sum(s) * (1.f / DM) + RMS_EPS);
#pragma unroll
                        for (int j = 0; j < 4; ++j) xr[64 * j] = (f32x4){v[j].x * r * gg[j].x, v[j].y * r * gg[j].y, v[j].z * r * gg[j].z, v[j].w * r * gg[j].w};
#pragma unroll
                        for (int j = 0; j < 4; ++j) { cx[j] = nx[j]; c0[j] = n0[j]; c1[j] = n1[j]; }
                        wwc = wwn; rrn = rrnn; wwn = wwnn; } }
            }
        }
    }
    {
        constexpr int l = 1;
        const int pb = 1 + 9 * l;
        if (INL(0)) { asm volatile("; PHASE_MARK L0" ::: "memory"); PHB;
            pg8::Gemm g{(const bf16*)XNQ, (const bf16*)(ws + OFF_WL) + (size_t)l * W_LAYER_E, DM / 2, DM / 2}; pg8::GridOrder S; S.init(MTOK / 256, IN_N / 256, G, bid);
            pg8::EpiIn E{ws, (const float*)ka->in[8] + l * 8, CSIN + l * IN_N};
            REPEAT(pb + 0) pg8::gemm_phase<pg8::EpiIn, pg8::GridOrder, false, true, true, true>(F.lds + RING_OFF, g, S, E, wave);
#ifdef PROBE_NULL_EPI_IN
            { pg8::EpiNull EN; pg8::gemm_phase<pg8::EpiNull, pg8::GridOrder, false, true, true, true>(F.lds + RING_OFF, g, S, EN, wave); }
#endif
        }
        SEAML(0);
        if (INL(1)) { asm volatile("; PHASE_MARK L1" ::: "memory"); PHB;
            const int sw0 = (G >= 256) ? bid - 192 : F.vcu, sw1 = (G >= 256) ? bid - 128 : F.vcu - 64;
            for (int it = sw0; it < 64; it += G) { if (it < 0) continue;
                const int b = it >> 3, h = it & 7; LAS float* part = (LAS float*)(F.lds + RING_OFF);
                float v[8]; float run = 0.f;
#pragma unroll
                for (int k = 0; k < 8; ++k) { run += LOGF[((size_t)b * SEQ + tid * 8 + k) * 8 + h]; v[k] = run; }
                float inc = run;
#pragma unroll
                for (int o = 1; o < 64; o <<= 1) { const float t = __shfl_up(inc, o); if (lane >= o) inc += t; }
                if (lane == 63) part[wave] = inc;
                LDS_WAIT(); __syncthreads();
                float base = inc - run;
                for (int w = 0; w < wave; ++w) base += part[w];
                float* dst = CUM + ((size_t)b * 8 + h) * SEQ + tid * 8;
                *(f32x4*)dst = (f32x4){v[0] + base, v[1] + base, v[2] + base, v[3] + base}; *(f32x4*)(dst + 4) = (f32x4){v[4] + base, v[5] + base, v[6] + base, v[7] + base};
                __syncthreads();
                float kn = 0.f;
                { const v4u* kp = (const v4u*)(FK + ((size_t)b * SEQ + (tid >> 3)) * BR_W + h * 64) + (tid & 7);
#pragma unroll 8
                  for (int p = 0; p < SEQ / 64; ++p) { const v4u w = kp[(size_t)p * 64 * (BR_W / 8)]; float sq = 0.f;
#pragma unroll
                      for (int e = 0; e < 4; ++e) { const float lo = bfl(w[e]), hi2 = bfh(w[e]); sq += lo * lo + hi2 * hi2; }
                      sq += __shfl_xor(sq, 1); sq += __shfl_xor(sq, 2); sq += __shfl_xor(sq, 4);
                      kn = fmaxf(kn, sq); } }
#pragma unroll
                for (int o = 1; o < 64; o <<= 1) kn = fmaxf(kn, __shfl_xor(kn, o));
                if (lane == 0) part[8 + wave] = kn;
                LDS_WAIT(); __syncthreads();
                if (tid == 0) { float m = 0.f; for (int w = 0; w < 8; ++w) m = fmaxf(m, part[8 + w]); KNM[it] = sqrtf(m); }
                __syncthreads();
            }
            for (int it = sw1; it < 128; it += G) { if (it < 0) continue;
                const v4u* src = (const v4u*)(MK + ((size_t)it * 256 + wave * 32) * BR_W) + lane; float a8[8];
#pragma unroll
                for (int e = 0; e < 8; ++e) a8[e] = 0.f;
#pragma unroll 8
                for (int r = 0; r < 32; ++r) { const v4u w = src[(size_t)r * (BR_W / 8)];
#pragma unroll
                    for (int e = 0; e < 4; ++e) { a8[2 * e] += bfl(w[e]); a8[2 * e + 1] += bfh(w[e]); } }
                LAS float* red = (LAS float*)(F.lds + RING_OFF + 4096);
                *(LAS f32x4*)(red + wave * 512 + 8 * lane) = (f32x4){a8[0], a8[1], a8[2], a8[3]}; *(LAS f32x4*)(red + wave * 512 + 8 * lane + 4) = (f32x4){a8[4], a8[5], a8[6], a8[7]};
                LDS_WAIT(); __syncthreads();
                float s = 0.f;
#pragma unroll
                for (int w = 0; w < 8; ++w) s += red[w * 512 + tid];
                KMEAN[(size_t)it * 512 + tid] = s * (1.0f / 256.0f);
                __syncthreads(); }
            VM_WAIT(); __syncthreads();
            pg8::Gemm g{LAT, ((const bf16*)(ws + OFF_WL) + (size_t)l * W_LAYER_E) + W_IN_E, LAT_W, 256}; pg8::MidOrder S; S.init(MTOK / 256, UP_N / 256, G, bid);
            pg8::EpiUp E{ws};
            REPEAT(pb + 1) pg8::gemm_phase<pg8::EpiUp, pg8::MidOrder>(F.lds + RING_OFF, g, S, E, wave);
        }
        SEAML(1);
        if (INL(2)) { asm volatile("; PHASE_MARK L2" ::: "memory"); PHB;
            att::Args A0{(const att::bf16*)QM, (const att::bf16*)KVM, (const att::bf16*)KR, (const att::bf16*)KVM + 64, (att::bf16*)Y3, nullptr, nullptr, QM_W, KVM_W, KVM_W, Y3_W, 96, 128};
            att::Args A1{(const att::bf16*)FQ, (const att::bf16*)FK, nullptr, (const att::bf16*)FV, (att::bf16*)Y3 + 512, CUM, KNM, BR_W, BR_W, BR_W, Y3_W, 64, 64};
            att::Args A2{(const att::bf16*)MQ, (const att::bf16*)MK, nullptr, (const att::bf16*)MV, (att::bf16*)Y3 + 1024, nullptr, KMEAN, BR_W, BR_W, BR_W, Y3_W, 64, 64};
            char* shm = (char*)lds + RING_OFF;
            for (int rep_ = 0; rep_ < (((REP_ATT >> 0) & 1u) ? 2 : 1); ++rep_)
            for (int v = F.vcu; v < 512; v += G) { const int bh = v >> 3, s = v & 7;
                att::attn_unit<0>(bh >> 3, bh & 7, 15 - s, A0, shm, wave); att::attn_unit<0>(bh >> 3, bh & 7, s, A0, shm, wave); }
            for (int rep_ = 0; rep_ < (((REP_ATT >> 1) & 1u) ? 2 : 1); ++rep_)
            for (int v = F.vcu; v < 512; v += G) { const int bh = v >> 3, s = v & 7;
                att::attn_unit<1>(bh >> 3, bh & 7, 15 - s, A1, shm, wave); att::attn_unit<1>(bh >> 3, bh & 7, s, A1, shm, wave); }
            for (int rep_ = 0; rep_ < (((REP_ATT >> 2) & 1u) ? 2 : 1); ++rep_)
            for (int v = F.vcu; v < 512; v += G) { const int bh = v >> 3, s = v & 7;
                att::attn_unit<2>(bh >> 3, bh & 7, 15 - s, A2, shm, wave); att::attn_unit<2>(bh >> 3, bh & 7, s, A2, shm, wave); }
        }
        SEAML(2);
        if (INL(3)) { asm volatile("; PHASE_MARK L3" ::: "memory"); PHB;
            pg8::Gemm g{Y3, ((const bf16*)(ws + OFF_WL) + (size_t)l * W_LAYER_E) + W_IN_E + W_UP_E, Y3_W, Y3_W}; pg8::GridOrder S; S.init(MTOK / 256, DM / 256, G, bid);
            pg8::EpiMerge E{GT, MERGED};
            REPEAT(pb + 3) pg8::gemm_phase<pg8::EpiMerge, pg8::GridOrder>(F.lds + RING_OFF, g, S, E, wave);
        }
        SEAML(3);
        if (INL(4)) { asm volatile("; PHASE_MARK L4" ::: "memory"); PHB;
            pg8::Gemm g{MERGED, ((const bf16*)(ws + OFF_WL) + (size_t)l * W_LAYER_E) + W_IN_E + W_UP_E + W_BR_E, DM, DM}; pg8::GridOrder S; S.init(MTOK / 256, DM / 256, G, bid);
            pg8::EpiResidB<l == 0> E{l == 0 ? (const void*)x_in : (const void*)XS16, XS16, 1.0f};
            REPEAT(l == 0 ? pb + 4 : 31) pg8::gemm_phase<pg8::EpiResidB<l == 0>, pg8::GridOrder>(F.lds + RING_OFF, g, S, E, wave);
        }
        SEAML(4);
        if (l == 0) {
            if (IN(6)) { asm volatile("; PHASE_MARK 6" ::: "memory"); PHB; const float* gf = (const float*)ka->in[11]; REPEAT(6) rms_rows_to_i8<false>(XS16, gf, XNQ, RSX, gw, NGW, lane); }
            SEAM(6);
            if (IN(7)) { asm volatile("; PHASE_MARK 7" ::: "memory"); PHB;
                pg8::Gemm g{(const bf16*)XNQ, (const bf16*)(ws + OFF_WDGU), DM / 2, DM / 2}; pg8::GridOrder S; S.init(MTOK / 256, 2 * DFF / 256, G, bid);
#if DENSE_DOWN_F8
                pg8::EpiSwigluI8 E{(unsigned char*)ACTD, DFF, RSX, CSC};
                REPEAT(7) pg8::gemm_phase<pg8::EpiSwigluI8, pg8::GridOrder, false, true, true, true>(F.lds + RING_OFF, g, S, E, wave);
#else
                pg8::EpiSwigluI8B E{ACTD, DFF, RSX, CSC};
                REPEAT(7) pg8::gemm_phase<pg8::EpiSwigluI8B, pg8::GridOrder, false, true, true, true>(F.lds + RING_OFF, g, S, E, wave);
#endif
            }
            SEAM(7);
            if (IN(8)) { asm volatile("; PHASE_MARK 8" ::: "memory"); PHB;
#if DENSE_DOWN_F8
                pg8::Gemm g{(const bf16*)ACTD, (const bf16*)(ws + OFF_WDDN), DFF / 2, DFF / 2}; pg8::GridOrder S; S.init(MTOK / 256, DM / 256, G, bid);
                pg8::EpiResidB<false> E{(const void*)XS16, XS16, 1.0f / (A8S_ACT * W8S_DN)};
                pg8::gemm_phase<pg8::EpiResidB<false>, pg8::GridOrder, true, true, true, false, false, false>(F.lds + RING_OFF, g, S, E, wave);
#else
                pg8::Gemm g{ACTD, (const bf16*)(ws + OFF_WDDN), DFF, DFF}; pg8::GridOrder S; S.init(MTOK / 256, DM / 256, G, bid);
                pg8::EpiResidB<false> E{(const void*)XS16, XS16, 1.0f};
                pg8::gemm_phase<pg8::EpiResidB<false>, pg8::GridOrder>(F.lds + RING_OFF, g, S, E, wave);
#endif
            }
            SEAM(8);
            if (IN(9)) { asm volatile("; PHASE_MARK 9" ::: "memory"); PHB; const float* gm = (const float*)ka->in[2] + DM; REPEAT(9) rms_rows_to_i8<false>(XS16, gm, XNQ, RSIN, gw, NGW, lane); }
            SEAM(9);
        } else {
            if (IN(15)) { asm volatile("; PHASE_MARK 15" ::: "memory"); PHB;
                const float* gf = (const float*)ka->in[11] + DM;
                LAS int* cnt = (LAS int*)(F.lds + RING_OFF + 32768);
                const float* wr = (const float*)ka->in[14];
                f32x4 w0[4][4], w1[4][4], gg[4];
#pragma unroll
                for (int j = 0; j < 4; ++j) { gg[j] = ((const f32x4*)gf + lane)[64 * j];
#pragma unroll
                    for (int q = 0; q < 4; ++q) { const f32x4* wp = (const f32x4*)(wr + (size_t)(256 * j + 4 * lane + q) * 8); w0[j][q] = wp[0]; w1[j][q] = wp[1]; } }
                const bool b0_ = (lane & 1) != 0, b1_ = (lane & 2) != 0, b2_ = (lane & 4) != 0;
                REPEAT(15) for (int c = bid; c < 256; c += G) {
                    if (tid < 64) cnt[tid] = 0;
                    LDS_WAIT(); __syncthreads();
                    const int t0 = c * 128 + wave * 16;
                    auto row_do = [&](int t, f32x4 (&v)[4]) __attribute__((always_inline)) {
                        float s = 0.f;
#pragma unroll
                        for (int j = 0; j < 4; ++j) s += (v[j].x * v[j].x + v[j].y * v[j].y) + (v[j].z * v[j].z + v[j].w * v[j].w);
                        const float r = rsqrtf(wave_sum(s) * (1.f / DM) + RMS_EPS);
                        float lg[8];
#pragma unroll
                        for (int e = 0; e < 8; ++e) lg[e] = 0.f;
                        float mx = 0.f;
#pragma unroll
                        for (int j = 0; j < 4; ++j) { const f32x4 hv = {v[j].x * r * gg[j].x, v[j].y * r * gg[j].y, v[j].z * r * gg[j].z, v[j].w * r * gg[j].w}; v[j] = hv;
                            mx = fmaxf(fmaxf(mx, fmaxf(fabsf(hv.x), fabsf(hv.y))), fmaxf(fabsf(hv.z), fabsf(hv.w)));
#pragma unroll
                            for (int q = 0; q < 4; ++q) { const f32x4 a0 = w0[j][q], a1 = w1[j][q]; const float hh = hv[q];
                                lg[0] += hh * a0.x; lg[1] += hh * a0.y; lg[2] += hh * a0.z; lg[3] += hh * a0.w; lg[4] += hh * a1.x; lg[5] += hh * a1.y; lg[6] += hh * a1.z; lg[7] += hh * a1.w; } }
#pragma unroll
                        for (int o = 1; o < 64; o <<= 1) mx = fmaxf(mx, __shfl_xor(mx, o));
                        { const float sc = mx > 0.f ? 127.0f / mx : 0.f; unsigned* o4 = (unsigned*)(XN8 + (size_t)t * DM) + lane;
#pragma unroll
                          for (int j = 0; j < 4; ++j) o4[64 * j] = pk4_i8(v[j].x * sc, v[j].y * sc, v[j].z * sc, v[j].w * sc);
                          if (lane == 0) RSX[t] = mx * (1.0f / 127.0f); }
                        float y4[4], y2[2], y1;
#pragma unroll
                        for (int k = 0; k < 4; ++k) { const float keep = b0_ ? lg[4 + k] : lg[k], send = b0_ ? lg[k] : lg[4 + k]; y4[k] = keep + __shfl_xor(send, 1); }
#pragma unroll
                        for (int k = 0; k < 2; ++k) { const float keep = b1_ ? y4[2 + k] : y4[k], send = b1_ ? y4[k] : y4[2 + k]; y2[k] = keep + __shfl_xor(send, 2); }
                        { const float keep = b2_ ? y2[1] : y2[0], send = b2_ ? y2[0] : y2[1]; y1 = keep + __shfl_xor(send, 4); }
                        y1 += __shfl_xor(y1, 8); y1 += __shfl_xor(y1, 16); y1 += __shfl_xor(y1, 32);
#pragma unroll
                        for (int e = 0; e < 8; ++e) lg[e] = __uint_as_float(__builtin_amdgcn_readlane(__float_as_uint(y1), ((e >> 2) & 1) | (((e >> 1) & 1) << 1) | ((e & 1) << 2)));
                        int e0 = 0; float b0 = lg[0];
#pragma unroll
                        for (int e = 1; e < 8; ++e) if (lg[e] > b0) { b0 = lg[e]; e0 = e; }
                        int e1 = 0; float b1 = -INFINITY;
#pragma unroll
                        for (int e = 0; e < 8; ++e) if (e != e0 && lg[e] > b1) { b1 = lg[e]; e1 = e; }
                        if (lane == 0) { const float w1v = 1.0f / (1.0f + __expf(b0 - b1)); const float w0v = 1.0f - w1v;
                            volatile LAS int* cw = cnt + wave * 8; const int i0 = cw[e0]; cw[e0] = i0 + 1; const int i1 = cw[e1]; cw[e1] = i1 + 1;
                            *(i32x4*)(TOKI + (size_t)t * 4) = (i32x4){e0, e1, i0, i1}; *(f32x2*)(TOKW + (size_t)t * 2) = (f32x2){w0v, w1v}; }
                    };
                    f32x4 na[4], nb[4]; ld_row16(XS16 + (size_t)t0 * DM, lane, na); ld_row16(XS16 + (size_t)(t0 + 1) * DM, lane, nb);
                    for (int i = 0; i < 16; i += 2) { const int t = t0 + i;
                        f32x4 va[4], vb[4];
#pragma unroll
                        for (int j = 0; j < 4; ++j) { va[j] = na[j]; vb[j] = nb[j]; }
                        if (i + 2 < 16) { ld_row16(XS16 + (size_t)(t + 2) * DM, lane, na); ld_row16(XS16 + (size_t)(t + 3) * DM, lane, nb); }
                        row_do(t, va); row_do(t + 1, vb);
                    }
                    LDS_WAIT(); __syncthreads();
                    if (tid < 8) { int* wp = (int*)(ws + OFF_WPRE) + c * 64 + tid; int run = 0;
#pragma unroll
                        for (int w = 0; w < 8; ++w) { wp[w * 8] = run; run += cnt[w * 8 + tid]; }
                        CNT[c * 8 + tid] = run; }
                    __syncthreads();
                }
            }
            SEAM(15);
            if (IN(16)) { asm volatile("; PHASE_MARK 16" ::: "memory"); PHB;
                LAS int* PRE = (LAS int*)(F.lds + RING_OFF);
                LAS int* TOT = PRE + 2048;
                { const int e = wave; int cv[4]; int run = 0;
#pragma unroll
                    for (int k = 0; k < 4; ++k) { cv[k] = CNT[(lane * 4 + k) * 8 + e]; run += cv[k]; }
                    int inc = run;
#pragma unroll
                    for (int o = 1; o < 64; o <<= 1) { const int t = __shfl_up(inc, o); if (lane >= o) inc += t; }
                    int ex = inc - run;
#pragma unroll
                    for (int k = 0; k < 4; ++k) { PRE[e * 256 + lane * 4 + k] = ex; ex += cv[k]; }
                    if (lane == 63) TOT[e] = inc; }
                LDS_WAIT(); __syncthreads();
                if (tid == 0) { int st = 0;
                    for (int e = 0; e < 8; ++e) { TOT[8 + e] = st; const int nb = (TOT[e] + 255) >> 8;
                        if (bid == 0) for (int k = 0; k < nb; ++k) MTAB[(st >> 8) + k] = e;
                        st += nb << 8; }
                    if (bid == 0) MTAB[264] = st >> 8; }
                LDS_WAIT(); __syncthreads();
                REPEAT(16) for (int c = bid; c < 256; c += G)
                    for (int i = 0; i < 16; ++i) { const int t = c * 128 + wave * 16 + i; const i32x4 ti = *(const i32x4*)(TOKI + (size_t)t * 4);
                        const int* wpre = (const int*)(ws + OFF_WPRE) + (c * 8 + wave) * 8;
                        const int r0 = TOT[8 + ti.x] + PRE[ti.x * 256 + c] + wpre[ti.x] + ti.z, r1 = TOT[8 + ti.y] + PRE[ti.y * 256 + c] + wpre[ti.y] + ti.w;
                        if (lane == 0) { *(i32x2*)(TOKR + (size_t)t * 2) = (i32x2){r0, r1}; const float rsv = RSX[t]; RSG[r0] = rsv; RSG[r1] = rsv; }
                        const v4u a = *((const v4u*)(XN8 + (size_t)t * DM) + lane);
                        *((v4u*)(XG + (size_t)r0 * DM) + lane) = a; *((v4u*)(XG + (size_t)r1 * DM) + lane) = a; }
            }
            SEAM(16);
            if (IN(17)) { asm volatile("; PHASE_MARK 17" ::: "memory"); PHB;
                const __attribute__((address_space(4))) int* mtab = (const __attribute__((address_space(4))) int*)(ws + OFF_MTAB); const int nblk = mtab[264];
                pg8::Gemm g{(const bf16*)XG, (const bf16*)(ws + OFF_WEGU), DM / 2, DM / 2}; pg8::MoeOrder S; S.init(nblk, 2 * EFF / 256, G, bid); S.tab = mtab;
                pg8::EpiSwigluI8 E{ACTM, EFF, RSG, (const float*)(ws + OFF_CSE)};
                REPEAT(17) pg8::gemm_phase<pg8::EpiSwigluI8, pg8::MoeOrder, false, true, true, true>(F.lds + RING_OFF, g, S, E, wave);
#ifdef PROBE_NULL_EPI
                { pg8::EpiNull EN; pg8::gemm_phase<pg8::EpiNull, pg8::MoeOrder, true>(F.lds + RING_OFF, g, S, EN, wave); }
#endif
            }
            SEAM(17);
            if (IN(18)) { asm volatile("; PHASE_MARK 18" ::: "memory"); PHB;
                const __attribute__((address_space(4))) int* mtab = (const __attribute__((address_space(4))) int*)(ws + OFF_MTAB); const int nblk = mtab[264];
                pg8::Gemm g{(const bf16*)ACTM, (const bf16*)(ws + OFF_WEDN), EFF / 2, EFF / 2}; pg8::MoeDownOrder S; S.init(nblk, G, bid); S.tab = mtab;
                pg8::EpiBf8K E{YE, (float*)(ws + OFF_XG), 1.0f / (A8S_ACT * W8S_DN)};
                REPEAT(18) pg8::gemm_phase<pg8::EpiBf8K, pg8::MoeDownOrder, true, true, true, false, true, false>(F.lds + RING_OFF, g, S, E, wave);
            }
            SEAM(18);
            if (IN(19)) { asm volatile("; PHASE_MARK 19" ::: "memory"); PHB;
                {
                    const __attribute__((address_space(4))) int* mtab = (const __attribute__((address_space(4))) int*)(ws + OFF_MTAB); const int ntail = (mtab[264] - 256) * 256;
                    const float* PART = (const float*)(ws + OFF_XG);
                    for (int r = gw; r < ntail; r += NGW) { const float* pp = PART + (size_t)(((r >> 8) * 7) * 256 + (r & 255)) * DM; f32x4 pv[7][4];
#pragma unroll
                        for (int k = 0; k < 7; ++k)
#pragma unroll
                            for (int j = 0; j < 4; ++j) pv[k][j] = ((const f32x4*)(pp + (size_t)k * 256 * DM) + lane)[64 * j];
#pragma unroll
                        for (int j = 0; j < 4; ++j) { f32x4 a = pv[0][j];
#pragma unroll
                            for (int k = 1; k < 7; ++k) a += pv[k][j];
                            ((v2u*)(YE + (size_t)(65536 + r) * DM) + lane)[64 * j] = (v2u){pg8::cvt_pk_bf16(a.x, a.y), pg8::cvt_pk_bf16(a.z, a.w)}; } }
                    xcd_barrier(bar, F.wave); }
                const f32x4* gr = (const f32x4*)ka->in[17] + lane;
                {   f32x4 gg[4];
#pragma unroll
                    for (int j = 0; j < 4; ++j) gg[j] = gr[64 * j];
                    v2u cx[4], c0[4], c1[4], nx[4], n0[4], n1[4]; i32x2 rrn = {0, 0}; f32x2 wwc = {0.f, 0.f}, wwn = {0.f, 0.f};
                    auto rows = [&](int t, i32x2 rr, v2u (&ax)[4], v2u (&a0)[4], v2u (&a1)[4]) __attribute__((always_inline)) {
                        const v2u* px = (const v2u*)(XS16 + (size_t)t * DM) + lane; const v2u* p0 = (const v2u*)(YE + (size_t)rr.x * DM) + lane; const v2u* p1 = (const v2u*)(YE + (size_t)rr.y * DM) + lane;
#pragma unroll
                        for (int j = 0; j < 4; ++j) { ax[j] = px[64 * j]; a0[j] = p0[64 * j]; a1[j] = p1[64 * j]; } };
                    int t = gw;
                    if (t < MTOK) { const i32x2 rr = *(const i32x2*)(TOKR + (size_t)t * 2); wwc = *(const f32x2*)(TOKW + (size_t)t * 2); rows(t, rr, cx, c0, c1); }
                    if (t + NGW < MTOK) { rrn = *(const i32x2*)(TOKR + (size_t)(t + NGW) * 2); wwn = *(const f32x2*)(TOKW + (size_t)(t + NGW) * 2); }
                    for (; t < MTOK; t += NGW) {
                        i32x2 rrnn = {0, 0}; f32x2 wwnn = {0.f, 0.f};
                        if (t + NGW < MTOK) rows(t + NGW, rrn, nx, n0, n1);
                        if (t + 2 * NGW < MTOK) { rrnn = *(const i32x2*)(TOKR + (size_t)(t + 2 * NGW) * 2); wwnn = *(const f32x2*)(TOKW + (size_t)(t + 2 * NGW) * 2); }
                        f32x4* xr = (f32x4*)(xs + (size_t)t * DM) + lane; f32x4 v[4]; float s = 0.f; const f32x2 ww = wwc;
#pragma unroll
                        for (int j = 0; j < 4; ++j) { const v2u x = cx[j], a = c0[j], b2 = c1[j];
                            v[j].x = bfl(x.x) + ww.x * bfl(a.x) + ww.y * bfl(b2.x); v[j].y = bfh(x.x) + ww.x * bfh(a.x) + ww.y * bfh(b2.x); v[j].z = bfl(x.y) + ww.x * bfl(a.y) + ww.y * bfl(b2.y); v[j].w = bfh(x.y) + ww.x * bfh(a.y) + ww.y * bfh(b2.y);
                            s += (v[j].x * v[j].x + v[j].y * v[j].y) + (v[j].z * v[j].z + v[j].w * v[j].w); }
                        const float r = rsqrtf(wave_sum(s) * (1.f / DM) + RMS_EPS);
#pragma unroll
                        for (int j = 0; j < 4; ++j) xr[64 * j] = (f32x4){v[j].x * r * gg[j].x, v[j].y * r * gg[j].y, v[j].z * r * gg[j].z, v[j].w * r * gg[j].w};
#pragma unroll
                        for (int j = 0; j < 4; ++j) { cx[j] = nx[j]; c0[j] = n0[j]; c1[j] = n1[j]; }
                        wwc = wwn; rrn = rrnn; wwn = wwnn; } }
            }
        }
    }
#undef IN
#undef SEAM
#undef INL
#undef SEAML
}

#undef SSQ
#undef LOGF
#undef CUM
#undef KMEAN
#undef KNM
#undef R64C
#undef R64S
#undef R32C
#undef R32S
#undef TOKI
#undef TOKW
#undef TOKR
#undef CNT
#undef MTAB
#undef XN8
#undef RSX
#undef RSG
#undef XS16
#undef XNQ
#undef CSC
#undef CSIN
#undef RSIN
#undef XN
#undef QM
#undef LAT
#undef KR
#undef FQ
#undef FK
#undef FV
#undef MQ
#undef MK
#undef MV
#undef GT
#undef KVM
#undef MERGED
#undef Y3
#undef ACTD
#undef ACTM
#undef XG
#undef YE
extern "C" void kernel_launch(void* const* d_in, const int* in_sizes, int n_in, void* d_out, int out_size, void* d_ws, size_t ws_size, hipStream_t stream) {
    static int grid = 0;
    if (grid == 0) {
        if (n_in != 18 || in_sizes[0] != MTOK * DM || out_size != MTOK * DM || ws_size < WS_NEED) { fprintf(stderr, "kernel_launch: shape / workspace mismatch (n_in %d, ws %zu, need %zu); nothing launched\n", n_in, ws_size, (size_t)WS_NEED); grid = -1; return; }
        int dev = 0, cus = 0, per_cu = 0;
        if (hipGetDevice(&dev) != hipSuccess || hipDeviceGetAttribute(&cus, hipDeviceAttributeMultiprocessorCount, dev) != hipSuccess) { grid = -1; return; }
        if (hipFuncSetAttribute((const void*)mega_fwd, hipFuncAttributeMaxDynamicSharedMemorySize, LDS_BYTES) != hipSuccess) { fprintf(stderr, "kernel_launch: hipFuncSetAttribute failed\n"); grid = -1; return; }
        if (hipOccupancyMaxActiveBlocksPerMultiprocessor(&per_cu, (const void*)mega_fwd, NWAVES * 64, LDS_BYTES) != hipSuccess || per_cu < 1) fprintf(stderr, "kernel_launch: occupancy query reports %d\n", per_cu);
        (void)hipGetLastError();
        grid = cus;
    }
    if (grid < 0) return;
    if (hipMemsetAsync((char*)d_ws + WS_CTL, 0, CTL_ZERO_BYTES, stream) != hipSuccess) return;
    KArgs a; memset(&a, 0, sizeof(a));
    for (int i = 0; i < 18; ++i) a.in[i] = d_in[i];
    a.out = (float*)d_out; a.ws = (unsigned char*)d_ws;
#if MK_N_LAUNCHES == 1
    a.ph_lo = 0; a.ph_hi = NPHASE;
    hipLaunchKernelGGL(mega_fwd, dim3(grid), dim3(NWAVES * 64), LDS_BYTES, stream, a);
#else
    for (int p = 0; p < NPHASE; ++p) { a.ph_lo = p; a.ph_hi = p + 1; hipLaunchKernelGGL(mega_fwd, dim3(grid), dim3(NWAVES * 64), LDS_BYTES, stream, a); }
#endif
}
```
